# Optimizing an MI355X kernel written in HIP

```python
import jax, jax.numpy as jnp
from jax import lax
import numpy as np

D_MODEL = 2048
BATCH = 4
SEQ = 4096
DEPTH = 2

GRID_W = 64
CTX_LEN = 256
HEAD_DIM = 128
N_HEADS = D_MODEL // HEAD_DIM
N_KV_HEADS = N_HEADS // 4
GROUPS = N_HEADS // N_KV_HEADS
ATTN_WIDTH = N_HEADS * HEAD_DIM
KV_WIDTH = N_KV_HEADS * HEAD_DIM
CONV_WIDTH = D_MODEL
CONV_SIZE = 3
Q_BLOCK = 128
ROPE_THETA = 10000.0
AXIS_DIM = HEAD_DIM // 2
PEER_HEADS = 8
PEER_KEY_DIM = 256
PEER_HALF = PEER_KEY_DIM // 2
N_KEYS = 128
N_EXPERTS = N_KEYS * N_KEYS
PEER_TOPK = 16
PEER_CHUNK = 128
N_MOD = 6
EPS = 1e-6

Q_END = ATTN_WIDTH
K_END = Q_END + KV_WIDTH
V_END = K_END + KV_WIDTH
U_END = V_END + CONV_WIDTH
B_END = U_END + CONV_WIDTH
C_END = B_END + CONV_WIDTH
GA_END = C_END + D_MODEL
IN_WIDTH = GA_END + D_MODEL
SPLITS = (Q_END, K_END, V_END, U_END, B_END, C_END, GA_END)

kernel_name = "hybrid_gqa_shortconv_peer_dit"


def _rms_norm(x, g):
    xf = x.astype(jnp.float32)
    y = xf * lax.rsqrt(jnp.mean(xf * xf, axis=-1, keepdims=True) + EPS)
    return y.astype(x.dtype) * g


def _modulate(h, shift, scale):
    return h * (1 + scale) + shift


def _adaln(cvec, w, b):
    return jnp.split(jax.nn.silu(cvec) @ w + b, N_MOD, axis=-1)


def _axial_rope_tables(n):
    rows = n // GRID_W
    row = jnp.repeat(jnp.arange(rows, dtype=jnp.float32), GRID_W)
    col = jnp.tile(jnp.arange(GRID_W, dtype=jnp.float32), rows)
    inv = ROPE_THETA ** (-jnp.arange(0, AXIS_DIM, 2, dtype=jnp.float32) / AXIS_DIM)
    ang_r = row[:, None] * inv[None, :]
    ang_c = col[:, None] * inv[None, :]
    return (jnp.cos(ang_r), jnp.sin(ang_r), jnp.cos(ang_c), jnp.sin(ang_c))


def _rotate(x, cos, sin):
    x1, x2 = jnp.split(x, 2, axis=-1)
    return jnp.concatenate([x1 * cos - x2 * sin, x2 * cos + x1 * sin], axis=-1)


def _apply_rope(x, tabs):
    cr, sr, cc, sc = (t[None, :, None, :] for t in tabs)
    xf = x.astype(jnp.float32)
    out = jnp.concatenate([_rotate(xf[..., :AXIS_DIM], cr, sr),
                           _rotate(xf[..., AXIS_DIM:], cc, sc)], axis=-1)
    return out.astype(x.dtype)


def _block_attention(q, k, v):
    b, t = q.shape[0], q.shape[1]
    nb = t // Q_BLOCK
    qb = q.reshape(b, nb, Q_BLOCK, N_KV_HEADS, GROUPS, HEAD_DIM).transpose(1, 0, 2, 3, 4, 5)
    scale = HEAD_DIM ** -0.5

    def one_block(q_blk):
        s = jnp.einsum('bqkgd,bskd->bkgqs', q_blk, k).astype(jnp.float32) * scale
        p = jax.nn.softmax(s, axis=-1).astype(v.dtype)
        return jnp.einsum('bkgqs,bskd->bqkgd', p, v)

    o = lax.map(one_block, qb)
    return o.transpose(1, 0, 2, 3, 4, 5).reshape(b, t, ATTN_WIDTH)


def _short_conv(u, w):
    up = jnp.pad(u, ((0, 0), (1, 1), (0, 0)))
    return w[0] * up[:, :-2] + w[1] * up[:, 1:-1] + w[2] * up[:, 2:]


def _ctx_kv(p_kv, k_g):
    b, t, _ = p_kv.shape
    k = _rms_norm(p_kv[..., :KV_WIDTH].reshape(b, t, N_KV_HEADS, HEAD_DIM), k_g)
    v = p_kv[..., KV_WIDTH:].reshape(b, t, N_KV_HEADS, HEAD_DIM)
    return k, v


def _token_mixer(p, q_g, k_g, conv_w, b_gate, w_ao, w_co, w_o, rope, k_pre, v_pre):
    b, t, _ = p.shape
    q, k, v, u, gate_b, gate_c, g_att, g_conv = jnp.split(p, SPLITS, axis=-1)
    q = _rms_norm(q.reshape(b, t, N_HEADS, HEAD_DIM), q_g)
    k = _rms_norm(k.reshape(b, t, N_KV_HEADS, HEAD_DIM), k_g)
    v = v.reshape(b, t, N_KV_HEADS, HEAD_DIM)
    if rope is not None:
        q = _apply_rope(q, rope)
        k = _apply_rope(k, rope)
    if k_pre is not None:
        k = jnp.concatenate([k, k_pre], axis=1)
        v = jnp.concatenate([v, v_pre], axis=1)
    attn = _block_attention(q.reshape(b, t, N_KV_HEADS, GROUPS, HEAD_DIM), k, v) @ w_ao
    conv = (gate_b * _short_conv(gate_c * u, conv_w)) @ w_co
    merged = (jax.nn.sigmoid(g_att + b_gate[:D_MODEL]) * attn
              + jax.nn.sigmoid(g_conv + b_gate[D_MODEL:]) * conv)
    return merged @ w_o


def _peer(h, wq, k1, k2, u, v):
    b, t, d = h.shape
    q = (h @ wq).reshape(b, t, PEER_HEADS, 2, PEER_HALF)
    s1 = jnp.einsum('bthd,hkd->bthk', q[..., 0, :], k1)
    s2 = jnp.einsum('bthd,hkd->bthk', q[..., 1, :], k2)
    v1, i1 = lax.top_k(s1, PEER_TOPK)
    v2, i2 = lax.top_k(s2, PEER_TOPK)
    cand_s = (v1[..., :, None] + v2[..., None, :]).reshape(b, t, PEER_HEADS, PEER_TOPK * PEER_TOPK)
    cand_i = (i1[..., :, None] * N_KEYS + i2[..., None, :]).reshape(b, t, PEER_HEADS, PEER_TOPK * PEER_TOPK)
    top_s, top_j = lax.top_k(cand_s, PEER_TOPK)
    eidx = jnp.take_along_axis(cand_i, top_j, axis=-1)
    gw = jax.nn.softmax(top_s.astype(jnp.float32), axis=-1).astype(h.dtype)
    n = b * t
    nc = n // PEER_CHUNK
    hf = h.reshape(nc, PEER_CHUNK, d)
    ef = eidx.reshape(nc, PEER_CHUNK, PEER_HEADS * PEER_TOPK)
    gf = gw.reshape(nc, PEER_CHUNK, PEER_HEADS * PEER_TOPK)

    def one_chunk(args):
        hc, ec, gc = args
        act = jax.nn.gelu(jnp.einsum('tkd,td->tk', u[ec], hc), approximate=False)
        return jnp.einsum('tk,tkd->td', gc * act, v[ec])

    out = lax.map(one_chunk, (hf, ef, gf))
    return out.reshape(b, t, d)


def setup_inputs(seed: int = 0) -> dict:
    key = jax.random.key(seed)
    ks = jax.random.split(key, 24)
    f32 = jnp.float32
    nrm = lambda k, shape, s: jax.random.normal(k, shape, f32) * s
    D = D_MODEL
    return {
        "x": nrm(ks[0], (BATCH, SEQ, D), 1.0),
        "c": nrm(ks[1], (BATCH, D), 1.0),
        "ctx": nrm(ks[2], (BATCH, CTX_LEN, D), 1.0),
        "c_ctx": nrm(ks[3], (D,), 1.0),
        "ada_w": nrm(ks[4], (DEPTH, D, N_MOD * D), 0.5 * D ** -0.5),
        "ada_b": nrm(ks[5], (DEPTH, N_MOD * D), 0.01),
        "norm1_g": 1.0 + nrm(ks[6], (DEPTH, D), 0.02),
        "norm2_g": 1.0 + nrm(ks[7], (DEPTH, D), 0.02),
        "w_in": nrm(ks[8], (DEPTH, D, IN_WIDTH), D ** -0.5),
        "b_gate": nrm(ks[9], (DEPTH, 2 * D), 0.02),
        "q_norm_g": 1.0 + nrm(ks[10], (DEPTH, HEAD_DIM), 0.02),
        "k_norm_g": 1.0 + nrm(ks[11], (DEPTH, HEAD_DIM), 0.02),
        "conv_w": nrm(ks[12], (DEPTH, CONV_SIZE, CONV_WIDTH), CONV_SIZE ** -0.5),
        "w_attn_out": nrm(ks[13], (DEPTH, ATTN_WIDTH, D), ATTN_WIDTH ** -0.5),
        "w_conv_out": nrm(ks[14], (DEPTH, CONV_WIDTH, D), CONV_WIDTH ** -0.5),
        "w_o": nrm(ks[15], (DEPTH, D, D), D ** -0.5),
        "peer_wq": nrm(ks[16], (DEPTH, D, PEER_HEADS * PEER_KEY_DIM), D ** -0.5),
        "peer_k1": nrm(ks[17], (DEPTH, PEER_HEADS, N_KEYS, PEER_HALF), PEER_HALF ** -0.5),
        "peer_k2": nrm(ks[18], (DEPTH, PEER_HEADS, N_KEYS, PEER_HALF), PEER_HALF ** -0.5),
        "peer_u": nrm(ks[19], (DEPTH, N_EXPERTS, D), D ** -0.5),
        "peer_v": nrm(ks[20], (DEPTH, N_EXPERTS, D), 1.0),
        "final_g": 1.0 + nrm(ks[21], (D,), 0.02),
    }


def reference(x, c, ctx, c_ctx, ada_w, ada_b, norm1_g, norm2_g, w_in, b_gate,
              q_norm_g, k_norm_g, conv_w, w_attn_out, w_conv_out, w_o,
              peer_wq, peer_k1, peer_k2, peer_u, peer_v, final_g):
    rope = _axial_rope_tables(x.shape[1])
    xc = ctx
    for l in range(DEPTH):
        last = l == DEPTH - 1
        sh1, sc1, g1, sh2, sc2, g2 = [m[:, None, :] for m in _adaln(c, ada_w[l], ada_b[l])]
        csh1, csc1, cg1, csh2, csc2, cg2 = _adaln(c_ctx, ada_w[l], ada_b[l])
        mix_args = (q_norm_g[l], k_norm_g[l], conv_w[l], b_gate[l],
                    w_attn_out[l], w_conv_out[l], w_o[l])

        h = _modulate(_rms_norm(x, norm1_g[l]), sh1, sc1)
        hc = _modulate(_rms_norm(xc, norm1_g[l]), csh1, csc1)
        if last:
            kc, vc = _ctx_kv(hc @ w_in[l][:, Q_END:V_END], k_norm_g[l])
        else:
            pc = hc @ w_in[l]
            kc, vc = _ctx_kv(pc[..., Q_END:V_END], k_norm_g[l])
            xc = xc + cg1 * _token_mixer(pc, *mix_args, None, None, None)
        x = x + g1 * _token_mixer(h @ w_in[l], *mix_args, rope, kc, vc)

        peer_args = (peer_wq[l], peer_k1[l], peer_k2[l], peer_u[l], peer_v[l])
        h2 = _modulate(_rms_norm(x, norm2_g[l]), sh2, sc2)
        x = x + g2 * _peer(h2, *peer_args)
        if not last:
            hc2 = _modulate(_rms_norm(xc, norm2_g[l]), csh2, csc2)
            xc = xc + cg2 * _peer(hc2, *peer_args)
    return _rms_norm(x, final_g)
```

```cpp
#include <hip/hip_runtime.h>
#include <hip/hip_bf16.h>
#include <cstdio>
#include <cstdint>
namespace pg8 {
#define PG8_LAS __attribute__((address_space(3)))
typedef unsigned short bf16_t;
typedef short bf16x8 __attribute__((ext_vector_type(8)));
typedef float f32x4 __attribute__((ext_vector_type(4)));
typedef unsigned u32x4 __attribute__((ext_vector_type(4)));
constexpr int BM = 256, BK = 64, HALF = 128, HTB = HALF * BK * 2  , STAGE_BYTES = 8 * HTB, NXCD = 8, WGM = 4;

__host__ __device__ __forceinline__ int lds_byte(int r, int c) { const int st = (r >> 4) * 2 + (c >> 5), rr = r & 15, cc = c & 31, ob = rr * 64 + cc * 2; return st * 1024 + (ob ^ (((ob >> 9) & 1) << 5)); }
__host__ __device__ __forceinline__ void stage_rc(int b, int& R, int& C) { const int st = b / 1024, sb = b % 1024, swz = sb ^ (((sb >> 9) & 1) << 5); R = (st >> 1) * 16 + swz / 64; C = (st & 1) * 32 + (swz % 64) / 2; }
__host__ __device__ __forceinline__ int perm32(int rho) { const int n = rho >> 4, i = rho & 15; return 8 * (i >> 2) + 4 * n + (i & 3); }

struct Unit { int pm, pn; };
struct Gemm { const bf16_t* A; const bf16_t* Bt; int M, N, K; };

struct StaticOrder {
    int nM, nN, nwg, G, c;
    __host__ __device__ void init(int M, int N, int G_, int c_) { nM = M / BM; nN = N / BM; nwg = nM * nN; G = G_; c = c_; }
    __host__ __device__ bool next(int i, Unit& u) const {
        const long L = (long)i * G + c; if (L >= nwg) return false;
        int wgid = (int)L; { const int q = nwg / NXCD, r = nwg % NXCD, xcd = wgid % NXCD, off = wgid / NXCD; wgid = (xcd < r ? xcd * (q + 1) : r * (q + 1) + (xcd - r) * q) + off; }
        const int nig = WGM * nN, gid = wgid / nig, fm = gid * WGM, gsz = (nM - fm) < WGM ? (nM - fm) : WGM;
        u.pm = fm + ((wgid % nig) % gsz); u.pn = (wgid % nig) / gsz; return true;
    }
    __device__ __forceinline__ void a_ready(const Unit&) const {}
    __device__ __forceinline__ void done(const Unit&) const {}
};

__device__ __forceinline__ unsigned cvt_pk_bf16(float lo, float hi) { unsigned r; asm volatile("v_cvt_pk_bf16_f32 %0, %1, %2" : "=v"(r) : "v"(lo), "v"(hi)); return r; }
typedef float f32x2 __attribute__((ext_vector_type(2)));
__device__ __forceinline__ f32x2 gelu_pk(f32x2 v) {
    const f32x2 av = __builtin_elementwise_abs(v), d = av * 0.2316418882f + 1.0f;
    f32x2 t; t.x = __builtin_amdgcn_rcpf(d.x); t.y = __builtin_amdgcn_rcpf(d.y);
    f32x2 q = t * 0.5307027145f + (-0.7265760135f); q = q * t + 0.7107068705f; q = q * t + (-0.142248368f); q = q * t + 0.127414796f; q = q * t;
    const f32x2 s = (v * v) * (-0.72134752044f);
    f32x2 e; e.x = __builtin_amdgcn_exp2f(s.x); e.y = __builtin_amdgcn_exp2f(s.y);
    const f32x2 m = v * (q * e), r = v - m;
    f32x2 o; o.x = v.x < 0.f ? m.x : r.x; o.y = v.y < 0.f ? m.y : r.y; return o;
}


__device__ __forceinline__ float bf_lo(unsigned w) { return __uint_as_float(w << 16); }
__device__ __forceinline__ float bf_hi(unsigned w) { return __uint_as_float(w & 0xffff0000u); }
struct EpiStore {
    static constexpr bool PERM = true, AFTER_DRAIN = false, HAS_MID = false;
    bf16_t* O; int ldc;
    __device__ __forceinline__ void mid(f32x4 (&)[2][2][4][2], const Unit&, int, int, int, int) const {}
    __device__ __forceinline__ void operator()(const f32x4 (&acc)[2][2][4][2], const Unit& u, int wr, int wc, int fr, int fq) const {
        const int row0 = u.pm * BM + wr * 64 + fr, col0 = u.pn * BM + wc * 32 + 8 * fq;
#pragma unroll
        for (int ai = 0; ai < 2; ++ai)
#pragma unroll
            for (int m = 0; m < 4; ++m) { bf16_t* rowp = O + (size_t)(row0 + ai * HALF + m * 16) * ldc + col0;
#pragma unroll
                for (int bj = 0; bj < 2; ++bj) { const f32x4 v0 = acc[ai][bj][m][0], v1 = acc[ai][bj][m][1];
                    u32x4 w; w.x = cvt_pk_bf16(v0[0], v0[1]); w.y = cvt_pk_bf16(v0[2], v0[3]); w.z = cvt_pk_bf16(v1[0], v1[1]); w.w = cvt_pk_bf16(v1[2], v1[3]);
                    *(u32x4*)(rowp + bj * HALF) = w; } }
    }
};
struct EpiStore8 {
    static constexpr bool PERM = true, AFTER_DRAIN = false, HAS_MID = false;
    bf16_t* O; int ldc; const float* rs; float cs; int gcol0; float gscale;
    __device__ __forceinline__ void mid(f32x4 (&)[2][2][4][2], const Unit&, int, int, int, int) const {}
    __device__ __forceinline__ void operator()(const f32x4 (&acc)[2][2][4][2], const Unit& u, int wr, int wc, int fr, int fq) const {
        int fr_ = fr, fq_ = fq; asm volatile("" : "+v"(fr_), "+v"(fq_));
        const int row0 = u.pm * BM + wr * 64 + fr_, col0 = u.pn * BM + wc * 32 + 8 * fq_;
        const bool g8 = gcol0 >= 0 && u.pn * BM >= gcol0;
        typedef unsigned u32x2 __attribute__((ext_vector_type(2)));
#pragma unroll
        for (int ai = 0; ai < 2; ++ai)
#pragma unroll
            for (int m = 0; m < 4; ++m) { const int row = row0 + ai * HALF + m * 16; bf16_t* rowp = O + (size_t)row * ldc + col0; const float sc = rs[row] * cs;
#pragma unroll
                for (int bj = 0; bj < 2; ++bj) { const f32x4 v0 = acc[ai][bj][m][0] * sc, v1 = acc[ai][bj][m][1] * sc;
                    if (g8) { float c8[8] = {v0[0], v0[1], v0[2], v0[3], v1[0], v1[1], v1[2], v1[3]};
#pragma unroll
                        for (int e = 0; e < 8; ++e) c8[e] = fminf(fmaxf(c8[e] * gscale, -448.f), 448.f);
                        int w0 = 0, w1 = 0; w0 = __builtin_amdgcn_cvt_pk_fp8_f32(c8[0], c8[1], w0, false); w0 = __builtin_amdgcn_cvt_pk_fp8_f32(c8[2], c8[3], w0, true);
                        w1 = __builtin_amdgcn_cvt_pk_fp8_f32(c8[4], c8[5], w1, false); w1 = __builtin_amdgcn_cvt_pk_fp8_f32(c8[6], c8[7], w1, true);
                        u32x2 w; w.x = (unsigned)w0; w.y = (unsigned)w1;
                        *(u32x2*)((unsigned char*)(O + (size_t)row * ldc + gcol0) + (col0 + bj * HALF - gcol0)) = w;
                    } else { u32x4 w; w.x = cvt_pk_bf16(v0[0], v0[1]); w.y = cvt_pk_bf16(v0[2], v0[3]); w.z = cvt_pk_bf16(v1[0], v1[1]); w.w = cvt_pk_bf16(v1[2], v1[3]);
                    *(u32x4*)(rowp + bj * HALF) = w; } } }
    }
};
template <bool OUT8>
struct EpiGate {
    static constexpr bool PERM = true, AFTER_DRAIN = false, HAS_MID = true;
    bf16_t* O; int ldc; float oscale; float midf, endf; const unsigned char* G; int ldg; int ga_off, gc_off; float ginv; const float* bgate;
    __device__ __forceinline__ void mid(f32x4 (&acc)[2][2][4][2], const Unit& u, int wr, int wc, int fr, int fq) const {
        int rowv = u.pm * BM + wr * 64 + fr; asm volatile("" : "+v"(rowv));
        const int col0 = u.pn * BM + wc * 32 + 8 * fq;
        const unsigned char* pbase = G + (size_t)rowv * ldg + col0;
        typedef unsigned u32x2 __attribute__((ext_vector_type(2))); typedef float f32x2 __attribute__((ext_vector_type(2)));
#pragma unroll
        for (int bj = 0; bj < 2; ++bj) {
            const f32x4 ba0 = *(const f32x4*)(bgate + col0 + bj * HALF), ba1 = *(const f32x4*)(bgate + col0 + bj * HALF + 4), bc0 = *(const f32x4*)(bgate + 2048 + col0 + bj * HALF), bc1 = *(const f32x4*)(bgate + 2048 + col0 + bj * HALF + 4);
#pragma unroll
            for (int ai = 0; ai < 2; ++ai) { u32x2 gav[4], gcv[4];
                const unsigned char* pq = pbase + (size_t)(ai * HALF) * ldg + bj * HALF; asm volatile("" : "+v"(pq) :: "memory");
#pragma unroll
                for (int m = 0; m < 4; ++m) { const unsigned char* pr = pq + (size_t)(m * 16) * ldg; gav[m] = *(const u32x2*)(pr + ga_off); gcv[m] = *(const u32x2*)(pr + gc_off); }
#pragma unroll
                for (int m = 0; m < 4; ++m) { const u32x2 ga = gav[m], gc = gcv[m];
                    const f32x2 a0 = __builtin_amdgcn_cvt_pk_f32_fp8((int)ga.x, false), a1 = __builtin_amdgcn_cvt_pk_f32_fp8((int)ga.x, true), a2 = __builtin_amdgcn_cvt_pk_f32_fp8((int)ga.y, false), a3 = __builtin_amdgcn_cvt_pk_f32_fp8((int)ga.y, true);
                    const f32x2 c0 = __builtin_amdgcn_cvt_pk_f32_fp8((int)gc.x, false), c1 = __builtin_amdgcn_cvt_pk_f32_fp8((int)gc.x, true), c2 = __builtin_amdgcn_cvt_pk_f32_fp8((int)gc.y, false), c3 = __builtin_amdgcn_cvt_pk_f32_fp8((int)gc.y, true);
                    float a[8] = {a0.x * ginv, a0.y * ginv, a1.x * ginv, a1.y * ginv, a2.x * ginv, a2.y * ginv, a3.x * ginv, a3.y * ginv};
                    float c[8] = {c0.x * ginv, c0.y * ginv, c1.x * ginv, c1.y * ginv, c2.x * ginv, c2.y * ginv, c3.x * ginv, c3.y * ginv};
#pragma unroll
                    for (int e = 0; e < 8; ++e) { const float av = a[e] + (e < 4 ? ba0[e & 3] : ba1[e & 3]), cv = c[e] + (e < 4 ? bc0[e & 3] : bc1[e & 3]);
                        const float ratio = midf * (1.f + __expf(-cv)) * __builtin_amdgcn_rcpf(1.f + __expf(-av));
                        acc[ai][bj][m][e >> 2][e & 3] *= ratio; } } } }
    }
    __device__ __forceinline__ void operator()(const f32x4 (&acc)[2][2][4][2], const Unit& u, int wr, int wc, int fr, int fq) const {
        int rowv = u.pm * BM + wr * 64 + fr; asm volatile("" : "+v"(rowv));
        const int col0 = u.pn * BM + wc * 32 + 8 * fq;
        const unsigned char* pbase = G + (size_t)rowv * ldg + col0 + gc_off; typedef unsigned u32x2g __attribute__((ext_vector_type(2))); typedef float f32x2 __attribute__((ext_vector_type(2))); bf16_t* obase = OUT8 ? (bf16_t*)((unsigned char*)O + (size_t)rowv * ldc + col0) : O + (size_t)rowv * ldc + col0;
#pragma unroll
        for (int bj = 0; bj < 2; ++bj) {
            const f32x4 bc0 = *(const f32x4*)(bgate + 2048 + col0 + bj * HALF), bc1 = *(const f32x4*)(bgate + 2048 + col0 + bj * HALF + 4);
#pragma unroll
            for (int ai = 0; ai < 2; ++ai) { u32x2g gcv[4];
                const unsigned char* pq = pbase + (size_t)(ai * HALF) * ldg + bj * HALF; unsigned char* oq = (unsigned char*)obase + ((size_t)(ai * HALF) * ldc + bj * HALF) * (OUT8 ? 1 : 2);
                asm volatile("" : "+v"(pq), "+v"(oq) :: "memory");
#pragma unroll
                for (int m = 0; m < 4; ++m) gcv[m] = *(const u32x2g*)(pq + (size_t)(m * 16) * ldg);
#pragma unroll
                for (int m = 0; m < 4; ++m) { const u32x2g gc = gcv[m]; unsigned char* orow = oq + (size_t)(m * 16) * ldc * (OUT8 ? 1 : 2);
                    const f32x2 c0 = __builtin_amdgcn_cvt_pk_f32_fp8((int)gc.x, false), c1 = __builtin_amdgcn_cvt_pk_f32_fp8((int)gc.x, true), c2 = __builtin_amdgcn_cvt_pk_f32_fp8((int)gc.y, false), c3 = __builtin_amdgcn_cvt_pk_f32_fp8((int)gc.y, true);
                    float c[8] = {c0.x * ginv, c0.y * ginv, c1.x * ginv, c1.y * ginv, c2.x * ginv, c2.y * ginv, c3.x * ginv, c3.y * ginv};
                    float o[8];
#pragma unroll
                    for (int e = 0; e < 8; ++e) { const float cv = c[e] + (e < 4 ? bc0[e & 3] : bc1[e & 3]); o[e] = acc[ai][bj][m][e >> 2][e & 3] * endf * __builtin_amdgcn_rcpf(1.f + __expf(-cv)); }
                    if constexpr (OUT8) { float c8[8];
#pragma unroll
                        for (int e = 0; e < 8; ++e) c8[e] = fminf(fmaxf(o[e] * oscale, -448.f), 448.f);
                        int w0 = 0, w1 = 0; w0 = __builtin_amdgcn_cvt_pk_fp8_f32(c8[0], c8[1], w0, false); w0 = __builtin_amdgcn_cvt_pk_fp8_f32(c8[2], c8[3], w0, true);
                        w1 = __builtin_amdgcn_cvt_pk_fp8_f32(c8[4], c8[5], w1, false); w1 = __builtin_amdgcn_cvt_pk_fp8_f32(c8[6], c8[7], w1, true);
                        typedef unsigned u32x2 __attribute__((ext_vector_type(2))); u32x2 w; w.x = (unsigned)w0; w.y = (unsigned)w1; *(u32x2*)orow = w;
                    } else { u32x4 w; w.x = cvt_pk_bf16(o[0], o[1]); w.y = cvt_pk_bf16(o[2], o[3]); w.z = cvt_pk_bf16(o[4], o[5]); w.w = cvt_pk_bf16(o[6], o[7]);
                    *(u32x4*)orow = w; } } } }
    }
};
template <bool IN16>
struct EpiResid {
    static constexpr bool PERM = false, AFTER_DRAIN = false, HAS_MID = false;
    const float* xin_lat; const float* xin_ctx; bf16_t* xs; const float* mod; const float* bias; float ascale;
    __device__ __forceinline__ void mid(f32x4 (&)[2][2][4][2], const Unit&, int, int, int, int) const {}
    __device__ __forceinline__ void operator()(const f32x4 (&acc)[2][2][4][2], const Unit& u, int wr, int wc, int fr, int fq) const {
        const int modrow = u.pm < 64 ? (u.pm >> 4) : 4; const bool lat = u.pm < 64;
        const float* xi = lat ? xin_lat + (size_t)(u.pm * BM) * 2048 : xin_ctx + (size_t)((u.pm - 64) * BM) * 2048;
        bf16_t* xo = xs + (size_t)(u.pm * BM) * 2048;
        const float* md = mod + modrow * 12288;
        const int col0 = u.pn * BM + wc * 32 + 4 * fq;
        typedef unsigned u32x2 __attribute__((ext_vector_type(2)));
#pragma unroll
        for (int bj = 0; bj < 2; ++bj)
#pragma unroll
            for (int n = 0; n < 2; ++n) { const int col = col0 + bj * HALF + n * 16; const f32x4 g = (*(const f32x4*)(md + col) + *(const f32x4*)(bias + col)) * ascale;
#pragma unroll
                for (int ai = 0; ai < 2; ++ai)
#pragma unroll
                    for (int m = 0; m < 4; ++m) { const size_t off = (size_t)(ai * HALF + wr * 64 + m * 16 + fr) * 2048 + col;
                        f32x4 xv;
                        if constexpr (IN16) { const u32x2 w = *(const u32x2*)(xo + off); xv = (f32x4){bf_lo(w.x), bf_hi(w.x), bf_lo(w.y), bf_hi(w.y)}; } else xv = *(const f32x4*)(xi + off);
                        const f32x4 o = xv + g * acc[ai][bj][m][n];
                        u32x2 w; w.x = cvt_pk_bf16(o[0], o[1]); w.y = cvt_pk_bf16(o[2], o[3]); *(u32x2*)(xo + off) = w; } }
    }
};
struct OrderX {
    StaticOrder b; int nextra;
    __device__ __forceinline__ void init(int M, int N, int G, int c, int nextra_) { b.init(M, N, G, c); nextra = nextra_; }
    __device__ __forceinline__ bool next(int i, Unit& u) const {
        const long L = (long)i * b.G + b.c; if (L < b.nwg) return b.next(i, u);
        const int e = (int)(L - b.nwg); if (e >= nextra) return false; u.pm = 64 + (e >> 2); u.pn = 8 + (e & 3); return true; }
    __device__ __forceinline__ void a_ready(const Unit&) const {}
    __device__ __forceinline__ void done(const Unit&) const {}
};
typedef int pg8_v4i __attribute__((ext_vector_type(4))); typedef int pg8_v8i __attribute__((ext_vector_type(8)));
__device__ __forceinline__ pg8_v8i pg8_cat(bf16x8 lo, bf16x8 hi) { return __builtin_shufflevector(__builtin_bit_cast(pg8_v4i, lo), __builtin_bit_cast(pg8_v4i, hi), 0, 1, 2, 3, 4, 5, 6, 7); }
template <class Epi, class Sched, bool ALIGN_EPI = false, bool SP2 = false, bool FP8 = false>
__device__ __forceinline__ void gemm_phase(PG8_LAS unsigned char* lds, const Gemm g, const Sched& S, const Epi& E) {
    int tid = threadIdx.x; asm volatile("" : "+v"(tid));
    const int wid = __builtin_amdgcn_readfirstlane(tid >> 6), lane = tid & 63, wr = wid >> 2, wc = wid & 3, fr = lane & 15, fq = lane >> 4;
    const int K = g.K, nt = K / BK;
    unsigned voffA[2], voffB[2];
#pragma unroll
    for (int i = 0; i < 2; ++i) { int R, C; stage_rc(tid * 16 + i * 8192, R, C); const int Rb = Epi::PERM ? ((R & ~31) + perm32(R & 31)) : R;
        voffA[i] = (unsigned)(R * K + C) * 2u; voffB[i] = (unsigned)(Rb * K + C) * 2u; }
    const size_t kstep = (size_t)(BK * 2);
    const size_t hstep = (size_t)HALF * K * 2;
    const size_t tstep = 2 * hstep;
    const unsigned ldsw = (unsigned)wid * 1024u;
    const int aoff = FP8 ? lds_byte(wr * 64 + fr, 16 * (fq & 1)) + (fq >> 1) * 1024 : lds_byte(wr * 64 + fr, fq * 8), boff = FP8 ? lds_byte(wc * 32 + fr, 16 * (fq & 1)) + (fq >> 1) * 1024 : lds_byte(wc * 32 + fr, fq * 8);
    constexpr int KSTEP = FP8 ? 16 : 1024;
    int sc8 = 0x7F7F7F7F; asm volatile("" : "+v"(sc8));
    unsigned abase8 = (unsigned)(size_t)lds + (unsigned)aoff, bbase8 = (unsigned)(size_t)lds + (unsigned)boff + 4u * HTB; asm volatile("" : "+v"(abase8), "+v"(bbase8));
#define PG8_SA(b, h) (((b) * 2 + (h)) * HTB)
#define PG8_SB(b, h) ((4 + (b) * 2 + (h)) * HTB)
#define PG8_STAGE(bufoff, gbase, voff) do { _Pragma("unroll") for (int _i = 0; _i < 2; ++_i) \
        __builtin_amdgcn_global_load_lds((const unsigned*)((const char*)(gbase) + (voff)[_i]), (PG8_LAS unsigned*)(lds + (bufoff) + ldsw + _i * 8192), 16, 0, 0); } while (0)
#define PG8_LDA(dst, b, h) do { _Pragma("unroll") for (int m = 0; m < 4; ++m) _Pragma("unroll") for (int k = 0; k < 2; ++k) { if constexpr (FP8) { if (k == 0) dst##8[m].lo = *(const PG8_LAS pg8_v4i*)(size_t)(abase8 + (PG8_SA(b, h) + m * 2048)); else dst##8[m].hi = *(const PG8_LAS pg8_v4i*)(size_t)(abase8 + (PG8_SA(b, h) + m * 2048 + 16)); } else dst[m][k] = *(const PG8_LAS bf16x8*)(lds + PG8_SA(b, h) + aoff + m * 2048 + k * KSTEP); } } while (0)
#define PG8_LDB(dst, b, h) do { _Pragma("unroll") for (int n = 0; n < 2; ++n) _Pragma("unroll") for (int k = 0; k < 2; ++k) { if constexpr (FP8) { if (k == 0) dst##8[n].lo = *(const PG8_LAS pg8_v4i*)(size_t)(bbase8 + (PG8_SB(b, h) - 4 * HTB + n * 2048)); else dst##8[n].hi = *(const PG8_LAS pg8_v4i*)(size_t)(bbase8 + (PG8_SB(b, h) - 4 * HTB + n * 2048 + 16)); } else dst[n][k] = *(const PG8_LAS bf16x8*)(lds + PG8_SB(b, h) + boff + n * 2048 + k * KSTEP); } } while (0)
#define PG8_MMA(ai, bj, At, Bt) do { __builtin_amdgcn_s_setprio(1); if constexpr (FP8) { _Pragma("unroll") for (int m = 0; m < 4; ++m) _Pragma("unroll") for (int n = 0; n < 2; ++n) \
        asm volatile("v_mfma_scale_f32_16x16x128_f8f6f4 %0, %1, %2, %0, %3, %3 op_sel_hi:[0,0,0]" : "+v"(acc[ai][bj][m][n]) : "v"(Bt##8[n]), "v"(At##8[m]), "v"(sc8)); } else { \
        _Pragma("unroll") for (int m = 0; m < 4; ++m) _Pragma("unroll") for (int n = 0; n < 2; ++n) _Pragma("unroll") for (int k = 0; k < 2; ++k) \
        acc[ai][bj][m][n] = __builtin_amdgcn_mfma_f32_16x16x32_bf16(Bt[n][k], At[m][k], acc[ai][bj][m][n], 0, 0, 0); } __builtin_amdgcn_s_setprio(0); } while (0)
#define PG8_WAIT_V(n) asm volatile("s_waitcnt vmcnt(" #n ")" ::: "memory")
#define PG8_WAIT_L(n) asm volatile("s_waitcnt lgkmcnt(" #n ")" ::: "memory")
#define PG8_BAR __builtin_amdgcn_s_barrier()
#define PG8_SCHED __builtin_amdgcn_sched_barrier(0)
    Unit cur, nxt; int ui = 0;
    if (!S.next(0, cur)) return;
    f32x4 acc[2][2][4][2];
#pragma unroll
    for (int a = 0; a < 2; ++a)
#pragma unroll
        for (int b = 0; b < 2; ++b)
#pragma unroll
            for (int m = 0; m < 4; ++m)
#pragma unroll
                for (int n = 0; n < 2; ++n) acc[a][b][m][n] = (f32x4){0.f, 0.f, 0.f, 0.f};
    bf16x8 At[4][2], B0[2][2], B1[2][2]; pg8_v8i At8[4], B08[2], B18[2];
    const char* cA = (const char*)g.A + (size_t)cur.pm * tstep; const char* cB = (const char*)g.Bt + (size_t)cur.pn * tstep;
    S.a_ready(cur);
    if constexpr (SP2) {
        PG8_STAGE(PG8_SB(0, 0), cB, voffB); PG8_STAGE(PG8_SB(0, 1), cB + hstep, voffB); PG8_STAGE(PG8_SA(0, 0), cA, voffA); PG8_STAGE(PG8_SA(0, 1), cA + hstep, voffA);
        if (wr == 1) PG8_BAR;
        PG8_WAIT_V(2); PG8_BAR;
        PG8_STAGE(PG8_SB(1, 0), cB + kstep, voffB); PG8_STAGE(PG8_SA(1, 0), cA + kstep, voffA); PG8_STAGE(PG8_SB(1, 1), cB + hstep + kstep, voffB);
        PG8_WAIT_V(6); PG8_BAR;
    } else {
        PG8_STAGE(PG8_SB(0, 0), cB, voffB); PG8_STAGE(PG8_SA(0, 0), cA, voffA); PG8_STAGE(PG8_SB(0, 1), cB + hstep, voffB); PG8_STAGE(PG8_SA(0, 1), cA + hstep, voffA);
        if (wr == 1) PG8_BAR;
        PG8_WAIT_V(4); PG8_BAR;
        PG8_STAGE(PG8_SB(1, 0), cB + kstep, voffB); PG8_STAGE(PG8_SA(1, 0), cA + kstep, voffA); PG8_STAGE(PG8_SB(1, 1), cB + hstep + kstep, voffB);
        PG8_WAIT_V(6); PG8_BAR;
    }
    for (;;) {
        const bool has_next = S.next(ui + 1, nxt);
        const char* nA = has_next ? (const char*)g.A + (size_t)nxt.pm * tstep : cA; const char* nB = has_next ? (const char*)g.Bt + (size_t)nxt.pn * tstep : cB;
        constexpr int NPART = Epi::HAS_MID ? 2 : 1; const int tpp = nt / NPART;
        for (int part = 0; part < NPART; ++part) {
        if constexpr (Epi::HAS_MID) { if (part == 1) { if constexpr (FP8) asm volatile("s_nop 15\n\ts_nop 15\n\ts_nop 15\n\ts_nop 15" ::: "memory"); E.mid(acc, cur, wr, wc, fr, fq); } }
        for (int t = part * tpp; t < (part + 1) * tpp; t += 2) {
            const bool last = (t == nt - 2);
            const char* a1 = cA + (size_t)(t + 1) * kstep;
            const char* a2 = last ? nA : cA + (size_t)(t + 2) * kstep; const char* b2 = last ? nB : cB + (size_t)(t + 2) * kstep;
            const char* a3 = a2 + kstep; const char* b3 = b2 + kstep;
            if (last && has_next) S.a_ready(nxt);
            if constexpr (SP2) {
            PG8_LDB(B0, 0, 0); PG8_LDB(B1, 0, 1); PG8_SCHED; PG8_LDA(At, 0, 0); PG8_STAGE(PG8_SA(1, 1), a1 + hstep, voffA);
            PG8_WAIT_V(8); PG8_WAIT_L(0); PG8_BAR; PG8_MMA(0, 0, At, B0); PG8_MMA(0, 1, At, B1); PG8_BAR; PG8_SCHED;
            PG8_LDA(At, 0, 1); PG8_STAGE(PG8_SB(0, 0), b2, voffB); PG8_STAGE(PG8_SB(0, 1), b2 + hstep, voffB); PG8_STAGE(PG8_SA(0, 0), a2, voffA);
            PG8_WAIT_V(8); PG8_WAIT_L(0); PG8_BAR; PG8_MMA(1, 0, At, B0); PG8_MMA(1, 1, At, B1); PG8_BAR; PG8_SCHED;
            PG8_LDB(B0, 1, 0); PG8_LDB(B1, 1, 1); PG8_SCHED; PG8_LDA(At, 1, 0); PG8_STAGE(PG8_SA(0, 1), a2 + hstep, voffA);
            PG8_WAIT_V(8); PG8_WAIT_L(0); PG8_BAR; PG8_MMA(0, 0, At, B0); PG8_MMA(0, 1, At, B1); PG8_BAR; PG8_SCHED;
            PG8_LDA(At, 1, 1); PG8_STAGE(PG8_SB(1, 0), b3, voffB); PG8_STAGE(PG8_SB(1, 1), b3 + hstep, voffB); PG8_STAGE(PG8_SA(1, 0), a3, voffA);
            PG8_WAIT_V(8); PG8_WAIT_L(0); PG8_BAR; PG8_MMA(1, 0, At, B0); PG8_MMA(1, 1, At, B1); PG8_BAR; PG8_SCHED;
            } else {
            PG8_LDB(B0, 0, 0); PG8_SCHED; PG8_LDA(At, 0, 0); PG8_STAGE(PG8_SA(1, 1), a1 + hstep, voffA);
            PG8_WAIT_L(8); PG8_BAR; PG8_WAIT_L(0); PG8_MMA(0, 0, At, B0); PG8_BAR; PG8_SCHED;
            PG8_LDB(B1, 0, 1); PG8_STAGE(PG8_SB(0, 0), b2, voffB);
            PG8_BAR; PG8_WAIT_L(0); PG8_MMA(0, 1, At, B1); PG8_BAR;
            PG8_LDA(At, 0, 1); PG8_STAGE(PG8_SA(0, 0), a2, voffA);
            PG8_BAR; PG8_WAIT_L(0); PG8_MMA(1, 0, At, B0); PG8_BAR; PG8_SCHED;
            PG8_STAGE(PG8_SB(0, 1), b2 + hstep, voffB);
            PG8_WAIT_V(6); PG8_BAR; PG8_MMA(1, 1, At, B1); PG8_BAR;
            PG8_LDB(B0, 1, 0); PG8_SCHED; PG8_LDA(At, 1, 0); PG8_STAGE(PG8_SA(0, 1), a2 + hstep, voffA);
            PG8_WAIT_L(8); PG8_BAR; PG8_WAIT_L(0); PG8_MMA(0, 0, At, B0); PG8_BAR; PG8_SCHED;
            PG8_LDB(B1, 1, 1); PG8_STAGE(PG8_SB(1, 0), b3, voffB);
            PG8_BAR; PG8_WAIT_L(0); PG8_MMA(0, 1, At, B1); PG8_BAR;
            PG8_LDA(At, 1, 1); PG8_STAGE(PG8_SA(1, 0), a3, voffA);
            PG8_BAR; PG8_WAIT_L(0); PG8_MMA(1, 0, At, B0); PG8_BAR; PG8_SCHED;
            PG8_STAGE(PG8_SB(1, 1), b3 + hstep, voffB);
            PG8_WAIT_V(6); PG8_BAR; PG8_MMA(1, 1, At, B1); PG8_BAR;
            }
        }
        }
        if constexpr (FP8) asm volatile("s_nop 15\n\ts_nop 15\n\ts_nop 15\n\ts_nop 15" ::: "memory");
        if constexpr (ALIGN_EPI) { if (wr == 0) PG8_BAR; }
        if constexpr (!Epi::AFTER_DRAIN) { E(acc, cur, wr, wc, fr, fq); S.done(cur); }
        if (!has_next) break;
#pragma unroll
        for (int a = 0; a < 2; ++a)
#pragma unroll
            for (int b = 0; b < 2; ++b)
#pragma unroll
                for (int m = 0; m < 4; ++m)
#pragma unroll
                    for (int n = 0; n < 2; ++n) acc[a][b][m][n] = (f32x4){0.f, 0.f, 0.f, 0.f};
        cur = nxt; cA = nA; cB = nB; ++ui;
        if constexpr (ALIGN_EPI) { if (wr == 1) PG8_BAR; }
    }
    PG8_WAIT_V(0);
    if constexpr (!ALIGN_EPI) { if (wr == 0) PG8_BAR; }
    PG8_BAR;
    if constexpr (Epi::AFTER_DRAIN) { E.fused(acc, cur, wr, wc, fr, fq, lds, wid, lane); S.done(cur); }
#undef PG8_SA
#undef PG8_SB
#undef PG8_STAGE
#undef PG8_LDA
#undef PG8_LDB
#undef PG8_MMA
#undef PG8_WAIT_V
#undef PG8_WAIT_L
#undef PG8_BAR
#undef PG8_SCHED
}
}
namespace att {
using bf16 = __hip_bfloat16;
constexpr int   D = 128, NW = 8, QBLK = 32, KVBLK = 64;
constexpr float QK8 = 0.35709534f;
constexpr float THR2 = 4.3f;
constexpr float V8 = 32.f;
constexpr int VTS = 4 * 8192;
constexpr int SDEPTH = 2;
constexpr int LDQ = 2048, LDK = 512;
constexpr size_t SHM_V = KVBLK * D, SHM_K = KVBLK * D, NBUF = 6, SHM_ATTN = NBUF * SHM_V + NBUF * SHM_K + NW * 64 * 4;
typedef int v4i_t __attribute__((ext_vector_type(4))); typedef int v8i_t __attribute__((ext_vector_type(8)));
using bf16x8 = __attribute__((ext_vector_type(8))) short;
using s16x4  = __attribute__((ext_vector_type(4))) short;
using f32x16 = __attribute__((ext_vector_type(16))) float;
using f32x8  = __attribute__((ext_vector_type(8))) float;
using u32x4  = __attribute__((ext_vector_type(4))) unsigned;
#define KSWZ(row, colB) ((row) * 256 + ((colB) ^ (((row) & 7) << 4)))
#define SBAR() __builtin_amdgcn_sched_barrier(0)
__device__ __forceinline__ int crow(int r, int hi) { return (r & 3) + 8 * (r >> 2) + 4 * hi; }
__device__ __forceinline__ unsigned cvtpk(float lo, float hi) {
  unsigned r; asm volatile("v_cvt_pk_bf16_f32 %0, %1, %2" : "=v"(r) : "v"(lo), "v"(hi)); return r;
}
template <typename TIn> struct Stage;
template <> struct Stage<bf16>  { using T = bf16x8;
  __device__ static __forceinline__ T ld8(const bf16* p) { return *reinterpret_cast<const bf16x8*>(p); }
  __device__ static __forceinline__ bf16x8 tobf(T x) { return x; } };
template <> struct Stage<float> { using T = f32x8;
  __device__ static __forceinline__ T ld8(const float* p) { return *reinterpret_cast<const f32x8*>(p); }
  __device__ static __forceinline__ bf16x8 tobf(T x) {
    u32x4 w = {cvtpk(x[0], x[1]), cvtpk(x[2], x[3]), cvtpk(x[4], x[5]), cvtpk(x[6], x[7])}; return *reinterpret_cast<bf16x8*>(&w); } };

__device__ __forceinline__ void partialSM(f32x16& p0, f32x16& p1, f32x16& negm, float& alpha, bool first) {
  float pmax = p0[0]; for (int r = 1; r < 16; ++r) pmax = fmaxf(pmax, p0[r]); for (int r = 0; r < 16; ++r) pmax = fmaxf(pmax, p1[r]);
  { auto rr = __builtin_amdgcn_permlane32_swap(__float_as_uint(pmax), __float_as_uint(pmax), false, false);
    pmax = fmaxf(__uint_as_float(rr[0]), __uint_as_float(rr[1])); }
  if (__builtin_expect(!first && __all(pmax <= THR2 + 4.f), 1)) alpha = 1.f;
  else { const float delta = first ? pmax - 4.f : fmaxf(pmax - 4.f, 0.f);
    alpha = __builtin_amdgcn_exp2f(-delta);
    for (int r = 0; r < 16; ++r) { p0[r] -= delta; p1[r] -= delta; negm[r] -= delta; } }
  for (int r = 0; r < 16; ++r) p0[r] = __builtin_amdgcn_exp2f(p0[r]);
}
__device__ __forceinline__ void finishSM(f32x16& p0, f32x16& p1, float alpha, float& l_reg, v8i_t& pa) {
  for (int r = 0; r < 16; ++r) p1[r] = __builtin_amdgcn_exp2f(p1[r]);
  float ps = 0; for (int r = 0; r < 16; ++r) ps += p0[r]; for (int r = 0; r < 16; ++r) ps += p1[r];
  { auto rr = __builtin_amdgcn_permlane32_swap(__float_as_uint(ps), __float_as_uint(ps), false, false);
    ps = __uint_as_float(rr[0]) + __uint_as_float(rr[1]); }
  l_reg = l_reg * alpha + ps;
#pragma unroll
  for (int i = 0; i < 4; ++i) { int w = 0; w = __builtin_amdgcn_cvt_pk_fp8_f32(p0[4 * i], p0[4 * i + 1], w, false); w = __builtin_amdgcn_cvt_pk_fp8_f32(p0[4 * i + 2], p0[4 * i + 3], w, true); pa[i] = w;
    int x = 0; x = __builtin_amdgcn_cvt_pk_fp8_f32(p1[4 * i], p1[4 * i + 1], x, false); x = __builtin_amdgcn_cvt_pk_fp8_f32(p1[4 * i + 2], p1[4 * i + 3], x, true); pa[4 + i] = x; }
}
__device__ __forceinline__ void qkt(f32x16& p0, f32x16& p1, const char* Ks, const v8i_t* qr, const f32x16& negm, int r32, int hi) {
  const int sw = r32 & 7;
  const char* k0 = Ks + r32 * 128; const char* k1 = Ks + (32 + r32) * 128;
  { v8i_t a0, a1;
    a0.lo = *reinterpret_cast<const v4i_t*>(k0 + (((2 * hi) ^ sw) << 4)); a0.hi = *reinterpret_cast<const v4i_t*>(k0 + (((2 * hi + 1) ^ sw) << 4));
    a1.lo = *reinterpret_cast<const v4i_t*>(k1 + (((2 * hi) ^ sw) << 4)); a1.hi = *reinterpret_cast<const v4i_t*>(k1 + (((2 * hi + 1) ^ sw) << 4));
    p0 = __builtin_amdgcn_mfma_scale_f32_32x32x64_f8f6f4(a0, qr[0], negm, 0, 0, 0, 0x7F7F7F7F, 0, 0x7F7F7F7F);
    p1 = __builtin_amdgcn_mfma_scale_f32_32x32x64_f8f6f4(a1, qr[0], negm, 0, 0, 0, 0x7F7F7F7F, 0, 0x7F7F7F7F); }
  SBAR();
  { v8i_t b0, b1;
    b0.lo = *reinterpret_cast<const v4i_t*>(k0 + (((4 + 2 * hi) ^ sw) << 4)); b0.hi = *reinterpret_cast<const v4i_t*>(k0 + (((5 + 2 * hi) ^ sw) << 4));
    b1.lo = *reinterpret_cast<const v4i_t*>(k1 + (((4 + 2 * hi) ^ sw) << 4)); b1.hi = *reinterpret_cast<const v4i_t*>(k1 + (((5 + 2 * hi) ^ sw) << 4));
    p0 = __builtin_amdgcn_mfma_scale_f32_32x32x64_f8f6f4(b0, qr[1], p0, 0, 0, 0, 0x7F7F7F7F, 0, 0x7F7F7F7F);
    p1 = __builtin_amdgcn_mfma_scale_f32_32x32x64_f8f6f4(b1, qr[1], p1, 0, 0, 0, 0x7F7F7F7F, 0, 0x7F7F7F7F); }
}
__device__ __forceinline__ void pv_d0(f32x16* o, const char* Vs, const v8i_t& pa, int r32, int hi) {
  const int sw = (r32 >> 2) & 3;
#pragma unroll
  for (int db = 0; db < 4; ++db) { const char* row = Vs + (db * 32 + r32) * 64; v8i_t b;
    b.lo = *reinterpret_cast<const v4i_t*>(row + (((2 * hi) ^ sw) << 4)); b.hi = *reinterpret_cast<const v4i_t*>(row + (((2 * hi + 1) ^ sw) << 4));
    o[db] = __builtin_amdgcn_mfma_scale_f32_32x32x64_f8f6f4(pa, b, o[db], 0, 0, 0, 0x7F7F7F7F, 0, 0x7F7F7F7F); }
}

__device__ __forceinline__ int undef_i() { int w; asm volatile("" : "=v"(w)); return w; }
#define ATT_MFMA(a_, b_, c_) __builtin_amdgcn_mfma_scale_f32_32x32x64_f8f6f4(a_, b_, c_, 0, 0, 0, 0x7F7F7F7F, 0, 0x7F7F7F7F)
#ifndef ATT_PLIM
#define ATT_PLIM 448.f
#endif
template <bool HASN>
__device__ __forceinline__ void att_redo(f32x16& pO0, f32x16& pO1, f32x16& pN0, f32x16& pN1, f32x16* o, f32x16& negm, float& l_reg, float& ps_lane, float* al_l, int r32, int hi) {
  float pmax = pO0[0];
#pragma unroll
  for (int r = 1; r < 16; ++r) pmax = fmaxf(pmax, pO0[r]);
#pragma unroll
  for (int r = 0; r < 16; ++r) pmax = fmaxf(pmax, pO1[r]);
  { auto rr = __builtin_amdgcn_permlane32_swap(__float_as_uint(pmax), __float_as_uint(pmax), false, false); pmax = fmaxf(__uint_as_float(rr[0]), __uint_as_float(rr[1])); }
  const float delta = fmaxf(__builtin_amdgcn_logf(pmax) - 4.f, 0.f), alpha = __builtin_amdgcn_exp2f(-delta);
#pragma unroll
  for (int r = 0; r < 16; ++r) { pO0[r] *= alpha; pO1[r] *= alpha; negm[r] -= delta; }
  if constexpr (HASN) {
#pragma unroll
    for (int r = 0; r < 16; ++r) { pN0[r] -= delta; pN1[r] -= delta; } }
  ps_lane *= alpha; l_reg *= alpha;
  if (hi == 0) al_l[r32] = alpha; asm volatile("s_waitcnt lgkmcnt(0)" ::: "memory");
#pragma unroll
  for (int d = 0; d < 4; ++d)
#pragma unroll
    for (int r = 0; r < 16; ++r) o[d][r] *= al_l[crow(r, hi)];
}
__device__ __forceinline__ void att_pack(const f32x16& p0, const f32x16& p1, v8i_t& pa) {
#pragma unroll
  for (int i = 0; i < 4; ++i) { int w = undef_i(); w = __builtin_amdgcn_cvt_pk_fp8_f32(p0[4 * i], p0[4 * i + 1], w, false); w = __builtin_amdgcn_cvt_pk_fp8_f32(p0[4 * i + 2], p0[4 * i + 3], w, true); pa[i] = w;
    int x = undef_i(); x = __builtin_amdgcn_cvt_pk_fp8_f32(p1[4 * i], p1[4 * i + 1], x, false); x = __builtin_amdgcn_cvt_pk_fp8_f32(p1[4 * i + 2], p1[4 * i + 3], x, true); pa[4 + i] = x; }
}
__device__ __forceinline__ void att_step(f32x16& pN0, f32x16& pN1, f32x16& pO0, f32x16& pO1, f32x16* o, const v8i_t* qr, f32x16& negm, float& l_reg,
                                         const char* Ks, const char* KsO, const char* Vs, float* al_l, int r32, int hi) {
  v8i_t a0, a1, b0, b1, pa;
  { const int sw = r32 & 7; const char* k0 = Ks + r32 * 128; const char* k1 = Ks + (32 + r32) * 128;
    a0.lo = *reinterpret_cast<const v4i_t*>(k0 + (((2 * hi) ^ sw) << 4)); a0.hi = *reinterpret_cast<const v4i_t*>(k0 + (((2 * hi + 1) ^ sw) << 4));
    a1.lo = *reinterpret_cast<const v4i_t*>(k1 + (((2 * hi) ^ sw) << 4)); a1.hi = *reinterpret_cast<const v4i_t*>(k1 + (((2 * hi + 1) ^ sw) << 4));
    b0.lo = *reinterpret_cast<const v4i_t*>(k0 + (((4 + 2 * hi) ^ sw) << 4)); b0.hi = *reinterpret_cast<const v4i_t*>(k0 + (((5 + 2 * hi) ^ sw) << 4));
    b1.lo = *reinterpret_cast<const v4i_t*>(k1 + (((4 + 2 * hi) ^ sw) << 4)); b1.hi = *reinterpret_cast<const v4i_t*>(k1 + (((5 + 2 * hi) ^ sw) << 4)); }
  SBAR();
#pragma unroll
  for (int r = 0; r < 16; ++r) pO1[r] = __builtin_amdgcn_exp2f(pO1[r]);
  SBAR();
  pN0 = ATT_MFMA(a0, qr[0], negm); SBAR();
  float s0 = pO0[0], s1 = pO0[1], s2 = pO0[2], s3 = pO0[3];
  s0 += pO0[4]; s1 += pO0[5]; s2 += pO0[6]; s3 += pO0[7]; s0 += pO0[8]; s1 += pO0[9]; s2 += pO0[10]; s3 += pO0[11]; s0 += pO0[12]; s1 += pO0[13]; s2 += pO0[14]; s3 += pO0[15];
  SBAR();
  pN1 = ATT_MFMA(a1, qr[0], negm); SBAR();
  s0 += pO1[0]; s1 += pO1[1]; s2 += pO1[2]; s3 += pO1[3]; s0 += pO1[4]; s1 += pO1[5]; s2 += pO1[6]; s3 += pO1[7]; s0 += pO1[8]; s1 += pO1[9]; s2 += pO1[10]; s3 += pO1[11];
  SBAR();
  pN0 = ATT_MFMA(b0, qr[1], pN0); SBAR();
  s0 += pO1[12]; s1 += pO1[13]; s2 += pO1[14]; s3 += pO1[15];
  float ps_lane = (s0 + s1) + (s2 + s3);
  if (__builtin_expect(__any(!(ps_lane <= ATT_PLIM)), 0)) att_redo<true>(pO0, pO1, pN0, pN1, o, negm, l_reg, ps_lane, al_l, r32, hi);
  { auto rr = __builtin_amdgcn_permlane32_swap(__float_as_uint(ps_lane), __float_as_uint(ps_lane), false, false);
    l_reg += __uint_as_float(rr[0]) + __uint_as_float(rr[1]); }
#pragma unroll
  for (int i = 0; i < 4; ++i) { int w = undef_i(); w = __builtin_amdgcn_cvt_pk_fp8_f32(pO0[4 * i], pO0[4 * i + 1], w, false); w = __builtin_amdgcn_cvt_pk_fp8_f32(pO0[4 * i + 2], pO0[4 * i + 3], w, true); pa[i] = w; }
  SBAR();
  pN1 = ATT_MFMA(b1, qr[1], pN1); SBAR();
#pragma unroll
  for (int i = 0; i < 4; ++i) { int x = undef_i(); x = __builtin_amdgcn_cvt_pk_fp8_f32(pO1[4 * i], pO1[4 * i + 1], x, false); x = __builtin_amdgcn_cvt_pk_fp8_f32(pO1[4 * i + 2], pO1[4 * i + 3], x, true); pa[4 + i] = x; }
  asm volatile("" : "+v"(pa));
  v8i_t vb[4];
  { const int sw = (r32 >> 2) & 3;
#pragma unroll
    for (int db = 0; db < 4; ++db) { const char* row = Vs + (db * 32 + r32) * 64;
      vb[db].lo = *reinterpret_cast<const v4i_t*>(row + (((2 * hi) ^ sw) << 4)); vb[db].hi = *reinterpret_cast<const v4i_t*>(row + (((2 * hi + 1) ^ sw) << 4)); } }
  SBAR();
#pragma unroll
  for (int db = 0; db < 4; ++db) {
    o[db] = ATT_MFMA(pa, vb[db], o[db]); SBAR();
#pragma unroll
    for (int r = 0; r < 4; ++r) pN0[4 * db + r] = __builtin_amdgcn_exp2f(pN0[4 * db + r]);
    asm volatile("" : "+v"(pN0));
    SBAR(); }
}
__device__ __forceinline__ void att_last(f32x16& pO0, f32x16& pO1, f32x16* o, const v8i_t* qr, f32x16& negm, float& l_reg, const char* KsO, const char* Vs, float* al_l, int r32, int hi) {
  float ps_lane = 0.f; v8i_t pa;
#pragma unroll
  for (int r = 0; r < 16; ++r) { pO1[r] = __builtin_amdgcn_exp2f(pO1[r]); ps_lane += pO0[r] + pO1[r]; }
  if (__builtin_expect(__any(!(ps_lane <= ATT_PLIM)), 0)) att_redo<false>(pO0, pO1, pO0, pO1, o, negm, l_reg, ps_lane, al_l, r32, hi);
  { auto rr = __builtin_amdgcn_permlane32_swap(__float_as_uint(ps_lane), __float_as_uint(ps_lane), false, false);
    l_reg += __uint_as_float(rr[0]) + __uint_as_float(rr[1]); }
  att_pack(pO0, pO1, pa); SBAR();
  pv_d0(o, Vs, pa, r32, hi);
}

__device__ __forceinline__ void attn_dense_body(const unsigned char* __restrict__ Qb, const unsigned char* __restrict__ Kh, const unsigned char* __restrict__ Vh, unsigned char* Ob, int ldo, float oscale, int seq, char* lds) {
  int tid = threadIdx.x; asm volatile("" : "+v"(tid));
  const int wid = tid >> 6, lane = tid & 63, r32 = lane & 31, hi = lane >> 5;
  char* V_lds = lds; char* K_lds = lds + NBUF * SHM_V;
  float* ws = (float*)(lds + NBUF * SHM_V + NBUF * SHM_K) + wid * 64; float* li_l = ws; float* al_l = ws + 32;
  float l_reg = 0; f32x16 o[4] = {}; v8i_t qr[2]; f32x16 negm;
#pragma unroll
  for (int r = 0; r < 16; ++r) negm[r] = 4.f;
  const unsigned char* Qw = Qb + (long)(wid * QBLK + r32) * LDQ + hi * 32;
#pragma unroll
  for (int sq = 0; sq < 2; ++sq) { qr[sq].lo = *reinterpret_cast<const v4i_t*>(Qw + sq * 64); qr[sq].hi = *reinterpret_cast<const v4i_t*>(Qw + sq * 64 + 16); }
  const int kkey = tid >> 3, ksrc = (long)kkey * LDK + (((tid & 7) ^ (kkey & 7)) << 4);
  typedef __attribute__((address_space(3))) unsigned lds_u32;
  const unsigned ldsK = (unsigned)(uintptr_t)K_lds + (unsigned)wid * 1024u, ldsV = (unsigned)(uintptr_t)V_lds + (unsigned)wid * 1024u;
#define DMA_TILE(t_, slot_) do { \
    __builtin_amdgcn_global_load_lds((const unsigned*)(Kh + (long)(t_) * KVBLK * LDK + ksrc), (lds_u32*)(uintptr_t)(unsigned)__builtin_amdgcn_readfirstlane((int)(ldsK + (unsigned)(slot_))), 16, 0, 0); \
    __builtin_amdgcn_global_load_lds((const unsigned*)(Vh + (long)(t_) * VTS + tid * 16), (lds_u32*)(uintptr_t)(unsigned)__builtin_amdgcn_readfirstlane((int)(ldsV + (unsigned)(slot_))), 16, 0, 0); } while (0)
#define RESC(a) do { if (__any((a) < 1.f)) { if (hi == 0) al_l[r32] = (a); asm volatile("s_waitcnt lgkmcnt(0)" ::: "memory"); \
    for (int d = 0; d < 4; ++d) for (int r = 0; r < 16; ++r) o[d][r] *= al_l[crow(r, hi)]; } } while (0)
  f32x16 pA0, pA1, pB0, pB1; float alA, alB; v8i_t pa; const int NT = seq / KVBLK;
  int c6 = 1;
#define SL6(d_) ((unsigned)((c6 + (d_) >= 6 ? c6 + (d_) - 6 : c6 + (d_)) << 13))
  DMA_TILE(0, 0); DMA_TILE(1, SHM_K); DMA_TILE(2, 2 * SHM_K); asm volatile("s_waitcnt vmcnt(0)" ::: "memory"); __syncthreads();
  qkt(pA0, pA1, K_lds, qr, negm, r32, hi); partialSM(pA0, pA1, negm, alA, true);
  for (int j = 1; j + 1 < NT; j += 2) {
    DMA_TILE(j + 2, SL6(2)); if (j + 3 < NT) DMA_TILE(j + 3, SL6(3));
    att_step(pB0, pB1, pA0, pA1, o, qr, negm, l_reg, K_lds + SL6(0), K_lds + SL6(5), V_lds + SL6(5), al_l, r32, hi);
    att_step(pA0, pA1, pB0, pB1, o, qr, negm, l_reg, K_lds + SL6(1), K_lds + SL6(0), V_lds + SL6(0), al_l, r32, hi);
    asm volatile("s_waitcnt vmcnt(0)" ::: "memory"); __syncthreads();
    c6 = c6 + 2 >= 6 ? c6 + 2 - 6 : c6 + 2;
  }
  att_step(pB0, pB1, pA0, pA1, o, qr, negm, l_reg, K_lds + SL6(0), K_lds + SL6(5), V_lds + SL6(5), al_l, r32, hi);
  att_last(pB0, pB1, o, qr, negm, l_reg, K_lds + SL6(0), V_lds + SL6(0), al_l, r32, hi);
#undef SL6
  if (hi == 0) li_l[r32] = l_reg; asm volatile("s_waitcnt lgkmcnt(0)" ::: "memory");
  float rli[16];
#pragma unroll
  for (int r = 0; r < 16; ++r) rli[r] = __builtin_amdgcn_rcpf(li_l[crow(r, hi)]) * (1.f / V8);
  __syncthreads();
  { unsigned char* stg = (unsigned char*)(lds + wid * 4096);
#pragma unroll
    for (int r = 0; r < 16; ++r) { const int orow = crow(r, hi);
#pragma unroll
      for (int d0 = 0; d0 < 4; ++d0) { const float v = fminf(fmaxf(o[d0][r] * rli[r] * oscale, -448.f), 448.f); stg[orow * 128 + d0 * 32 + r32] = (unsigned char)__builtin_amdgcn_cvt_pk_fp8_f32(v, v, 0, false); } }
    asm volatile("s_waitcnt lgkmcnt(0)" ::: "memory");
    int rb = (lane >> 3) * 128 + (lane & 7) * 16; asm volatile("" : "+v"(rb));
    const unsigned char* rp = stg + rb;
    unsigned char* op = (unsigned char*)Ob + (long)(wid * QBLK + (rb >> 7)) * ldo + ((rb >> 4) & 7) * 16;
#pragma unroll
    for (int i = 0; i < 4; ++i) { const u32x4 v = *(const u32x4*)(rp + i * 1024); *(u32x4*)op = v; op += 8 * ldo; } }
  __syncthreads();
#undef DMA_TILE
#undef RESC
}
#undef KSWZ
#undef SBAR
}
constexpr int NWAVES = 8;
constexpr int DM = 2048, BATCH = 4, SEQ = 4096, CTXL = 256, NLAT = BATCH * SEQ, NCTX = BATCH * CTXL, MALL = NLAT + NCTX;
constexpr int INW = 13312, KVW = 512, SKV = SEQ + CTXL;
constexpr int C_Q = 0, C_K = 2048, C_V = 2560, C_U = 3072, C_GB = 5120, C_GC = 7168, C_GA = 9216, C_GV = 11264;
constexpr int NEXP = 16384;
constexpr float EPS = 1e-6f;
#ifndef PROBE_GMODE
#define PROBE_GMODE 0
#endif
#ifndef PROBE_DUP
#define PROBE_DUP 0
#endif
#ifndef MK_ONE_LAUNCH
#define MK_ONE_LAUNCH 1
#endif
constexpr int NPH_LAYER = 12, NPH = 3 + 2 * NPH_LAYER;

constexpr size_t MiB = 1u << 20;
constexpr size_t WS_CTL = 0, CTL_ZERO_BYTES = 1 * MiB;
constexpr size_t CTL_MOD = 65536;
constexpr size_t WS_K1B = 1 * MiB, WS_K2B = WS_K1B + 524288;
constexpr size_t WS_WIN = 2 * MiB  , WS_W2 = 106 * MiB, WS_WO = 138 * MiB, WS_WQ = 154 * MiB;
constexpr size_t WS_PU = 170 * MiB, WS_PV = 234 * MiB;
constexpr size_t WS_Q = 300 * MiB;
constexpr float G8_SCALE = 16.f;
constexpr float AT8_SCALE = 32.f, CV8_SCALE = 8.f;
constexpr size_t WS_HS = 299 * MiB;
constexpr float W8_SCALE = 1024.f, MG8_SCALE = 64.f;
constexpr float W8_SCALE_UNUSED = 0.f;
constexpr size_t WS_SU = 298 * MiB, WS_SV = WS_SU + 131072;
constexpr size_t WS_XS = 336 * MiB;
constexpr size_t WS_H = 434 * MiB;
constexpr size_t WS_KB = 502 * MiB, WS_VB = 519 * MiB;
constexpr size_t WS_A2 = 536 * MiB;
constexpr size_t WS_P = 672 * MiB;
constexpr size_t WS_PQ = WS_P, WS_IDX = WS_P + 68 * MiB, WS_GW = WS_P + 80 * MiB;
constexpr size_t WS_MODP = 1114 * MiB;
constexpr size_t WS_END = 1122 * MiB;
constexpr int CW_BAR = 4096;

constexpr int PHASE_LDS = 149504, MISC_OFF = PHASE_LDS, LDS_BYTES = PHASE_LDS + 1024;

#define GAS __attribute__((address_space(1)))
#define LAS __attribute__((address_space(3)))
typedef unsigned short bf16;
typedef unsigned v4u __attribute__((ext_vector_type(4)));
typedef unsigned v2u __attribute__((ext_vector_type(2)));
typedef float v4f __attribute__((ext_vector_type(4)));
typedef __bf16 bf16x2_t __attribute__((ext_vector_type(2)));
#define LDS_WAIT() asm volatile("s_waitcnt lgkmcnt(0)" ::: "memory")
#define VM_WAIT() asm volatile("s_waitcnt vmcnt(0)" ::: "memory")
__device__ __forceinline__ unsigned f2bf(float f) { unsigned u = __builtin_bit_cast(unsigned, f); return (u + 0x7fffu + ((u >> 16) & 1u)) >> 16; }
__device__ __forceinline__ unsigned pk2(float lo, float hi) { return f2bf(lo) | (f2bf(hi) << 16); }
__device__ __forceinline__ float bflo(unsigned w) { return __uint_as_float(w << 16); }
__device__ __forceinline__ float bfhi(unsigned w) { return __uint_as_float(w & 0xffff0000u); }
__device__ __forceinline__ float dot2bf(unsigned a, unsigned b, float c) { return __builtin_amdgcn_fdot2_f32_bf16(__builtin_bit_cast(bf16x2_t, a), __builtin_bit_cast(bf16x2_t, b), c, false); }
template <int CTRL> __device__ __forceinline__ float dppf(float v) { return __builtin_bit_cast(float, __builtin_amdgcn_update_dpp(0, __builtin_bit_cast(int, v), CTRL, 0xF, 0xF, true)); }
template <int CTRL> __device__ __forceinline__ unsigned dppu(unsigned v) { return (unsigned)__builtin_amdgcn_update_dpp(0, (int)v, CTRL, 0xF, 0xF, true); }
constexpr int DPP_X1 = 0xB1, DPP_X2 = 0x4E, DPP_HMIR = 0x141, DPP_MIR = 0x140, DPP_ROR8 = 0x128;
__device__ __forceinline__ float wave_sum(float v) {
#pragma unroll
    for (int o = 1; o < 64; o <<= 1) v += __shfl_xor(v, o);
    return v;
}
__device__ __forceinline__ float sum16(float v) {
    v += dppf<DPP_X1>(v); v += dppf<DPP_X2>(v); v += dppf<DPP_HMIR>(v); v += dppf<DPP_MIR>(v); return v;
}
__device__ __forceinline__ unsigned max32u(unsigned v) {
    v = max(v, dppu<DPP_X1>(v)); v = max(v, dppu<DPP_X2>(v)); v = max(v, dppu<DPP_HMIR>(v)); v = max(v, dppu<DPP_MIR>(v));
    v = max(v, (unsigned)__shfl_xor((int)v, 16)); return v;
}
__device__ __forceinline__ float gelu_erf(float v) {
    const float av = fabsf(v), t = __builtin_amdgcn_rcpf(av * 0.2316418882f + 1.0f);
    float q = t * 0.5307027145f + (-0.7265760135f); q = q * t + 0.7107068705f; q = q * t + (-0.142248368f); q = q * t + 0.127414796f; q = q * t;
    const float e = __builtin_amdgcn_exp2f((v * v) * (-0.72134752044f));
    const float m = v * (q * e); return v < 0.f ? m : v - m;
}
#define XB_TMO      128
#define XB_XCNT(j)  (256  + 64 * (j))
#define XB_XSUB(j)  (1280 + 64 * (j))
#define XB_XGEN(j)  (2304 + 64 * (j))
#define XB_TOP      3328
#define XB_TOPGEN   3392
#define XCD_BAR_WORDS 3456
#define XB_SPIN_CAP (1u << 18)

__device__ __forceinline__ unsigned xb_ld(unsigned* p)              { return __hip_atomic_load(p, __ATOMIC_RELAXED, __HIP_MEMORY_SCOPE_AGENT); }
__device__ __forceinline__ unsigned xb_add(unsigned* p, unsigned v) { return __hip_atomic_fetch_add(p, v, __ATOMIC_RELAXED, __HIP_MEMORY_SCOPE_AGENT); }
__device__ __forceinline__ unsigned xb_xcc_id() { return (unsigned)__builtin_amdgcn_s_getreg((3 << 11) | 20) & 0xFu; }
#define XB_SPIN(cond, bar) do { unsigned _sp = 0; while (cond) { __builtin_amdgcn_s_sleep(1); \
    if ((++_sp & 255u) == 0u) { if (xb_ld(&(bar)[XB_TMO])) break; if (_sp > XB_SPIN_CAP) { atomicAdd(&(bar)[XB_TMO], 1u); break; } } } } while (0)

struct XcdBarrier {
    unsigned* bar; unsigned x;
    volatile LAS unsigned* st;
};

__device__ __forceinline__ XcdBarrier xcd_barrier_post(unsigned* bar, volatile LAS unsigned* st) {
    XcdBarrier b; b.bar = bar; b.x = xb_xcc_id(); b.st = st;
    if (threadIdx.x == 0) (void)xb_add(&bar[XB_XCNT(b.x)], 1u);
    return b;
}
__device__ __forceinline__ void xcd_barrier_complete(unsigned* bar, unsigned x, unsigned& nloc, unsigned& nx) {
    const unsigned G = gridDim.x * gridDim.y * gridDim.z;
    unsigned sum, cnt, mine, sp = 0u;
    for (;;) {
        sum = 0u; cnt = 0u; mine = 0u;
#pragma unroll
        for (unsigned j = 0; j < 16; ++j) { const unsigned c = xb_ld(&bar[XB_XCNT(j)]); sum += c; cnt += (c > 0u) ? 1u : 0u; mine = (j == x) ? c : mine; }
        if (sum == G) break;
        __builtin_amdgcn_s_sleep(1);
        if ((++sp & 255u) == 0u) { if (xb_ld(&bar[XB_TMO])) break; if (sp > XB_SPIN_CAP) { atomicAdd(&bar[XB_TMO], 1u); break; } }
    }
    nloc = mine > 0u ? mine : 1u; nx = cnt > 0u ? cnt : 1u;
}

__device__ __forceinline__ void xcd_barrier(const XcdBarrier& b) {
    asm volatile("s_waitcnt vmcnt(0)" ::: "memory");
    __syncthreads();
    if (threadIdx.x == 0) {
        unsigned* bar = b.bar;
        __builtin_amdgcn_s_waitcnt(0);
        unsigned nloc = b.st[0], nx = b.st[1];
        if (nloc == 0u) { xcd_barrier_complete(bar, b.x, nloc, nx); b.st[0] = nloc; b.st[1] = nx; }
        const unsigned old = xb_add(&bar[XB_XSUB(b.x)], 1u);
        const unsigned gen = old / nloc;
        if (old + 1u == (gen + 1u) * nloc) {
            __builtin_amdgcn_fence(__ATOMIC_RELEASE, "agent");
            asm volatile("s_waitcnt vmcnt(0)" ::: "memory");
            const unsigned og = xb_add(&bar[XB_TOP], 1u);
            const unsigned tg = og / nx;
            if (og + 1u == (tg + 1u) * nx) xb_add(&bar[XB_TOPGEN], 1u);
            else XB_SPIN(xb_ld(&bar[XB_TOPGEN]) == tg, bar);
            __builtin_amdgcn_fence(__ATOMIC_ACQUIRE, "agent");
            xb_add(&bar[XB_XGEN(b.x)], 1u);
            asm volatile("s_waitcnt vmcnt(0)" ::: "memory");
        } else {
            XB_SPIN(xb_ld(&bar[XB_XGEN(b.x)]) == gen, bar);
            __builtin_amdgcn_fence(__ATOMIC_ACQUIRE, "agent");
            asm volatile("s_waitcnt vmcnt(0)" ::: "memory");
        }
    }
    __syncthreads();
}
struct Frame {
    LAS unsigned char* lds; unsigned char* ldsg;
    int tid, lane, wave, vcu, G, gw, NGW;
    const float *x, *c, *ctx, *c_ctx, *ada_w, *ada_b, *norm1_g, *norm2_g, *w_in, *b_gate, *q_norm_g, *k_norm_g, *conv_w, *w_ao, *w_co, *w_o, *peer_wq, *peer_k1, *peer_k2, *peer_u, *peer_v, *final_g;
    float* out; unsigned char* ws;
    float* mod;
};

__device__ __forceinline__ void frame_refresh(Frame& F) {
    int tid = threadIdx.x; asm volatile("" : "+v"(tid));
    F.tid = tid; F.lane = tid & 63; F.wave = __builtin_amdgcn_readfirstlane(tid >> 6);
    int bx = blockIdx.x; asm volatile("" : "+s"(bx));
    F.vcu = (F.G % 8 == 0) ? (bx % 8) * (F.G / 8) + bx / 8 : bx;
    F.gw = F.vcu * NWAVES + F.wave; F.NGW = F.G * NWAVES;
}
__device__ __forceinline__ void p0_transpose_item(const float* W, int N, bf16* WT, int ldk, int koff, LAS float* scr, int item, int lane) {
    const int nblk = N / 32, kb = item / nblk, nb = item % nblk, k0 = 64 * kb, n0 = 32 * nb;
#pragma unroll 8
    for (int i = 0; i < 32; ++i) { const int kk = 2 * i + (lane >> 5); scr[kk * 33 + (lane & 31)] = W[(size_t)(k0 + kk) * N + n0 + (lane & 31)]; }
    LDS_WAIT(); asm volatile("" ::: "memory");
    const int c = lane & 7;
#pragma unroll
    for (int j = 0; j < 4; ++j) { const int n = (lane >> 3) + 8 * j; const LAS float* s = scr + (8 * c) * 33 + n;
        v4u o; o.x = pk2(s[0 * 33], s[1 * 33]); o.y = pk2(s[2 * 33], s[3 * 33]); o.z = pk2(s[4 * 33], s[5 * 33]); o.w = pk2(s[6 * 33], s[7 * 33]);
        *(GAS v4u*)(WT + (size_t)(n0 + n) * ldk + koff + k0 + 8 * c) = o; }
    LDS_WAIT(); asm volatile("" ::: "memory");
}
__device__ __forceinline__ void p0_transpose_item8(const float* W, int N, unsigned char* WT, int ldk, LAS float* scr, int item, int lane) {
    const int nblk = N / 32, kb = item / nblk, nb = item % nblk, k0 = 64 * kb, n0 = 32 * nb;
#pragma unroll 8
    for (int i = 0; i < 32; ++i) { const int kk = 2 * i + (lane >> 5); scr[kk * 33 + (lane & 31)] = W[(size_t)(k0 + kk) * N + n0 + (lane & 31)]; }
    LDS_WAIT(); asm volatile("" ::: "memory");
    const int c = lane & 7;
#pragma unroll
    for (int j = 0; j < 4; ++j) { const int n = (lane >> 3) + 8 * j; const LAS float* s = scr + (8 * c) * 33 + n; float f[8];
#pragma unroll
        for (int i = 0; i < 8; ++i) f[i] = fminf(fmaxf(s[i * 33] * W8_SCALE, -448.f), 448.f);
        int w0 = 0, w1 = 0; w0 = __builtin_amdgcn_cvt_pk_fp8_f32(f[0], f[1], w0, false); w0 = __builtin_amdgcn_cvt_pk_fp8_f32(f[2], f[3], w0, true);
        w1 = __builtin_amdgcn_cvt_pk_fp8_f32(f[4], f[5], w1, false); w1 = __builtin_amdgcn_cvt_pk_fp8_f32(f[6], f[7], w1, true);
        v2u o; o.x = (unsigned)w0; o.y = (unsigned)w1; *(GAS v2u*)(WT + (size_t)(n0 + n) * ldk + k0 + 8 * c) = o; }
    LDS_WAIT(); asm volatile("" ::: "memory");
}
__device__ __forceinline__ void p0_cvt_item(const float* src, bf16* dst, size_t item, int lane) {
    const float* s = src + item * 4096 + lane * 8; bf16* d = dst + item * 4096 + lane * 8;
#pragma unroll
    for (int j = 0; j < 8; ++j) { const v4f a = *(const GAS v4f*)(s + j * 512), b = *(const GAS v4f*)(s + j * 512 + 4);
        v4u o; o.x = pk2(a.x, a.y); o.y = pk2(a.z, a.w); o.z = pk2(b.x, b.y); o.w = pk2(b.z, b.w); *(GAS v4u*)(d + j * 512) = o; }
}
__device__ __forceinline__ void p0_fp8_row(const float* src, unsigned char* dst, float* scale, int lane) {
    const GAS v4f* xr = (const GAS v4f*)src + lane; v4f v[8]; float am = 0.f;
#pragma unroll
    for (int j = 0; j < 8; ++j) { v[j] = xr[64 * j]; am = fmaxf(am, fmaxf(fmaxf(fabsf(v[j].x), fabsf(v[j].y)), fmaxf(fabsf(v[j].z), fabsf(v[j].w)))); }
#pragma unroll
    for (int o = 1; o < 64; o <<= 1) am = fmaxf(am, __shfl_xor(am, o));
    const float inv = am > 0.f ? 448.f / am : 0.f;
    if (lane == 0) *scale = am * (1.f / 448.f);
#pragma unroll
    for (int j = 0; j < 8; ++j) { int w = 0; w = __builtin_amdgcn_cvt_pk_fp8_f32(v[j].x * inv, v[j].y * inv, w, false); w = __builtin_amdgcn_cvt_pk_fp8_f32(v[j].z * inv, v[j].w * inv, w, true);
        *(GAS int*)(dst + (size_t)(2 * j + (lane >> 5)) * ((size_t)16384 * 128) + 4 * (lane & 31)) = w; }
}
__device__ __forceinline__ void p0_ada_item(Frame& F, const LAS float* sl, int item) {
    const int kc = item & 15, nb = (item >> 4) % 48, l = item / (16 * 48);
    const float* W = F.ada_w + ((size_t)l * DM + kc * 128) * 12288 + nb * 256 + F.lane * 4;
    v4f acc[5];
#pragma unroll
    for (int r = 0; r < 5; ++r) acc[r] = (v4f){0.f, 0.f, 0.f, 0.f};
#pragma unroll 4
    for (int k = 0; k < 128; ++k) { const v4f w = *(const GAS v4f*)(W + (size_t)k * 12288);
#pragma unroll
        for (int r = 0; r < 5; ++r) acc[r] += w * sl[r * DM + kc * 128 + k]; }
    float* m = (float*)(F.ws + WS_MODP) + ((size_t)kc * 2 + l) * 5 * 12288 + nb * 256 + F.lane * 4;
#pragma unroll
    for (int r = 0; r < 5; ++r) *(GAS v4f*)(m + r * 12288) = acc[r];
}
__device__ __forceinline__ void mod_reduce_phase(Frame& F) {
    frame_refresh(F);
    const float* mp = (const float*)(F.ws + WS_MODP);
    for (int i = F.gw * 64 + F.lane; i < 2 * 5 * 12288 / 4; i += F.NGW * 64) { v4f s = (v4f){0.f, 0.f, 0.f, 0.f};
#pragma unroll
        for (int kc = 0; kc < 16; ++kc) s += *(const GAS v4f*)(mp + (size_t)kc * 2 * 5 * 12288 + (size_t)i * 4);
        *(GAS v4f*)(F.mod + (size_t)i * 4) = s; }
}
__device__ __forceinline__ void p0_prologue(Frame& F) {
    frame_refresh(F);
    LAS float* scr = (LAS float*)(F.lds + F.wave * 9216);
    LAS float* sl = (LAS float*)(F.lds + 8 * 9216);
    for (int i = F.tid; i < 5 * DM; i += NWAVES * 64) { const float v = (i < 4 * DM) ? F.c[i] : F.c_ctx[i - 4 * DM]; sl[i] = v / (1.f + __expf(-v)); }
    __syncthreads();
    constexpr int I_ADA = 2 * 48 * 16;
    constexpr int I_WIN = 2 * 32 * (INW / 32);
    constexpr int I_SQ = 2 * 32 * 64;
    constexpr int I_UV = 2 * NEXP;
    constexpr int I_KEY = 2 * 8 * 128 * 128 / 4096;
    constexpr int NITEMS = I_ADA + I_WIN + 4 * I_SQ + 2 * I_UV + 2 * I_KEY;
    for (int it = F.gw; it < NITEMS; it += F.NGW) {
        int r = it;
        if (r < I_ADA) { p0_ada_item(F, sl, r); continue; } r -= I_ADA;
        if (r < I_WIN) { const int l = r / (I_WIN / 2), q = r % (I_WIN / 2); p0_transpose_item8(F.w_in + (size_t)l * DM * INW, INW, F.ws + WS_WIN + (size_t)l * INW * DM, DM, scr, q, F.lane); continue; } r -= I_WIN;
        if (r < 4 * I_SQ) { const int mtx = r / I_SQ, rr = r % I_SQ, l = rr / (I_SQ / 2), q = rr % (I_SQ / 2);
            const size_t mo = (size_t)l * DM * DM;
            if (mtx == 0) p0_transpose_item8(F.w_ao + mo, DM, F.ws + WS_W2 + (size_t)l * DM * 4096, 4096, scr, q, F.lane);
            else if (mtx == 1) p0_transpose_item8(F.w_co + mo, DM, F.ws + WS_W2 + (size_t)l * DM * 4096 + DM, 4096, scr, q, F.lane);
            else if (mtx == 2) p0_transpose_item8(F.w_o + mo, DM, F.ws + WS_WO + mo, DM, scr, q, F.lane);
            else p0_transpose_item(F.peer_wq + mo, DM, (bf16*)(F.ws + WS_WQ) + mo, DM, 0, scr, q, F.lane);
            continue; } r -= 4 * I_SQ;
        if (r < 2 * I_UV) { const int tb = r / I_UV, row = r % I_UV; p0_fp8_row((tb ? F.peer_v : F.peer_u) + (size_t)row * DM, F.ws + (tb ? WS_PV : WS_PU) + (size_t)(row / NEXP) * NEXP * DM + (size_t)(row % NEXP) * 128, (float*)(F.ws + (tb ? WS_SV : WS_SU)) + row, F.lane); continue; } r -= 2 * I_UV;
        { const int tb = r / I_KEY; p0_cvt_item(tb ? F.peer_k2 : F.peer_k1, (bf16*)(F.ws + (tb ? WS_K2B : WS_K1B)), (size_t)(r % I_KEY), F.lane); }
    }
}

__device__ __forceinline__ const float* xrow_ptr(const float* xlat, const float* xctx, int row) { return row < NLAT ? xlat + (size_t)row * DM : xctx + (size_t)(row - NLAT) * DM; }
template <bool IN16> __device__ __forceinline__ int row_col(int j, int lane) { return IN16 ? 8 * lane + 512 * (j >> 1) + 4 * (j & 1) : 4 * lane + 256 * j; }
template <bool IN16>
__device__ __forceinline__ void quant_row8(const v4f (&y)[8], unsigned char* orow8, float* hs, int lane) {
    float am = 0.f;
#pragma unroll
    for (int j = 0; j < 8; ++j) am = fmaxf(am, fmaxf(fmaxf(fabsf(y[j].x), fabsf(y[j].y)), fmaxf(fabsf(y[j].z), fabsf(y[j].w))));
#pragma unroll
    for (int o = 1; o < 64; o <<= 1) am = fmaxf(am, __shfl_xor(am, o));
    const float inv = am > 0.f ? 448.f / am : 0.f;
    if (lane == 0) *hs = am * (1.f / 448.f);
#pragma unroll
    for (int j = 0; j < 8; ++j) { int w = 0; w = __builtin_amdgcn_cvt_pk_fp8_f32(y[j].x * inv, y[j].y * inv, w, false); w = __builtin_amdgcn_cvt_pk_fp8_f32(y[j].z * inv, y[j].w * inv, w, true);
        *(GAS int*)(orow8 + row_col<IN16>(j, lane)) = w; }
}
template <bool IN16> __device__ __forceinline__ void load_row(v4f (&d)[8], const float* xlat, const float* xctx, const bf16* xs, int row, int lane) {
    if constexpr (IN16) { const GAS v4u* p = (const GAS v4u*)(xs + (size_t)row * DM) + lane;
#pragma unroll
        for (int j = 0; j < 4; ++j) { const v4u w = p[64 * j]; d[2 * j] = (v4f){bflo(w.x), bfhi(w.x), bflo(w.y), bfhi(w.y)}; d[2 * j + 1] = (v4f){bflo(w.z), bfhi(w.z), bflo(w.w), bfhi(w.w)}; }
    } else { const GAS v4f* xr = (const GAS v4f*)(row < NLAT ? xlat + (size_t)row * DM : xctx + (size_t)(row - NLAT) * DM) + lane;
#pragma unroll
        for (int j = 0; j < 8; ++j) d[j] = xr[64 * j]; }
}
template <int F8, bool IN16>
__device__ __forceinline__ void norm_phase(Frame& F, const float* xlat, const float* xctx, int nrows, int l, const float* g, int csh, int csc) {
    frame_refresh(F); asm volatile("" : "+s"(l));
    bf16* H = (bf16*)(F.ws + WS_H); const bf16* XS = (const bf16*)(F.ws + WS_XS);
    const float* modl = F.mod + (size_t)l * 5 * 12288; const float* bl = F.ada_b + (size_t)l * 12288;
    const int lane = F.lane;
    const int r0 = (int)(((long)F.gw * nrows) / F.NGW), r1 = (int)(((long)(F.gw + 1) * nrows) / F.NGW);
    if (r0 >= r1) return;
    v4f cur[8], nxt[8], Av[8], Bv[8]; int have = -1;
    load_row<IN16>(cur, xlat, xctx, XS, r0, lane);
    for (int row = r0; row < r1; ++row) {
        if (row + 1 < r1) load_row<IN16>(nxt, xlat, xctx, XS, row + 1, lane);
        const int mr = row < NLAT ? row / SEQ : 4;
        if (mr != have) { have = mr;
            const float* msh = modl + mr * 12288 + csh * DM; const float* msc = modl + mr * 12288 + csc * DM; const float* bsh = bl + csh * DM; const float* bsc = bl + csc * DM;
#pragma unroll
            for (int j = 0; j < 8; ++j) { const int cidx = row_col<IN16>(j, lane);
                Av[j] = *(const v4f*)(g + cidx) * (*(const v4f*)(msc + cidx) + *(const v4f*)(bsc + cidx) + 1.f); Bv[j] = *(const v4f*)(msh + cidx) + *(const v4f*)(bsh + cidx); } }
        float s = 0.f;
#pragma unroll
        for (int j = 0; j < 8; ++j) s += (cur[j].x * cur[j].x + cur[j].y * cur[j].y) + (cur[j].z * cur[j].z + cur[j].w * cur[j].w);
        const float rstd = rsqrtf(wave_sum(s) * (1.f / DM) + EPS);
        bf16* orow = H + (size_t)row * DM; v4f yv[8];
#pragma unroll
        for (int j = 0; j < 8; ++j) { const int cidx = row_col<IN16>(j, lane);
            const v4f y = (cur[j] * rstd) * Av[j] + Bv[j]; yv[j] = y;
            if (!F8) { v2u o; o.x = pk2(y.x, y.y); o.y = pk2(y.z, y.w); *(GAS v2u*)(orow + cidx) = o; } }
        if (F8) quant_row8<IN16>(yv, (unsigned char*)H + (size_t)row * DM, (float*)(F.ws + WS_HS) + row, lane);
#pragma unroll
        for (int j = 0; j < 8; ++j) cur[j] = nxt[j];
    }
}
__device__ __forceinline__ void unpack8(const v4u w, float (&f)[8]) { f[0] = bflo(w.x); f[1] = bfhi(w.x); f[2] = bflo(w.y); f[3] = bfhi(w.y); f[4] = bflo(w.z); f[5] = bfhi(w.z); f[6] = bflo(w.w); f[7] = bfhi(w.w); }
__device__ __forceinline__ v4u pack8(const float (&f)[8]) { v4u o; o.x = pk2(f[0], f[1]); o.y = pk2(f[2], f[3]); o.z = pk2(f[4], f[5]); o.w = pk2(f[6], f[7]); return o; }
__device__ __forceinline__ v2u pack8_fp8(const float (&f)[8], float scale) { float c[8];
#pragma unroll
    for (int i = 0; i < 8; ++i) c[i] = fminf(fmaxf(f[i] * scale, -448.f), 448.f);
    int w0 = 0, w1 = 0; w0 = __builtin_amdgcn_cvt_pk_fp8_f32(c[0], c[1], w0, false); w0 = __builtin_amdgcn_cvt_pk_fp8_f32(c[2], c[3], w0, true);
    w1 = __builtin_amdgcn_cvt_pk_fp8_f32(c[4], c[5], w1, false); w1 = __builtin_amdgcn_cvt_pk_fp8_f32(c[6], c[7], w1, true);
    v2u o; o.x = (unsigned)w0; o.y = (unsigned)w1; return o; }
__device__ __forceinline__ v2u head_norm_rope(const v4u in, const float (&g)[8], bool rope, const float (&cs)[8], const float (&sn)[8], bool second) {
    float f[8]; unpack8(in, f); float ss = 0.f;
#pragma unroll
    for (int i = 0; i < 8; ++i) ss += f[i] * f[i];
    ss = sum16(ss);
    const float rstd = rsqrtf(ss * (1.f / 128.f) + EPS);
#pragma unroll
    for (int i = 0; i < 8; ++i) f[i] = f[i] * rstd * g[i];
    if (rope) {
        float o[8];
#pragma unroll
        for (int i = 0; i < 8; ++i) { const float pv = __shfl_xor(f[i], 4); o[i] = second ? f[i] * cs[i] + pv * sn[i] : f[i] * cs[i] - pv * sn[i]; }
        return pack8_fp8(o, att::QK8);
    }
    return pack8_fp8(f, att::QK8);
}
template <int VARX = 0>
__device__ __forceinline__ void split_phase(Frame& F, int l, int nfull, int nrows) {
    frame_refresh(F); asm volatile("" : "+s"(l));
    const bf16* P = (const bf16*)(F.ws + WS_P); unsigned char* A2 = F.ws + WS_A2; unsigned char* QB = F.ws + WS_Q; unsigned char* KB = F.ws + WS_KB; unsigned char* VT = F.ws + WS_VB;
    const int lane = F.lane, l16 = lane & 15;
    float qg[8], kg[8];
#pragma unroll
    for (int i = 0; i < 8; ++i) { qg[i] = F.q_norm_g[l * 128 + l16 * 8 + i]; kg[i] = F.k_norm_g[l * 128 + l16 * 8 + i]; }
    const bool second = (lane >> 2) & 1; const int blk = (lane >> 3) & 1;
    float inv[8];
#pragma unroll
    for (int i = 0; i < 8; ++i) inv[i] = __builtin_amdgcn_exp2f(-(float)((lane & 3) * 8 + i) * (13.287712379549449f / 32.f));
    const float* cw = F.conv_w + (size_t)l * 3 * DM;
    { int row = F.gw;
      if (row < nrows) {
        v4u cq[4], ck, nq[4], nk;
#define QK_LD(q_, k_, r_) do { const bf16* pr_ = P + (size_t)(r_) * INW + lane * 8; k_ = *(const GAS v4u*)(pr_ + C_K); \
        if ((r_) < nfull) { _Pragma("unroll") for (int p = 0; p < 4; ++p) q_[p] = *(const GAS v4u*)(pr_ + C_Q + p * 512); } } while (0)
        QK_LD(cq, ck, row);
        for (; row < nrows; row += F.NGW) {
            const int nr = row + F.NGW; if (nr < nrows) QK_LD(nq, nk, nr);
            const bool lat = row < NLAT; const int b = lat ? row / SEQ : (row - NLAT) / CTXL, t = lat ? row % SEQ : (row - NLAT) % CTXL;
            const size_t kvrow = (size_t)b * SKV + (lat ? t : SEQ + t);
            float cs[8], sn[8];
            if (lat) { const float pos = (float)(blk ? (t & 63) : (t >> 6));
#pragma unroll
                for (int i = 0; i < 8; ++i) { const float a = pos * inv[i]; cs[i] = __cosf(a); sn[i] = __sinf(a); } }
            else {
#pragma unroll
                for (int i = 0; i < 8; ++i) { cs[i] = 1.f; sn[i] = 0.f; } }
            *(GAS v2u*)(KB + kvrow * KVW + lane * 8) = head_norm_rope(ck, kg, lat, cs, sn, second);
            if (row < nfull) {
#pragma unroll
                for (int p = 0; p < 4; ++p) *(GAS v2u*)(QB + (size_t)row * DM + p * 512 + lane * 8) = head_norm_rope(cq[p], qg, lat, cs, sn, second); }
#pragma unroll
            for (int p = 0; p < 4; ++p) cq[p] = nq[p];
            ck = nk;
        }
#undef QK_LD
      }
    }
    {
        const float* cw = F.conv_w + (size_t)l * 3 * DM;
        const int r0 = (int)(((long)F.gw * nfull) / F.NGW), r1 = (int)(((long)(F.gw + 1) * nfull) / F.NGW);
        auto seqid = [](int r) { return r < NLAT ? r / SEQ : 4 + (r - NLAT) / CTXL; };
        if (r0 < r1)
        for (int pp = 0; pp < 2; ++pp) {
            float w0[2][8], w1[2][8], w2[2][8];
#pragma unroll
            for (int h = 0; h < 2; ++h)
#pragma unroll
                for (int i = 0; i < 8; ++i) { const int cc = (2 * pp + h) * 512 + lane * 8 + i; w0[h][i] = cw[cc]; w1[h][i] = cw[DM + cc]; w2[h][i] = cw[2 * DM + cc]; }
            const bf16* pc = P + (2 * pp) * 512 + lane * 8;
#define CV_LD(U_, G_, B_, r_) do { const bf16* q_ = pc + (size_t)(r_) * INW; _Pragma("unroll") for (int h = 0; h < 2; ++h) { U_[h] = *(const GAS v4u*)(q_ + h * 512 + C_U); G_[h] = *(const GAS v4u*)(q_ + h * 512 + C_GC); B_[h] = *(const GAS v4u*)(q_ + h * 512 + C_GB); } } while (0)
            float mp[2][8], mc[2][8], f0[8], f1[8];
            v4u un[2], gn[2], bn_[2], u2[2], g2[2], b2[2], bc[2];
            const bool hp0 = r0 > 0 && seqid(r0 - 1) == seqid(r0);
            { v4u a[2], g[2], bb[2]; CV_LD(a, g, bb, hp0 ? r0 - 1 : r0);
#pragma unroll
              for (int h = 0; h < 2; ++h) { unpack8(a[h], f0); unpack8(g[h], f1);
#pragma unroll
                for (int i = 0; i < 8; ++i) mp[h][i] = hp0 ? f0[i] * f1[i] : 0.f; } }
            { v4u a[2], g[2]; CV_LD(a, g, bc, r0);
#pragma unroll
              for (int h = 0; h < 2; ++h) { unpack8(a[h], f0); unpack8(g[h], f1);
#pragma unroll
                for (int i = 0; i < 8; ++i) mc[h][i] = f0[i] * f1[i]; } }
            const int rlast = nfull - 1;
            CV_LD(un, gn, bn_, min(r0 + 1, rlast));
            for (int row = r0; row < r1; ++row) {
                CV_LD(u2, g2, b2, min(row + 2, rlast));
                const int sid = seqid(row); const bool hp = row > 0 && seqid(row - 1) == sid, hn = row + 1 < nfull && seqid(row + 1) == sid;
#pragma unroll
                for (int h = 0; h < 2; ++h) { float mn[8], gb[8], o[8]; unpack8(un[h], f0); unpack8(gn[h], f1); unpack8(bc[h], gb);
#pragma unroll
                    for (int i = 0; i < 8; ++i) mn[i] = f0[i] * f1[i];
#pragma unroll
                    for (int i = 0; i < 8; ++i) o[i] = gb[i] * (w0[h][i] * (hp ? mp[h][i] : 0.f) + w1[h][i] * mc[h][i] + w2[h][i] * (hn ? mn[i] : 0.f));
                    *(GAS v2u*)(A2 + (size_t)row * 4096 + 2048 + (2 * pp + h) * 512 + lane * 8) = pack8_fp8(o, CV8_SCALE);
#pragma unroll
                    for (int i = 0; i < 8; ++i) { mp[h][i] = mc[h][i]; mc[h][i] = mn[i]; }
                    bc[h] = bn_[h]; un[h] = u2[h]; gn[h] = g2[h]; bn_[h] = b2[h]; }
            }
#undef CV_LD
        }
    }
    { LAS unsigned char* Vt = F.lds; const int tid = F.tid, wave = F.wave;
      for (int T = F.vcu; T < BATCH * (SKV / 64); T += F.G) {
        const int b = T / (SKV / 64), tile = T % (SKV / 64);
#pragma unroll
        for (int j = 0; j < 8; ++j) { const int i = wave * 8 + j, kk = tile * 64 + i; const size_t row = kk < SEQ ? (size_t)b * SEQ + kk : (size_t)NLAT + b * CTXL + (kk - SEQ);
            float f[8]; unpack8(*(const GAS v4u*)(P + row * INW + C_V + lane * 8), f);
            *(LAS v2u*)(Vt + i * 512 + lane * 8) = pack8_fp8(f, att::V8); }
        LDS_WAIT(); __syncthreads();
#pragma unroll
        for (int n = 0; n < 4; ++n) { const int c = tid + 512 * n, d = c & 127, rest = c >> 7, jj = rest & 1, hh = (rest >> 1) & 1, kvh = rest >> 2;
            v4u w;
#pragma unroll
            for (int q = 0; q < 4; ++q) { unsigned x = 0u;
#pragma unroll
                for (int e = 0; e < 4; ++e) { const int i = 4 * q + e, key = jj * 32 + (i & 3) + 8 * (i >> 2) + 4 * hh; x |= (unsigned)Vt[key * 512 + kvh * 128 + d] << (8 * e); }
                w[q] = x; }
            *(GAS v4u*)(VT + ((size_t)(b * (SKV / 64) + tile) * 4 + kvh) * 8192 + d * 64 + ((((hh * 2 + jj) ^ ((d >> 2) & 3))) << 4)) = w; }
        __syncthreads();
      }
    }
}
__device__ __forceinline__ void attn_phase(Frame& F, bool with_ctx, bool dry = false) {
    frame_refresh(F);
    unsigned char* A2 = F.ws + WS_A2; const unsigned char* Q = F.ws + WS_Q; const unsigned char* KB = F.ws + WS_KB; const unsigned char* VT = F.ws + WS_VB;
    const int nunits = 1024 + (with_ctx ? 64 : 0);
    for (int u = F.vcu; u < nunits; u += F.G) {
        size_t row0, ko, vo; int seq, h;
        if (u < 1024) { const int b = u >> 8, kvh = (u >> 6) & 3, g = (u >> 4) & 3, qb = u & 15; h = kvh * 4 + g;
            row0 = (size_t)b * SEQ + qb * 256; ko = (size_t)b * SKV * KVW + kvh * 128; vo = ((size_t)b * (SKV / 64) * 4 + kvh) * 8192; seq = SKV;
        } else { const int v = u - 1024, b = v >> 4; h = v & 15; const int kvh = h >> 2;
            row0 = (size_t)NLAT + b * CTXL; ko = ((size_t)b * SKV + SEQ) * KVW + kvh * 128; vo = ((size_t)(b * (SKV / 64) + SEQ / 64) * 4 + kvh) * 8192; seq = CTXL; }
        unsigned char* od = dry ? F.ws + 404 * MiB + row0 * 2048 + h * 128 : A2 + row0 * 4096 + h * 128;
        att::attn_dense_body(Q + row0 * DM + h * 128, KB + ko, VT + vo, od, dry ? 2048 : 4096, AT8_SCALE, seq, (char*)F.ldsg);
    }
}
__device__ __forceinline__ unsigned f2ord(float f) { const unsigned u = __float_as_uint(f); return u ^ ((u >> 31) ? 0xFFFFFFFFu : 0x80000000u); }
__device__ __forceinline__ float ord2f(unsigned o) { return __uint_as_float(o ^ ((o >> 31) ? 0x80000000u : 0xFFFFFFFFu)); }
typedef short s16x8 __attribute__((ext_vector_type(8)));
typedef float f32x16 __attribute__((ext_vector_type(16)));
__device__ __forceinline__ int crow16(int r, int hi) { return (r & 3) + 8 * (r >> 2) + 4 * hi; }
__device__ __forceinline__ unsigned max16u(unsigned v) {
    v = max(v, dppu<DPP_X1>(v)); v = max(v, dppu<DPP_X2>(v)); v = max(v, dppu<DPP_HMIR>(v)); v = max(v, dppu<DPP_MIR>(v)); return v;
}
#define CSWAP(a_, b_) do { const unsigned hi_ = max(a_, b_), lo_ = min(a_, b_); a_ = hi_; b_ = lo_; } while (0)
__device__ __forceinline__ void topk_phase(Frame& F, int l, int nrows) {
    frame_refresh(F); asm volatile("" : "+s"(l));
    const bf16* PQ = (const bf16*)(F.ws + WS_PQ);
    const bf16* K1 = (const bf16*)(F.ws + WS_K1B) + (size_t)l * 8 * 128 * 128; const bf16* K2 = (const bf16*)(F.ws + WS_K2B) + (size_t)l * 8 * 128 * 128;
    int* IDX = (int*)(F.ws + WS_IDX); float* GW = (float*)(F.ws + WS_GW);
    LAS float* S = (LAS float*)(F.lds + F.wave * 18688);
    LAS unsigned* T1 = (LAS unsigned*)(F.lds + F.wave * 18688 + 16384);
    LAS unsigned* T2 = T1 + 512;
    const int lane = F.lane, r32 = lane & 31, hi = lane >> 5, l16 = lane & 15, qd = lane >> 4;
    int ct[4] = {0xFF, 0xFF, 0xFF, 0xFF};
    { int cnt = 0;
      for (int i = 0; i < 16; ++i) for (int j = 0; j < 16; ++j) if ((i + 1) * (j + 1) <= 16) {
#pragma unroll
          for (int s = 0; s < 4; ++s) if (cnt == l16 * 4 + s) ct[s] = (i << 4) | j;
          ++cnt; } }
    const int nitems = (nrows / 32) * 8;
    for (int it = F.gw; it < nitems; it += F.NGW) {
        const int h = it & 7, tok0 = (it >> 3) * 32;
        for (int half = 0; half < 2; ++half) {
            f32x16 acc[4];
#pragma unroll
            for (int nb = 0; nb < 4; ++nb) acc[nb] = (f32x16){};
            const bf16* qp = PQ + (size_t)(tok0 + r32) * DM + h * 256 + half * 128 + hi * 8;
            const bf16* kp = (half ? K2 : K1) + ((size_t)h * 128 + r32) * 128 + hi * 8;
#pragma unroll
            for (int d0 = 0; d0 < 8; ++d0) { const s16x8 a = *(const GAS s16x8*)(qp + d0 * 16);
#pragma unroll
                for (int nb = 0; nb < 4; ++nb) { const s16x8 bb = *(const GAS s16x8*)(kp + (size_t)nb * 32 * 128 + d0 * 16); acc[nb] = __builtin_amdgcn_mfma_f32_32x32x16_bf16(a, bb, acc[nb], 0, 0, 0); } }
#pragma unroll
            for (int nb = 0; nb < 4; ++nb)
#pragma unroll
                for (int r = 0; r < 16; ++r) S[crow16(r, hi) * 128 + nb * 32 + r32] = acc[nb][r];
            LDS_WAIT();
            for (int ps = 0; ps < 8; ++ps) {
                const int tok = ps * 4 + qd;
                unsigned k[8];
#pragma unroll
                for (int j = 0; j < 8; ++j) k[j] = (f2ord(S[tok * 128 + j * 16 + l16]) & ~127u) | (unsigned)(127 - (j * 16 + l16));
                CSWAP(k[0], k[1]); CSWAP(k[2], k[3]); CSWAP(k[4], k[5]); CSWAP(k[6], k[7]);
                CSWAP(k[0], k[2]); CSWAP(k[1], k[3]); CSWAP(k[4], k[6]); CSWAP(k[5], k[7]);
                CSWAP(k[1], k[2]); CSWAP(k[5], k[6]); CSWAP(k[0], k[4]); CSWAP(k[3], k[7]);
                CSWAP(k[1], k[5]); CSWAP(k[2], k[6]);
                CSWAP(k[1], k[4]); CSWAP(k[3], k[6]);
                CSWAP(k[2], k[4]); CSWAP(k[3], k[5]);
                CSWAP(k[3], k[4]);
                unsigned mine = 0u;
                for (int rnd = 0; rnd < 16; ++rnd) {
                    const unsigned m = max16u(k[0]);
                    if (l16 == rnd) mine = m;
                    const bool pop = (k[0] == m);
#pragma unroll
                    for (int j = 0; j < 7; ++j) k[j] = pop ? k[j + 1] : k[j];
                    k[7] = pop ? 0u : k[7];
                }
                if (half == 0) T1[tok * 16 + l16] = mine;
                else {
                    T2[qd * 16 + l16] = mine;
                    LDS_WAIT();
                    unsigned ck[4];
#pragma unroll
                    for (int s = 0; s < 4; ++s) { const int i = (ct[s] >> 4) & 15, j = ct[s] & 15;
                        const float c = ord2f(T1[tok * 16 + i] & ~127u) + ord2f(T2[qd * 16 + j] & ~127u);
                        ck[s] = (ct[s] == 0xFF) ? 0u : ((f2ord(c) & ~255u) | (unsigned)(255 - ct[s])); }
                    CSWAP(ck[0], ck[1]); CSWAP(ck[2], ck[3]); CSWAP(ck[0], ck[2]); CSWAP(ck[1], ck[3]); CSWAP(ck[1], ck[2]);
                    unsigned win = 0u, m0 = 0u;
                    for (int rnd = 0; rnd < 16; ++rnd) {
                        const unsigned m = max16u(ck[0]);
                        if (rnd == 0) m0 = m;
                        if (l16 == rnd) win = m;
                        const bool pop = (ck[0] == m);
                        ck[0] = pop ? ck[1] : ck[0]; ck[1] = pop ? ck[2] : ck[1]; ck[2] = pop ? ck[3] : ck[2]; ck[3] = pop ? 0u : ck[3];
                    }
                    const float sv = ord2f(win & ~255u), smax = ord2f(m0 & ~255u);
                    const int ij = 255 - (int)(win & 255u), ci = (ij >> 4) & 15, cj = ij & 15;
                    const int e = (127 - (int)(T1[tok * 16 + ci] & 127u)) * 128 + (127 - (int)(T2[qd * 16 + cj] & 127u));
                    const float p = __expf(sv - smax);
                    const float den = sum16(p);
                    { const size_t o = (size_t)(tok0 + tok) * 128 + h * 16 + l16; IDX[o] = e; GW[o] = p / den; }
                    LDS_WAIT();
                }
            }
        }
    }
}
#undef CSWAP

typedef float f32x2_t __attribute__((ext_vector_type(2)));
constexpr int NSL = 16;
constexpr size_t WS_PART = WS_P + 96 * MiB, WS_WT = WS_P + 240 * MiB, WS_SSQ = WS_P + 250 * MiB;
#define PS_IDX2(dst, src, tok_) do { const GAS unsigned* p_ = (const GAS unsigned*)((src) + (size_t)(tok_) * 128 + grp * 16 + c8); dst[0] = p_[0]; dst[1] = p_[8]; } while (0)
#define PS_BC(v, II) __builtin_amdgcn_ds_swizzle((int)(v), ((II) << 5) | 0x18)
#define PS_LD1(buf, II, ev_) { const unsigned e_ = (unsigned)PS_BC(ev_, II); buf[II] = *(const GAS v4u*)(tbl + ((MODE == 2 ? (e_ & 63u) : e_) * 128u + loff)); }
#define PS_LOAD(buf, ev, C_) do { const unsigned ev_ = ev[C_]; PS_LD1(buf, 0, ev_) PS_LD1(buf, 1, ev_) PS_LD1(buf, 2, ev_) PS_LD1(buf, 3, ev_) PS_LD1(buf, 4, ev_) PS_LD1(buf, 5, ev_) PS_LD1(buf, 6, ev_) PS_LD1(buf, 7, ev_) } while (0)
template <int MODE>
__device__ __forceinline__ void peer_up_phase(Frame& F, int l, int nrows) {
    frame_refresh(F); asm volatile("" : "+s"(l));
    const int lane = F.lane, grp = lane >> 3, c8 = lane & 7;
    const int xg = blockIdx.x & 7, wg = (blockIdx.x >> 3) * NWAVES + F.wave, nwg = (F.G >> 3) * NWAVES;
    const unsigned char* tbl = F.ws + WS_PU + (size_t)l * NEXP * DM;
    const unsigned* IDX = (const unsigned*)(F.ws + WS_IDX); const bf16* H = (const bf16*)(F.ws + WS_H); bf16* PART = (bf16*)(F.ws + WS_PART);
    for (int sub = 0; sub < 2; ++sub) {
        const int slice = xg + 8 * sub; const unsigned loff = (unsigned)(slice * (NEXP * 128) + c8 * 16);
        int tok = wg; if (tok >= nrows) continue;
        unsigned e0[2], e1[2], e2[2], h0, h1 = 0u; v4u bufA[8], bufB[8];
        const GAS unsigned* H32 = (const GAS unsigned*)H + slice * 64 + lane;
        PS_IDX2(e0, IDX, tok); h0 = H32[(size_t)tok * (DM / 2)];
        if (tok + nwg < nrows) PS_IDX2(e1, IDX, tok + nwg); else { e1[0] = e0[0]; e1[1] = e0[1]; }
        PS_LOAD(bufA, e0, 0);
        for (; tok < nrows; tok += nwg) {
            const int t1 = tok + nwg, t2 = tok + 2 * nwg;
            if (t2 < nrows) PS_IDX2(e2, IDX, t2);
            if (t1 < nrows) h1 = H32[(size_t)t1 * (DM / 2)];
            PS_LOAD(bufB, e0, 1);
            f32x2_t hf[8];
#pragma unroll
            for (int k = 0; k < 8; ++k) { const unsigned w = (unsigned)__builtin_amdgcn_ds_bpermute((c8 * 8 + k) * 4, (int)h0); hf[k] = (f32x2_t){bflo(w), bfhi(w)}; }
            float keep[2] = {0.f, 0.f};
#define PS_UPCOMP(buf, C_) do { _Pragma("unroll") for (int ii = 0; ii < 8; ++ii) { const v4u uv = buf[ii]; f32x2_t s0 = {0.f, 0.f}, s1 = {0.f, 0.f}; \
                if (MODE == 1) { s0.x = __uint_as_float((uv.x ^ uv.y) & 0x3fffffffu); s1.x = __uint_as_float((uv.z ^ uv.w) & 0x3fffffffu); } else { \
                _Pragma("unroll") for (int q = 0; q < 4; ++q) { const f32x2_t lo = __builtin_amdgcn_cvt_pk_f32_fp8((int)uv[q], false), hi = __builtin_amdgcn_cvt_pk_f32_fp8((int)uv[q], true); \
                    s0 += lo * hf[q * 2]; s1 += hi * hf[q * 2 + 1]; } } \
                s0 += s1; float d = s0.x + s0.y; d += dppf<DPP_X1>(d); d += dppf<DPP_X2>(d); d += dppf<DPP_HMIR>(d); \
                if (c8 == ii) keep[C_] = d; } } while (0)
            PS_UPCOMP(bufA, 0);
            if (t1 < nrows) PS_LOAD(bufA, e1, 0);
            PS_UPCOMP(bufB, 1);
            bf16* pp = PART + ((size_t)slice * MALL + tok) * 128 + grp * 16 + c8;
            pp[0] = (bf16)f2bf(keep[0]); pp[8] = (bf16)f2bf(keep[1]);
            e0[0] = e1[0]; e0[1] = e1[1]; e1[0] = e2[0]; e1[1] = e2[1]; h0 = h1;
        }
    }
}
__device__ __forceinline__ void peer_combine_phase(Frame& F, int l, int nrows) {
    frame_refresh(F); asm volatile("" : "+s"(l));
    const bf16* PART = (const bf16*)(F.ws + WS_PART); const int* IDX = (const int*)(F.ws + WS_IDX); const float* GW = (const float*)(F.ws + WS_GW); float* WT = (float*)(F.ws + WS_WT);
    const float* SU = (const float*)(F.ws + WS_SU) + (size_t)l * NEXP; const float* SV = (const float*)(F.ws + WS_SV) + (size_t)l * NEXP;
    const int n = nrows * 128, step = F.NGW * 64;
    for (int i = F.gw * 64 + F.lane; i < n; i += 2 * step) {
        const int i2 = i + step; const bool h2 = i2 < n;
        float d = 0.f, dd = 0.f;
#pragma unroll
        for (int s = 0; s < NSL; ++s) { d += __uint_as_float((unsigned)PART[(size_t)s * MALL * 128 + i] << 16); if (h2) dd += __uint_as_float((unsigned)PART[(size_t)s * MALL * 128 + i2] << 16); }
        const int e = IDX[i]; const int e2 = h2 ? IDX[i2] : 0;
        const float a = gelu_erf(d * SU[e]) * GW[i] * SV[e];
        WT[i] = a;
        if (h2) WT[i2] = gelu_erf(dd * SU[e2]) * GW[i2] * SV[e2];
    }
}
template <int MODE>
__device__ __forceinline__ void peer_down_phase(Frame& F, int l, int nrows) {
    frame_refresh(F); asm volatile("" : "+s"(l));
    const int lane = F.lane, grp = lane >> 3, c8 = lane & 7;
    const bool b4 = (lane >> 4) & 1, b3 = (lane >> 3) & 1;
    const int xg = blockIdx.x & 7, wg = (blockIdx.x >> 3) * NWAVES + F.wave, nwg = (F.G >> 3) * NWAVES;
    const unsigned char* tbl = F.ws + WS_PV + (size_t)l * NEXP * DM;
    const unsigned* IDX = (const unsigned*)(F.ws + WS_IDX); const unsigned* WT = (const unsigned*)(F.ws + WS_WT); float* SSQ = (float*)(F.ws + WS_SSQ);
    bf16* XS = (bf16*)(F.ws + WS_XS);
    const float* modl = F.mod + (size_t)l * 5 * 12288 + 5 * DM; const float* bl = F.ada_b + (size_t)l * 12288 + 5 * DM;
    for (int sub = 0; sub < 2; ++sub) {
        const int slice = xg + 8 * sub; const unsigned loff = (unsigned)(slice * (NEXP * 128) + c8 * 16);
        int tok = wg; if (tok >= nrows) continue;
        unsigned e0[2], e1[2], e2[2], w0[2], w1[2], w2[2]; v4u bufA[8], bufB[8];
        PS_IDX2(e0, IDX, tok); PS_IDX2(w0, WT, tok);
        if (tok + nwg < nrows) { PS_IDX2(e1, IDX, tok + nwg); PS_IDX2(w1, WT, tok + nwg); } else { e1[0] = e0[0]; e1[1] = e0[1]; w1[0] = w0[0]; w1[1] = w0[1]; }
        PS_LOAD(bufA, e0, 0);
        for (; tok < nrows; tok += nwg) {
            const int t1 = tok + nwg, t2 = tok + 2 * nwg;
            if (t2 < nrows) { PS_IDX2(e2, IDX, t2); PS_IDX2(w2, WT, t2); }
            PS_LOAD(bufB, e0, 1);
            f32x2_t o2[8];
#pragma unroll
            for (int i = 0; i < 8; ++i) o2[i] = (f32x2_t){0.f, 0.f};
#define PS_DN1(buf, II, wv_) { const v4u vv = buf[II]; const float w = __uint_as_float((unsigned)PS_BC(wv_, II)); \
                if (MODE == 1) { o2[0].x += w * __uint_as_float((vv.x ^ vv.y) & 0x3fffffffu); o2[0].y += w * __uint_as_float((vv.z ^ vv.w) & 0x3fffffffu); } else { \
                _Pragma("unroll") for (int q = 0; q < 4; ++q) { const f32x2_t lo = __builtin_amdgcn_cvt_pk_f32_fp8((int)vv[q], false), hi = __builtin_amdgcn_cvt_pk_f32_fp8((int)vv[q], true); \
                    o2[q * 2] += lo * w; o2[q * 2 + 1] += hi * w; } } }
#define PS_DNCOMP(buf, C_) do { const unsigned wv_ = w0[C_]; PS_DN1(buf, 0, wv_) PS_DN1(buf, 1, wv_) PS_DN1(buf, 2, wv_) PS_DN1(buf, 3, wv_) PS_DN1(buf, 4, wv_) PS_DN1(buf, 5, wv_) PS_DN1(buf, 6, wv_) PS_DN1(buf, 7, wv_) } while (0)
            PS_DNCOMP(bufA, 0);
            if (t1 < nrows) PS_LOAD(bufA, e1, 0);
            PS_DNCOMP(bufB, 1);
            float o[16];
#pragma unroll
            for (int i = 0; i < 8; ++i) { o[2 * i] = o2[i].x; o[2 * i + 1] = o2[i].y; }
            float r1[8], r2[4], r3[2];
#pragma unroll
            for (int k = 0; k < 8; ++k) { auto rr = __builtin_amdgcn_permlane32_swap(__float_as_uint(o[k]), __float_as_uint(o[k + 8]), false, false); r1[k] = __uint_as_float(rr[0]) + __uint_as_float(rr[1]); }
#pragma unroll
            for (int k = 0; k < 4; ++k) { const float keep = b4 ? r1[k + 4] : r1[k], send = b4 ? r1[k] : r1[k + 4]; r2[k] = keep + __shfl_xor(send, 16); }
#pragma unroll
            for (int k = 0; k < 2; ++k) { const float keep = b3 ? r2[k + 2] : r2[k], send = b3 ? r2[k] : r2[k + 2]; r3[k] = keep + dppf<DPP_ROR8>(send); }
            const int mr = tok < NLAT ? tok / SEQ : 4; const int col = slice * 128 + c8 * 16 + grp * 2;
            GAS unsigned* xr = (GAS unsigned*)(XS + (size_t)tok * DM + col);
            const unsigned xw = *xr; const f32x2_t xv = {bflo(xw), bfhi(xw)}, gg = *(const f32x2_t*)(modl + mr * 12288 + col) + *(const f32x2_t*)(bl + col);
            const f32x2_t x2f = xv + gg * (f32x2_t){r3[0], r3[1]};
            const unsigned xo = pk2(x2f.x, x2f.y); const f32x2_t x2 = {bflo(xo), bfhi(xo)};
            if (MODE == 0) *xr = xo;
            const float ss = wave_sum(x2.x * x2.x + x2.y * x2.y);
            if (MODE == 0) { if (lane == 0) SSQ[(size_t)slice * MALL + tok] = ss; }
            else if (lane == 0) ((float*)(F.ws + WS_MODP))[(F.gw & 511) * 64] = ss;
            e0[0] = e1[0]; e0[1] = e1[1]; e1[0] = e2[0]; e1[1] = e2[1]; w0[0] = w1[0]; w0[1] = w1[1]; w1[0] = w2[0]; w1[1] = w2[1];
        }
    }
}
#undef PS_IDX2
#undef PS_BC
#undef PS_LD1
#undef PS_DN1
#undef PS_LOAD
#undef PS_UPCOMP
#undef PS_DNCOMP
__device__ __forceinline__ void post_norm_phase(Frame& F, int l, int nrows, bool last) {
    frame_refresh(F); asm volatile("" : "+s"(l));
    bf16* H = (bf16*)(F.ws + WS_H); const float* SSQ = (const float*)(F.ws + WS_SSQ); const bf16* XS = (const bf16*)(F.ws + WS_XS);
    const float* modn = F.mod + (size_t)(l + 1) * 5 * 12288; const float* bn = F.ada_b + (size_t)(l + 1) * 12288;
    const int lane = F.lane;
    const bool bad = last && __hip_atomic_load((unsigned*)(F.ws + WS_CTL) + 24, __ATOMIC_RELAXED, __HIP_MEMORY_SCOPE_AGENT) != 0u;
    const int r0 = (int)(((long)F.gw * nrows) / F.NGW), r1 = (int)(((long)(F.gw + 1) * nrows) / F.NGW);
    if (r0 >= r1) return;
    v4f cur[8], nxt[8], Av[8], Bv[8]; float scur, snxt = 0.f; int have = -1;
    load_row<true>(cur, nullptr, nullptr, XS, r0, lane); scur = (lane < NSL) ? SSQ[(size_t)lane * MALL + r0] : 0.f;
    for (int row = r0; row < r1; ++row) {
        if (row + 1 < r1) { load_row<true>(nxt, nullptr, nullptr, XS, row + 1, lane); snxt = (lane < NSL) ? SSQ[(size_t)lane * MALL + row + 1] : 0.f; }
        const int mr = row < NLAT ? row / SEQ : 4;
        if (mr != have) { have = mr;
#pragma unroll
            for (int j = 0; j < 8; ++j) { const int cidx = row_col<true>(j, lane);
                if (!last) { Av[j] = *(const v4f*)(F.norm1_g + (size_t)(l + 1) * DM + cidx) * (*(const v4f*)(modn + mr * 12288 + DM + cidx) + *(const v4f*)(bn + DM + cidx) + 1.f);
                    Bv[j] = *(const v4f*)(modn + mr * 12288 + cidx) + *(const v4f*)(bn + cidx); }
                else { Av[j] = *(const v4f*)(F.final_g + cidx); Bv[j] = (v4f){0.f, 0.f, 0.f, 0.f}; } } }
        const float rstd = rsqrtf(wave_sum(scur) * (1.f / DM) + EPS);
        v4f yv[8];
#pragma unroll
        for (int j = 0; j < 8; ++j) { const int cidx = row_col<true>(j, lane); yv[j] = (cur[j] * rstd) * Av[j] + Bv[j];
            if (last) *(GAS v4f*)(F.out + (size_t)row * DM + cidx) = bad ? (v4f){0.f, 0.f, 0.f, 0.f} : yv[j]; }
        if (!last) quant_row8<true>(yv, (unsigned char*)H + (size_t)row * DM, (float*)(F.ws + WS_HS) + row, lane);
#pragma unroll
        for (int j = 0; j < 8; ++j) cur[j] = nxt[j];
        scur = snxt;
    }
}
__device__ __forceinline__ bool mfma8_selftest(int lane) {
    typedef int v8i_t __attribute__((ext_vector_type(8)));
    const int idx = lane & 15, kb = lane >> 4;
    v8i_t X, Y;
#pragma unroll
    for (int w = 0; w < 8; ++w) { float xa[4], yb[4];
#pragma unroll
        for (int t = 0; t < 4; ++t) { const int k = 32 * kb + 4 * w + t; xa[t] = (float)(((idx * 3 + k * 5) % 7) - 3); yb[t] = (float)(((k * 2 + idx * 7) % 5) - 2); }
        int xw = 0, yw = 0; xw = __builtin_amdgcn_cvt_pk_fp8_f32(xa[0], xa[1], xw, false); xw = __builtin_amdgcn_cvt_pk_fp8_f32(xa[2], xa[3], xw, true);
        yw = __builtin_amdgcn_cvt_pk_fp8_f32(yb[0], yb[1], yw, false); yw = __builtin_amdgcn_cvt_pk_fp8_f32(yb[2], yb[3], yw, true); X[w] = xw; Y[w] = yw; }
    v4f d = {0.f, 0.f, 0.f, 0.f};
    d = __builtin_amdgcn_mfma_scale_f32_16x16x128_f8f6f4(X, Y, d, 0, 0, 0, 0x7F7F7F7F, 0, 0x7F7F7F7F);
    bool ok = true;
#pragma unroll
    for (int r = 0; r < 4; ++r) { const int i = 4 * kb + r, j = idx; int e = 0;
        for (int k = 0; k < 128; ++k) e += (((i * 3 + k * 5) % 7) - 3) * (((k * 2 + j * 7) % 5) - 2);
        ok = ok && (d[r] == (float)e); }
    return __all(ok);
}
struct Args { const float* in[22]; float* out; unsigned char* ws; int ph_lo, ph_hi, use_bar, pad; };
__global__ void __launch_bounds__(NWAVES * 64, 2) mk_fwd(Args args) {
    extern __shared__ __attribute__((aligned(16))) unsigned char lds[];
    Frame F;
    F.lds = (LAS unsigned char*)lds; F.ldsg = lds;
    F.tid = threadIdx.x; F.lane = F.tid & 63; F.wave = __builtin_amdgcn_readfirstlane(F.tid >> 6);
    F.G = gridDim.x; { const int bx = blockIdx.x; F.vcu = (F.G % 8 == 0) ? (bx % 8) * (F.G / 8) + bx / 8 : bx; }
    F.gw = F.vcu * NWAVES + F.wave; F.NGW = F.G * NWAVES;
    F.x = args.in[0]; F.c = args.in[1]; F.ctx = args.in[2]; F.c_ctx = args.in[3]; F.ada_w = args.in[4]; F.ada_b = args.in[5]; F.norm1_g = args.in[6]; F.norm2_g = args.in[7];
    F.w_in = args.in[8]; F.b_gate = args.in[9]; F.q_norm_g = args.in[10]; F.k_norm_g = args.in[11]; F.conv_w = args.in[12]; F.w_ao = args.in[13]; F.w_co = args.in[14]; F.w_o = args.in[15];
    F.peer_wq = args.in[16]; F.peer_k1 = args.in[17]; F.peer_k2 = args.in[18]; F.peer_u = args.in[19]; F.peer_v = args.in[20]; F.final_g = args.in[21];
    F.out = args.out; F.ws = args.ws; F.mod = (float*)(args.ws + WS_CTL + CTL_MOD);
    volatile LAS unsigned* MISC = (volatile LAS unsigned*)(F.lds + MISC_OFF);
    for (int u = F.tid; u < (LDS_BYTES - MISC_OFF) / 4; u += NWAVES * 64) MISC[u] = 0u;
    __syncthreads();
    XcdBarrier bar; bar.bar = (unsigned*)(args.ws + WS_CTL) + CW_BAR; bar.x = 0; bar.st = nullptr;
    if (args.use_bar) bar = xcd_barrier_post((unsigned*)(args.ws + WS_CTL) + CW_BAR, MISC + 8);
    const int lo = args.ph_lo, hi = args.ph_hi;
#ifndef PHASE_MASK
#define PHASE_MASK 0xFFFFFFFFu
#endif
#define PHK(k) ((k) < 3 ? (k) : 3 + ((k) - 3) % NPH_LAYER)
#define IN(k) (((PHASE_MASK >> PHK(k)) & 1u) && lo <= (k) && (k) < hi)
#define SEAM(k) do { if (IN(k) && IN((k) + 1)) xcd_barrier(bar); } while (0)
    bf16* H = (bf16*)(F.ws + WS_H); bf16* P = (bf16*)(F.ws + WS_P); bf16* A2 = (bf16*)(F.ws + WS_A2); bf16* XS = (bf16*)(F.ws + WS_XS);

#if PROBE_DUP & 0x200
    if (IN(0)) { p0_prologue(F); __syncthreads(); }
#endif
    if (IN(0) && blockIdx.x == 0 && F.wave == 0) { if (!mfma8_selftest(F.lane) && F.lane == 0) __hip_atomic_store((unsigned*)(args.ws + WS_CTL) + 24, 1u, __ATOMIC_RELAXED, __HIP_MEMORY_SCOPE_AGENT); }
    if (IN(0)) { p0_prologue(F); __syncthreads(); } SEAM(0);
    if (IN(1)) { mod_reduce_phase(F); } SEAM(1);
    if (IN(2)) { norm_phase<1, false>(F, F.x, F.ctx, MALL, 0, F.norm1_g, 0, 1); } SEAM(2);
    for (int l = 0; l < 2; ++l) {
        const int base = 3 + NPH_LAYER * l, Ml = (l == 0) ? MALL : NLAT;
        if (IN(base + 0)) {
            pg8::Gemm g{H, (const bf16*)(F.ws + WS_WIN + (size_t)l * INW * DM), Ml, INW, DM / 2}; pg8::OrderX S; S.init(Ml, INW, F.G, (int)blockIdx.x, l == 1 ? 16 : 0);
            pg8::EpiStore8 E{P, INW, (const float*)(F.ws + WS_HS), 1.f / W8_SCALE, C_GA, G8_SCALE};
            for (int rep = 0; rep < ((PROBE_DUP & 0x1) ? 2 : 1); ++rep) pg8::gemm_phase<pg8::EpiStore8, pg8::OrderX, true, true, true>(F.lds, g, S, E);
        } SEAM(base + 0);
#if PROBE_DUP & 0x2
        if (IN(base + 1)) { split_phase(F, l, Ml, MALL); }
#endif
        if (IN(base + 1)) { split_phase(F, l, Ml, MALL); } SEAM(base + 1);
#if PROBE_DUP & 0x4
        if (IN(base + 2)) { attn_phase(F, l == 0, true); }
#endif
        if (IN(base + 2)) { attn_phase(F, l == 0); } SEAM(base + 2);
        if (IN(base + 3)) {
            pg8::Gemm g{(const bf16*)(F.ws + WS_A2), (const bf16*)(F.ws + WS_W2 + (size_t)l * DM * 4096), Ml, DM, 2048}; pg8::OrderX S; S.init(Ml, DM, F.G, (int)blockIdx.x, 0);
            pg8::EpiGate<true> E{H, DM  , MG8_SCALE, CV8_SCALE / AT8_SCALE, 1.f / (CV8_SCALE * W8_SCALE), (const unsigned char*)P, INW * 2, C_GA * 2, C_GA * 2 + 2048, 1.f / G8_SCALE, F.b_gate + (size_t)l * 4096};
            for (int rep = 0; rep < ((PROBE_DUP & 0x8) ? 2 : 1); ++rep) pg8::gemm_phase<pg8::EpiGate<true>, pg8::OrderX, true, true, true>(F.lds, g, S, E);
        } SEAM(base + 3);
        if (IN(base + 4)) {
            pg8::Gemm g{H, (const bf16*)(F.ws + WS_WO + (size_t)l * DM * DM), Ml, DM, DM / 2}; pg8::OrderX S; S.init(Ml, DM, F.G, (int)blockIdx.x, 0);
            if (l == 0) { pg8::EpiResid<false> E{F.x, F.ctx, XS, F.mod + (size_t)l * 5 * 12288 + 2 * DM, F.ada_b + (size_t)l * 12288 + 2 * DM, 1.f / (MG8_SCALE * W8_SCALE)};
                pg8::gemm_phase<pg8::EpiResid<false>, pg8::OrderX, true, true, true>(F.lds, g, S, E); }
            else { pg8::EpiResid<true> E{nullptr, nullptr, XS, F.mod + (size_t)l * 5 * 12288 + 2 * DM, F.ada_b + (size_t)l * 12288 + 2 * DM, 1.f / (MG8_SCALE * W8_SCALE)};
                pg8::gemm_phase<pg8::EpiResid<true>, pg8::OrderX, true, true, true>(F.lds, g, S, E); }
        } SEAM(base + 4);
#if PROBE_DUP & 0x20
        if (IN(base + 5)) { norm_phase<0, true>(F, nullptr, nullptr, Ml, l, F.norm2_g + (size_t)l * DM, 3, 4); }
#endif
        if (IN(base + 5)) { norm_phase<0, true>(F, nullptr, nullptr, Ml, l, F.norm2_g + (size_t)l * DM, 3, 4); } SEAM(base + 5);
        if (IN(base + 6)) {
            pg8::Gemm g{H, (const bf16*)(F.ws + WS_WQ) + (size_t)l * DM * DM, Ml, DM, DM}; pg8::OrderX S; S.init(Ml, DM, F.G, (int)blockIdx.x, 0);
            pg8::EpiStore E{(bf16*)(F.ws + WS_PQ), DM};
            for (int rep = 0; rep < ((PROBE_DUP & 0x40) ? 2 : 1); ++rep) pg8::gemm_phase<pg8::EpiStore, pg8::OrderX, true, true>(F.lds, g, S, E);
        } SEAM(base + 6);
#if PROBE_DUP & 0x80
        if (IN(base + 7)) { topk_phase(F, l, Ml); }
#endif
        if (IN(base + 7)) { topk_phase(F, l, Ml); } SEAM(base + 7);
#if PROBE_DUP & 0x100
        if (IN(base + 8)) { peer_up_phase<PROBE_GMODE>(F, l, Ml); }
#endif
        if (IN(base + 8)) { peer_up_phase<0>(F, l, Ml); } SEAM(base + 8);
#if PROBE_DUP & 0x400
        if (IN(base + 9)) { peer_combine_phase(F, l, Ml); }
#endif
        if (IN(base + 9)) { peer_combine_phase(F, l, Ml); } SEAM(base + 9);
#if PROBE_DUP & 0x100
        if (IN(base + 10)) { peer_down_phase<PROBE_GMODE ? PROBE_GMODE : 3>(F, l, Ml); }
#endif
        if (IN(base + 10)) { peer_down_phase<0>(F, l, Ml); } SEAM(base + 10);
#if PROBE_DUP & 0x800
        if (IN(base + 11) && l == 0) { post_norm_phase(F, l, Ml, false); }
#endif
        if (IN(base + 11)) { post_norm_phase(F, l, Ml, l == 1); }
        if (l == 0) SEAM(base + 11);
    }
#undef IN
#undef SEAM
}

extern "C" void kernel_launch(void* const* d_in, const int* in_sizes, int n_in, void* d_out, int out_size, void* d_ws, size_t ws_size, hipStream_t stream) {
    static int grid = 0;
    if (grid == 0) {
        if (n_in != 22 || out_size != NLAT * DM || ws_size < WS_END) { fprintf(stderr, "kernel_launch: unexpected shapes: n_in %d out %d ws %zu (need %zu)\n", n_in, out_size, ws_size, (size_t)WS_END); grid = -1; return; }
        int dev = 0, cus = 0, per_cu = 0;
        if (hipGetDevice(&dev) != hipSuccess || hipDeviceGetAttribute(&cus, hipDeviceAttributeMultiprocessorCount, dev) != hipSuccess) { grid = -1; return; }
        if (hipFuncSetAttribute((const void*)mk_fwd, hipFuncAttributeMaxDynamicSharedMemorySize, LDS_BYTES) != hipSuccess) { fprintf(stderr, "kernel_launch: hipFuncSetAttribute failed\n"); grid = -1; return; }
        if (hipOccupancyMaxActiveBlocksPerMultiprocessor(&per_cu, (const void*)mk_fwd, NWAVES * 64, LDS_BYTES) != hipSuccess || per_cu < 1) fprintf(stderr, "kernel_launch: occupancy query reports %d\n", per_cu);
        (void)hipGetLastError();
        grid = cus;
    }
    if (grid < 0) return;
    if (hipMemsetAsync((char*)d_ws + WS_CTL, 0, CTL_ZERO_BYTES, stream) != hipSuccess) return;
    Args a{};
    for (int i = 0; i < 22; ++i) a.in[i] = (const float*)d_in[i];
    a.out = (float*)d_out; a.ws = (unsigned char*)d_ws; a.pad = 0;
#if MK_ONE_LAUNCH
    a.ph_lo = 0; a.ph_hi = NPH; a.use_bar = 1;
    hipLaunchKernelGGL(mk_fwd, dim3(grid), dim3(NWAVES * 64), LDS_BYTES, stream, a);
#else
    for (int p = 0; p < NPH; ++p) { a.ph_lo = p; a.ph_hi = p + 1; a.use_bar = 0;
        hipLaunchKernelGGL(mk_fwd, dim3(grid), dim3(NWAVES * 64), LDS_BYTES, stream, a); }
#endif
    const hipError_t le = hipPeekAtLastError();
    if (le != hipSuccess) fprintf(stderr, "kernel_launch: launch failed: %s\n", hipGetErrorName(le));
}
```

```cpp
#include <hip/hip_runtime.h>
#include <hip/hip_bf16.h>
#include <cstdio>
#include <cstdint>
namespace pg8 {
#define PG8_LAS __attribute__((address_space(3)))
typedef unsigned short bf16_t;
typedef short bf16x8 __attribute__((ext_vector_type(8)));
typedef float f32x4 __attribute__((ext_vector_type(4)));
typedef unsigned u32x4 __attribute__((ext_vector_type(4)));
constexpr int BM = 256, BK = 64, HALF = 128, HTB = HALF * BK * 2  , STAGE_BYTES = 8 * HTB, NXCD = 8, WGM = 4;

__host__ __device__ __forceinline__ int lds_byte(int r, int c) { const int st = (r >> 4) * 2 + (c >> 5), rr = r & 15, cc = c & 31, ob = rr * 64 + cc * 2; return st * 1024 + (ob ^ (((ob >> 9) & 1) << 5)); }
__host__ __device__ __forceinline__ void stage_rc(int b, int& R, int& C) { const int st = b / 1024, sb = b % 1024, swz = sb ^ (((sb >> 9) & 1) << 5); R = (st >> 1) * 16 + swz / 64; C = (st & 1) * 32 + (swz % 64) / 2; }
__host__ __device__ __forceinline__ int perm32(int rho) { const int n = rho >> 4, i = rho & 15; return 8 * (i >> 2) + 4 * n + (i & 3); }

struct Unit { int pm, pn; };
struct Gemm { const bf16_t* A; const bf16_t* Bt; int M, N, K; };

struct StaticOrder {
    int nM, nN, nwg, G, c;
    __host__ __device__ void init(int M, int N, int G_, int c_) { nM = M / BM; nN = N / BM; nwg = nM * nN; G = G_; c = c_; }
    __host__ __device__ bool next(int i, Unit& u) const {
        const long L = (long)i * G + c; if (L >= nwg) return false;
        int wgid = (int)L; { const int q = nwg / NXCD, r = nwg % NXCD, xcd = wgid % NXCD, off = wgid / NXCD; wgid = (xcd < r ? xcd * (q + 1) : r * (q + 1) + (xcd - r) * q) + off; }
        const int nig = WGM * nN, gid = wgid / nig, fm = gid * WGM, gsz = (nM - fm) < WGM ? (nM - fm) : WGM;
        u.pm = fm + ((wgid % nig) % gsz); u.pn = (wgid % nig) / gsz; return true;
    }
    __device__ __forceinline__ void a_ready(const Unit&) const {}
    __device__ __forceinline__ void done(const Unit&) const {}
};

__device__ __forceinline__ unsigned cvt_pk_bf16(float lo, float hi) { unsigned r; asm volatile("v_cvt_pk_bf16_f32 %0, %1, %2" : "=v"(r) : "v"(lo), "v"(hi)); return r; }
typedef float f32x2 __attribute__((ext_vector_type(2)));
__device__ __forceinline__ f32x2 gelu_pk(f32x2 v) {
    const f32x2 av = __builtin_elementwise_abs(v), d = av * 0.2316418882f + 1.0f;
    f32x2 t; t.x = __builtin_amdgcn_rcpf(d.x); t.y = __builtin_amdgcn_rcpf(d.y);
    f32x2 q = t * 0.5307027145f + (-0.7265760135f); q = q * t + 0.7107068705f; q = q * t + (-0.142248368f); q = q * t + 0.127414796f; q = q * t;
    const f32x2 s = (v * v) * (-0.72134752044f);
    f32x2 e; e.x = __builtin_amdgcn_exp2f(s.x); e.y = __builtin_amdgcn_exp2f(s.y);
    const f32x2 m = v * (q * e), r = v - m;
    f32x2 o; o.x = v.x < 0.f ? m.x : r.x; o.y = v.y < 0.f ? m.y : r.y; return o;
}


__device__ __forceinline__ float bf_lo(unsigned w) { return __uint_as_float(w << 16); }
__device__ __forceinline__ float bf_hi(unsigned w) { return __uint_as_float(w & 0xffff0000u); }
struct EpiStore {
    static constexpr bool PERM = true, AFTER_DRAIN = false, HAS_MID = false;
    bf16_t* O; int ldc;
    __device__ __forceinline__ void mid(f32x4 (&)[2][2][4][2], const Unit&, int, int, int, int) const {}
    __device__ __forceinline__ void operator()(const f32x4 (&acc)[2][2][4][2], const Unit& u, int wr, int wc, int fr, int fq) const {
        const int row0 = u.pm * BM + wr * 64 + fr, col0 = u.pn * BM + wc * 32 + 8 * fq;
#pragma unroll
        for (int ai = 0; ai < 2; ++ai)
#pragma unroll
            for (int m = 0; m < 4; ++m) { bf16_t* rowp = O + (size_t)(row0 + ai * HALF + m * 16) * ldc + col0;
#pragma unroll
                for (int bj = 0; bj < 2; ++bj) { const f32x4 v0 = acc[ai][bj][m][0], v1 = acc[ai][bj][m][1];
                    u32x4 w; w.x = cvt_pk_bf16(v0[0], v0[1]); w.y = cvt_pk_bf16(v0[2], v0[3]); w.z = cvt_pk_bf16(v1[0], v1[1]); w.w = cvt_pk_bf16(v1[2], v1[3]);
                    *(u32x4*)(rowp + bj * HALF) = w; } }
    }
};
struct EpiStore8 {
    static constexpr bool PERM = true, AFTER_DRAIN = false, HAS_MID = false;
    unsigned char* O; int ldc; const float* rs; float cs;
    __device__ __forceinline__ void mid(f32x4 (&)[2][2][4][2], const Unit&, int, int, int, int) const {}
    __device__ __forceinline__ void operator()(const f32x4 (&acc)[2][2][4][2], const Unit& u, int wr, int wc, int fr, int fq) const {
        int fr_ = fr, fq_ = fq; asm volatile("" : "+v"(fr_), "+v"(fq_));
        const int row0 = u.pm * BM + wr * 64 + fr_, col0 = u.pn * BM + wc * 32 + 8 * fq_;
        typedef unsigned u32x2 __attribute__((ext_vector_type(2)));
#pragma unroll
        for (int ai = 0; ai < 2; ++ai)
#pragma unroll
            for (int m = 0; m < 4; ++m) { const int row = row0 + ai * HALF + m * 16; unsigned char* rowp = O + (size_t)row * ldc + col0; const float sc = rs[row] * cs;
#pragma unroll
                for (int bj = 0; bj < 2; ++bj) { const f32x4 v0 = acc[ai][bj][m][0] * sc, v1 = acc[ai][bj][m][1] * sc;
                    float c8[8] = {v0[0], v0[1], v0[2], v0[3], v1[0], v1[1], v1[2], v1[3]};
#pragma unroll
                    for (int e = 0; e < 8; ++e) c8[e] = fminf(fmaxf(c8[e], -448.f), 448.f);
                    int w0 = 0, w1 = 0; w0 = __builtin_amdgcn_cvt_pk_fp8_f32(c8[0], c8[1], w0, false); w0 = __builtin_amdgcn_cvt_pk_fp8_f32(c8[2], c8[3], w0, true);
                    w1 = __builtin_amdgcn_cvt_pk_fp8_f32(c8[4], c8[5], w1, false); w1 = __builtin_amdgcn_cvt_pk_fp8_f32(c8[6], c8[7], w1, true);
                    u32x2 w; w.x = (unsigned)w0; w.y = (unsigned)w1;
                    *(u32x2*)(rowp + bj * HALF) = w; } }
    }
};
template <bool OUT8>
struct EpiGate {
    static constexpr bool PERM = true, AFTER_DRAIN = false, HAS_MID = true;
    bf16_t* O; int ldc; float oscale; float midf, endf; const unsigned char* G; int ldg; int ga_off, gc_off; float ginv; const float* bgate;
    __device__ __forceinline__ void mid(f32x4 (&acc)[2][2][4][2], const Unit& u, int wr, int wc, int fr, int fq) const {
        int rowv = u.pm * BM + wr * 64 + fr; asm volatile("" : "+v"(rowv));
        const int col0 = u.pn * BM + wc * 32 + 8 * fq;
        const unsigned char* pbase = G + (size_t)rowv * ldg + col0;
        typedef unsigned u32x2 __attribute__((ext_vector_type(2))); typedef float f32x2 __attribute__((ext_vector_type(2)));
#pragma unroll
        for (int bj = 0; bj < 2; ++bj) {
            const f32x4 ba0 = *(const f32x4*)(bgate + col0 + bj * HALF), ba1 = *(const f32x4*)(bgate + col0 + bj * HALF + 4), bc0 = *(const f32x4*)(bgate + 2048 + col0 + bj * HALF), bc1 = *(const f32x4*)(bgate + 2048 + col0 + bj * HALF + 4);
#pragma unroll
            for (int ai = 0; ai < 2; ++ai) { u32x2 gav[4], gcv[4];
                const unsigned char* pq = pbase + (size_t)(ai * HALF) * ldg + bj * HALF; asm volatile("" : "+v"(pq) :: "memory");
#pragma unroll
                for (int m = 0; m < 4; ++m) { const unsigned char* pr = pq + (size_t)(m * 16) * ldg; gav[m] = *(const u32x2*)(pr + ga_off); gcv[m] = *(const u32x2*)(pr + gc_off); }
#pragma unroll
                for (int m = 0; m < 4; ++m) { const u32x2 ga = gav[m], gc = gcv[m];
                    const f32x2 a0 = __builtin_amdgcn_cvt_pk_f32_fp8((int)ga.x, false), a1 = __builtin_amdgcn_cvt_pk_f32_fp8((int)ga.x, true), a2 = __builtin_amdgcn_cvt_pk_f32_fp8((int)ga.y, false), a3 = __builtin_amdgcn_cvt_pk_f32_fp8((int)ga.y, true);
                    const f32x2 c0 = __builtin_amdgcn_cvt_pk_f32_fp8((int)gc.x, false), c1 = __builtin_amdgcn_cvt_pk_f32_fp8((int)gc.x, true), c2 = __builtin_amdgcn_cvt_pk_f32_fp8((int)gc.y, false), c3 = __builtin_amdgcn_cvt_pk_f32_fp8((int)gc.y, true);
                    float a[8] = {a0.x * ginv, a0.y * ginv, a1.x * ginv, a1.y * ginv, a2.x * ginv, a2.y * ginv, a3.x * ginv, a3.y * ginv};
                    float c[8] = {c0.x * ginv, c0.y * ginv, c1.x * ginv, c1.y * ginv, c2.x * ginv, c2.y * ginv, c3.x * ginv, c3.y * ginv};
#pragma unroll
                    for (int e = 0; e < 8; ++e) { const float av = a[e] + (e < 4 ? ba0[e & 3] : ba1[e & 3]), cv = c[e] + (e < 4 ? bc0[e & 3] : bc1[e & 3]);
                        const float ratio = midf * (1.f + __expf(-cv)) * __builtin_amdgcn_rcpf(1.f + __expf(-av));
                        acc[ai][bj][m][e >> 2][e & 3] *= ratio; } } } }
    }
    __device__ __forceinline__ void operator()(const f32x4 (&acc)[2][2][4][2], const Unit& u, int wr, int wc, int fr, int fq) const {
        int rowv = u.pm * BM + wr * 64 + fr; asm volatile("" : "+v"(rowv));
        const int col0 = u.pn * BM + wc * 32 + 8 * fq;
        const unsigned char* pbase = G + (size_t)rowv * ldg + col0 + gc_off; typedef unsigned u32x2g __attribute__((ext_vector_type(2))); typedef float f32x2 __attribute__((ext_vector_type(2))); bf16_t* obase = OUT8 ? (bf16_t*)((unsigned char*)O + (size_t)rowv * ldc + col0) : O + (size_t)rowv * ldc + col0;
#pragma unroll
        for (int bj = 0; bj < 2; ++bj) {
            const f32x4 bc0 = *(const f32x4*)(bgate + 2048 + col0 + bj * HALF), bc1 = *(const f32x4*)(bgate + 2048 + col0 + bj * HALF + 4);
#pragma unroll
            for (int ai = 0; ai < 2; ++ai) { u32x2g gcv[4];
                const unsigned char* pq = pbase + (size_t)(ai * HALF) * ldg + bj * HALF; unsigned char* oq = (unsigned char*)obase + ((size_t)(ai * HALF) * ldc + bj * HALF) * (OUT8 ? 1 : 2);
                asm volatile("" : "+v"(pq), "+v"(oq) :: "memory");
#pragma unroll
                for (int m = 0; m < 4; ++m) gcv[m] = *(const u32x2g*)(pq + (size_t)(m * 16) * ldg);
#pragma unroll
                for (int m = 0; m < 4; ++m) { const u32x2g gc = gcv[m]; unsigned char* orow = oq + (size_t)(m * 16) * ldc * (OUT8 ? 1 : 2);
                    const f32x2 c0 = __builtin_amdgcn_cvt_pk_f32_fp8((int)gc.x, false), c1 = __builtin_amdgcn_cvt_pk_f32_fp8((int)gc.x, true), c2 = __builtin_amdgcn_cvt_pk_f32_fp8((int)gc.y, false), c3 = __builtin_amdgcn_cvt_pk_f32_fp8((int)gc.y, true);
                    float c[8] = {c0.x * ginv, c0.y * ginv, c1.x * ginv, c1.y * ginv, c2.x * ginv, c2.y * ginv, c3.x * ginv, c3.y * ginv};
                    float o[8];
#pragma unroll
                    for (int e = 0; e < 8; ++e) { const float cv = c[e] + (e < 4 ? bc0[e & 3] : bc1[e & 3]); o[e] = acc[ai][bj][m][e >> 2][e & 3] * endf * __builtin_amdgcn_rcpf(1.f + __expf(-cv)); }
                    if constexpr (OUT8) { float c8[8];
#pragma unroll
                        for (int e = 0; e < 8; ++e) c8[e] = fminf(fmaxf(o[e] * oscale, -448.f), 448.f);
                        int w0 = 0, w1 = 0; w0 = __builtin_amdgcn_cvt_pk_fp8_f32(c8[0], c8[1], w0, false); w0 = __builtin_amdgcn_cvt_pk_fp8_f32(c8[2], c8[3], w0, true);
                        w1 = __builtin_amdgcn_cvt_pk_fp8_f32(c8[4], c8[5], w1, false); w1 = __builtin_amdgcn_cvt_pk_fp8_f32(c8[6], c8[7], w1, true);
                        typedef unsigned u32x2 __attribute__((ext_vector_type(2))); u32x2 w; w.x = (unsigned)w0; w.y = (unsigned)w1; *(u32x2*)orow = w;
                    } else { u32x4 w; w.x = cvt_pk_bf16(o[0], o[1]); w.y = cvt_pk_bf16(o[2], o[3]); w.z = cvt_pk_bf16(o[4], o[5]); w.w = cvt_pk_bf16(o[6], o[7]);
                    *(u32x4*)orow = w; } } } }
    }
};
template <bool IN16>
struct EpiResid {
    static constexpr bool PERM = false, AFTER_DRAIN = false, HAS_MID = false;
    const float* xin_lat; const float* xin_ctx; bf16_t* xs; const float* mod; const float* bias; float ascale;
    __device__ __forceinline__ void mid(f32x4 (&)[2][2][4][2], const Unit&, int, int, int, int) const {}
    __device__ __forceinline__ void operator()(const f32x4 (&acc)[2][2][4][2], const Unit& u, int wr, int wc, int fr, int fq) const {
        const int modrow = u.pm < 64 ? (u.pm >> 4) : 4; const bool lat = u.pm < 64;
        const float* xi = lat ? xin_lat + (size_t)(u.pm * BM) * 2048 : xin_ctx + (size_t)((u.pm - 64) * BM) * 2048;
        bf16_t* xo = xs + (size_t)(u.pm * BM) * 2048;
        const float* md = mod + modrow * 12288;
        const int col0 = u.pn * BM + wc * 32 + 4 * fq;
        typedef unsigned u32x2 __attribute__((ext_vector_type(2)));
#pragma unroll
        for (int bj = 0; bj < 2; ++bj)
#pragma unroll
            for (int n = 0; n < 2; ++n) { const int col = col0 + bj * HALF + n * 16; const f32x4 g = (*(const f32x4*)(md + col) + *(const f32x4*)(bias + col)) * ascale;
#pragma unroll
                for (int ai = 0; ai < 2; ++ai)
#pragma unroll
                    for (int m = 0; m < 4; ++m) { const size_t off = (size_t)(ai * HALF + wr * 64 + m * 16 + fr) * 2048 + col;
                        f32x4 xv;
                        if constexpr (IN16) { const u32x2 w = *(const u32x2*)(xo + off); xv = (f32x4){bf_lo(w.x), bf_hi(w.x), bf_lo(w.y), bf_hi(w.y)}; } else xv = *(const f32x4*)(xi + off);
                        const f32x4 o = xv + g * acc[ai][bj][m][n];
                        u32x2 w; w.x = cvt_pk_bf16(o[0], o[1]); w.y = cvt_pk_bf16(o[2], o[3]); *(u32x2*)(xo + off) = w; } }
    }
};
struct OrderX {
    StaticOrder b; int nextra;
    __device__ __forceinline__ void init(int M, int N, int G, int c, int nextra_) { b.init(M, N, G, c); nextra = nextra_; }
    __device__ __forceinline__ bool next(int i, Unit& u) const {
        const long L = (long)i * b.G + b.c; if (L < b.nwg) return b.next(i, u);
        const int e = (int)(L - b.nwg); if (e >= nextra) return false; u.pm = 64 + (e >> 2); u.pn = 8 + (e & 3); return true; }
    __device__ __forceinline__ void a_ready(const Unit&) const {}
    __device__ __forceinline__ void done(const Unit&) const {}
};
typedef int pg8_v4i __attribute__((ext_vector_type(4))); typedef int pg8_v8i __attribute__((ext_vector_type(8)));
__device__ __forceinline__ pg8_v8i pg8_cat(bf16x8 lo, bf16x8 hi) { return __builtin_shufflevector(__builtin_bit_cast(pg8_v4i, lo), __builtin_bit_cast(pg8_v4i, hi), 0, 1, 2, 3, 4, 5, 6, 7); }
template <class Epi, class Sched, bool ALIGN_EPI = false, bool SP2 = false, bool FP8 = false>
__device__ __forceinline__ void gemm_phase(PG8_LAS unsigned char* lds, const Gemm g, const Sched& S, const Epi& E) {
    int tid = threadIdx.x; asm volatile("" : "+v"(tid));
    const int wid = __builtin_amdgcn_readfirstlane(tid >> 6), lane = tid & 63, wr = wid >> 2, wc = wid & 3, fr = lane & 15, fq = lane >> 4;
    const int K = g.K, nt = K / BK;
    unsigned voffA[2], voffB[2];
#pragma unroll
    for (int i = 0; i < 2; ++i) { int R, C; stage_rc(tid * 16 + i * 8192, R, C); const int Rb = Epi::PERM ? ((R & ~31) + perm32(R & 31)) : R;
        voffA[i] = (unsigned)(R * K + C) * 2u; voffB[i] = (unsigned)(Rb * K + C) * 2u; }
    const size_t kstep = (size_t)(BK * 2);
    const size_t hstep = (size_t)HALF * K * 2;
    const size_t tstep = 2 * hstep;
    const unsigned ldsw = (unsigned)wid * 1024u;
    const int aoff = FP8 ? lds_byte(wr * 64 + fr, 16 * (fq & 1)) + (fq >> 1) * 1024 : lds_byte(wr * 64 + fr, fq * 8), boff = FP8 ? lds_byte(wc * 32 + fr, 16 * (fq & 1)) + (fq >> 1) * 1024 : lds_byte(wc * 32 + fr, fq * 8);
    constexpr int KSTEP = FP8 ? 16 : 1024;
    int sc8 = 0x7F7F7F7F; asm volatile("" : "+v"(sc8));
    unsigned abase8 = (unsigned)(size_t)lds + (unsigned)aoff, bbase8 = (unsigned)(size_t)lds + (unsigned)boff + 4u * HTB; asm volatile("" : "+v"(abase8), "+v"(bbase8));
#define PG8_SA(b, h) (((b) * 2 + (h)) * HTB)
#define PG8_SB(b, h) ((4 + (b) * 2 + (h)) * HTB)
#define PG8_STAGE(bufoff, gbase, voff) do { _Pragma("unroll") for (int _i = 0; _i < 2; ++_i) \
        __builtin_amdgcn_global_load_lds((const unsigned*)((const char*)(gbase) + (voff)[_i]), (PG8_LAS unsigned*)(lds + (bufoff) + ldsw + _i * 8192), 16, 0, 0); } while (0)
#define PG8_LDA(dst, b, h) do { _Pragma("unroll") for (int m = 0; m < 4; ++m) _Pragma("unroll") for (int k = 0; k < 2; ++k) { if constexpr (FP8) { if (k == 0) dst##8[m].lo = *(const PG8_LAS pg8_v4i*)(size_t)(abase8 + (PG8_SA(b, h) + m * 2048)); else dst##8[m].hi = *(const PG8_LAS pg8_v4i*)(size_t)(abase8 + (PG8_SA(b, h) + m * 2048 + 16)); } else dst[m][k] = *(const PG8_LAS bf16x8*)(lds + PG8_SA(b, h) + aoff + m * 2048 + k * KSTEP); } } while (0)
#define PG8_LDB(dst, b, h) do { _Pragma("unroll") for (int n = 0; n < 2; ++n) _Pragma("unroll") for (int k = 0; k < 2; ++k) { if constexpr (FP8) { if (k == 0) dst##8[n].lo = *(const PG8_LAS pg8_v4i*)(size_t)(bbase8 + (PG8_SB(b, h) - 4 * HTB + n * 2048)); else dst##8[n].hi = *(const PG8_LAS pg8_v4i*)(size_t)(bbase8 + (PG8_SB(b, h) - 4 * HTB + n * 2048 + 16)); } else dst[n][k] = *(const PG8_LAS bf16x8*)(lds + PG8_SB(b, h) + boff + n * 2048 + k * KSTEP); } } while (0)
#define PG8_MMA(ai, bj, At, Bt) do { __builtin_amdgcn_s_setprio(1); if constexpr (FP8) { _Pragma("unroll") for (int m = 0; m < 4; ++m) _Pragma("unroll") for (int n = 0; n < 2; ++n) \
        asm volatile("v_mfma_scale_f32_16x16x128_f8f6f4 %0, %1, %2, %0, %3, %3 op_sel_hi:[0,0,0]" : "+v"(acc[ai][bj][m][n]) : "v"(Bt##8[n]), "v"(At##8[m]), "v"(sc8)); } else { \
        _Pragma("unroll") for (int m = 0; m < 4; ++m) _Pragma("unroll") for (int n = 0; n < 2; ++n) _Pragma("unroll") for (int k = 0; k < 2; ++k) \
        acc[ai][bj][m][n] = __builtin_amdgcn_mfma_f32_16x16x32_bf16(Bt[n][k], At[m][k], acc[ai][bj][m][n], 0, 0, 0); } __builtin_amdgcn_s_setprio(0); } while (0)
#define PG8_WAIT_V(n) asm volatile("s_waitcnt vmcnt(" #n ")" ::: "memory")
#define PG8_WAIT_L(n) asm volatile("s_waitcnt lgkmcnt(" #n ")" ::: "memory")
#define PG8_BAR __builtin_amdgcn_s_barrier()
#define PG8_SCHED __builtin_amdgcn_sched_barrier(0)
    Unit cur, nxt; int ui = 0;
    if (!S.next(0, cur)) return;
    f32x4 acc[2][2][4][2];
#pragma unroll
    for (int a = 0; a < 2; ++a)
#pragma unroll
        for (int b = 0; b < 2; ++b)
#pragma unroll
            for (int m = 0; m < 4; ++m)
#pragma unroll
                for (int n = 0; n < 2; ++n) acc[a][b][m][n] = (f32x4){0.f, 0.f, 0.f, 0.f};
    bf16x8 At[4][2], B0[2][2], B1[2][2]; pg8_v8i At8[4], B08[2], B18[2];
    const char* cA = (const char*)g.A + (size_t)cur.pm * tstep; const char* cB = (const char*)g.Bt + (size_t)cur.pn * tstep;
    S.a_ready(cur);
    if constexpr (SP2) {
        PG8_STAGE(PG8_SB(0, 0), cB, voffB); PG8_STAGE(PG8_SB(0, 1), cB + hstep, voffB); PG8_STAGE(PG8_SA(0, 0), cA, voffA); PG8_STAGE(PG8_SA(0, 1), cA + hstep, voffA);
        if (wr == 1) PG8_BAR;
        PG8_WAIT_V(2); PG8_BAR;
        PG8_STAGE(PG8_SB(1, 0), cB + kstep, voffB); PG8_STAGE(PG8_SA(1, 0), cA + kstep, voffA); PG8_STAGE(PG8_SB(1, 1), cB + hstep + kstep, voffB);
        PG8_WAIT_V(6); PG8_BAR;
    } else {
        PG8_STAGE(PG8_SB(0, 0), cB, voffB); PG8_STAGE(PG8_SA(0, 0), cA, voffA); PG8_STAGE(PG8_SB(0, 1), cB + hstep, voffB); PG8_STAGE(PG8_SA(0, 1), cA + hstep, voffA);
        if (wr == 1) PG8_BAR;
        PG8_WAIT_V(4); PG8_BAR;
        PG8_STAGE(PG8_SB(1, 0), cB + kstep, voffB); PG8_STAGE(PG8_SA(1, 0), cA + kstep, voffA); PG8_STAGE(PG8_SB(1, 1), cB + hstep + kstep, voffB);
        PG8_WAIT_V(6); PG8_BAR;
    }
    for (;;) {
        const bool has_next = S.next(ui + 1, nxt);
        const char* nA = has_next ? (const char*)g.A + (size_t)nxt.pm * tstep : cA; const char* nB = has_next ? (const char*)g.Bt + (size_t)nxt.pn * tstep : cB;
        constexpr int NPART = Epi::HAS_MID ? 2 : 1; const int tpp = nt / NPART;
        for (int part = 0; part < NPART; ++part) {
        if constexpr (Epi::HAS_MID) { if (part == 1) { if constexpr (FP8) asm volatile("s_nop 15\n\ts_nop 15\n\ts_nop 15\n\ts_nop 15" ::: "memory"); E.mid(acc, cur, wr, wc, fr, fq); } }
        for (int t = part * tpp; t < (part + 1) * tpp; t += 2) {
            const bool last = (t == nt - 2);
            const char* a1 = cA + (size_t)(t + 1) * kstep;
            const char* a2 = last ? nA : cA + (size_t)(t + 2) * kstep; const char* b2 = last ? nB : cB + (size_t)(t + 2) * kstep;
            const char* a3 = a2 + kstep; const char* b3 = b2 + kstep;
            if (last && has_next) S.a_ready(nxt);
            if constexpr (SP2) {
            PG8_LDB(B0, 0, 0); PG8_LDB(B1, 0, 1); PG8_SCHED; PG8_LDA(At, 0, 0); PG8_STAGE(PG8_SA(1, 1), a1 + hstep, voffA);
            PG8_WAIT_V(8); PG8_WAIT_L(0); PG8_BAR; PG8_MMA(0, 0, At, B0); PG8_MMA(0, 1, At, B1); PG8_BAR; PG8_SCHED;
            PG8_LDA(At, 0, 1); PG8_STAGE(PG8_SB(0, 0), b2, voffB); PG8_STAGE(PG8_SB(0, 1), b2 + hstep, voffB); PG8_STAGE(PG8_SA(0, 0), a2, voffA);
            PG8_WAIT_V(8); PG8_WAIT_L(0); PG8_BAR; PG8_MMA(1, 0, At, B0); PG8_MMA(1, 1, At, B1); PG8_BAR; PG8_SCHED;
            PG8_LDB(B0, 1, 0); PG8_LDB(B1, 1, 1); PG8_SCHED; PG8_LDA(At, 1, 0); PG8_STAGE(PG8_SA(0, 1), a2 + hstep, voffA);
            PG8_WAIT_V(8); PG8_WAIT_L(0); PG8_BAR; PG8_MMA(0, 0, At, B0); PG8_MMA(0, 1, At, B1); PG8_BAR; PG8_SCHED;
            PG8_LDA(At, 1, 1); PG8_STAGE(PG8_SB(1, 0), b3, voffB); PG8_STAGE(PG8_SB(1, 1), b3 + hstep, voffB); PG8_STAGE(PG8_SA(1, 0), a3, voffA);
            PG8_WAIT_V(8); PG8_WAIT_L(0); PG8_BAR; PG8_MMA(1, 0, At, B0); PG8_MMA(1, 1, At, B1); PG8_BAR; PG8_SCHED;
            } else {
            PG8_LDB(B0, 0, 0); PG8_SCHED; PG8_LDA(At, 0, 0); PG8_STAGE(PG8_SA(1, 1), a1 + hstep, voffA);
            PG8_WAIT_L(8); PG8_BAR; PG8_WAIT_L(0); PG8_MMA(0, 0, At, B0); PG8_BAR; PG8_SCHED;
            PG8_LDB(B1, 0, 1); PG8_STAGE(PG8_SB(0, 0), b2, voffB);
            PG8_BAR; PG8_WAIT_L(0); PG8_MMA(0, 1, At, B1); PG8_BAR;
            PG8_LDA(At, 0, 1); PG8_STAGE(PG8_SA(0, 0), a2, voffA);
            PG8_BAR; PG8_WAIT_L(0); PG8_MMA(1, 0, At, B0); PG8_BAR; PG8_SCHED;
            PG8_STAGE(PG8_SB(0, 1), b2 + hstep, voffB);
            PG8_WAIT_V(6); PG8_BAR; PG8_MMA(1, 1, At, B1); PG8_BAR;
            PG8_LDB(B0, 1, 0); PG8_SCHED; PG8_LDA(At, 1, 0); PG8_STAGE(PG8_SA(0, 1), a2 + hstep, voffA);
            PG8_WAIT_L(8); PG8_BAR; PG8_WAIT_L(0); PG8_MMA(0, 0, At, B0); PG8_BAR; PG8_SCHED;
            PG8_LDB(B1, 1, 1); PG8_STAGE(PG8_SB(1, 0), b3, voffB);
            PG8_BAR; PG8_WAIT_L(0); PG8_MMA(0, 1, At, B1); PG8_BAR;
            PG8_LDA(At, 1, 1); PG8_STAGE(PG8_SA(1, 0), a3, voffA);
            PG8_BAR; PG8_WAIT_L(0); PG8_MMA(1, 0, At, B0); PG8_BAR; PG8_SCHED;
            PG8_STAGE(PG8_SB(1, 1), b3 + hstep, voffB);
            PG8_WAIT_V(6); PG8_BAR; PG8_MMA(1, 1, At, B1); PG8_BAR;
            }
        }
        }
        if constexpr (FP8) asm volatile("s_nop 15\n\ts_nop 15\n\ts_nop 15\n\ts_nop 15" ::: "memory");
        if constexpr (ALIGN_EPI) { if (wr == 0) PG8_BAR; }
        if constexpr (!Epi::AFTER_DRAIN) { E(acc, cur, wr, wc, fr, fq); S.done(cur); }
        if (!has_next) break;
#pragma unroll
        for (int a = 0; a < 2; ++a)
#pragma unroll
            for (int b = 0; b < 2; ++b)
#pragma unroll
                for (int m = 0; m < 4; ++m)
#pragma unroll
                    for (int n = 0; n < 2; ++n) acc[a][b][m][n] = (f32x4){0.f, 0.f, 0.f, 0.f};
        cur = nxt; cA = nA; cB = nB; ++ui;
        if constexpr (ALIGN_EPI) { if (wr == 1) PG8_BAR; }
    }
    PG8_WAIT_V(0);
    if constexpr (!ALIGN_EPI) { if (wr == 0) PG8_BAR; }
    PG8_BAR;
    if constexpr (Epi::AFTER_DRAIN) { E.fused(acc, cur, wr, wc, fr, fq, lds, wid, lane); S.done(cur); }
#undef PG8_SA
#undef PG8_SB
#undef PG8_STAGE
#undef PG8_LDA
#undef PG8_LDB
#undef PG8_MMA
#undef PG8_WAIT_V
#undef PG8_WAIT_L
#undef PG8_BAR
#undef PG8_SCHED
}
}
namespace att {
using bf16 = __hip_bfloat16;
constexpr int   D = 128, NW = 8, QBLK = 32, KVBLK = 64;
constexpr float QK8 = 0.35709534f;
constexpr float THR2 = 4.3f;
constexpr float V8 = 32.f;
constexpr int VTS = 4 * 8192;
constexpr int SDEPTH = 2;
constexpr int LDQ = 2048, LDK = 512;
constexpr size_t SHM_V = KVBLK * D, SHM_K = KVBLK * D, NBUF = 6, SHM_ATTN = NBUF * SHM_V + NBUF * SHM_K + NW * 64 * 4;
typedef int v4i_t __attribute__((ext_vector_type(4))); typedef int v8i_t __attribute__((ext_vector_type(8)));
using bf16x8 = __attribute__((ext_vector_type(8))) short;
using s16x4  = __attribute__((ext_vector_type(4))) short;
using f32x16 = __attribute__((ext_vector_type(16))) float;
using f32x8  = __attribute__((ext_vector_type(8))) float;
using u32x4  = __attribute__((ext_vector_type(4))) unsigned;
#define KSWZ(row, colB) ((row) * 256 + ((colB) ^ (((row) & 7) << 4)))
#define SBAR() __builtin_amdgcn_sched_barrier(0)
__device__ __forceinline__ int crow(int r, int hi) { return (r & 3) + 8 * (r >> 2) + 4 * hi; }
__device__ __forceinline__ unsigned cvtpk(float lo, float hi) {
  unsigned r; asm volatile("v_cvt_pk_bf16_f32 %0, %1, %2" : "=v"(r) : "v"(lo), "v"(hi)); return r;
}
template <typename TIn> struct Stage;
template <> struct Stage<bf16>  { using T = bf16x8;
  __device__ static __forceinline__ T ld8(const bf16* p) { return *reinterpret_cast<const bf16x8*>(p); }
  __device__ static __forceinline__ bf16x8 tobf(T x) { return x; } };
template <> struct Stage<float> { using T = f32x8;
  __device__ static __forceinline__ T ld8(const float* p) { return *reinterpret_cast<const f32x8*>(p); }
  __device__ static __forceinline__ bf16x8 tobf(T x) {
    u32x4 w = {cvtpk(x[0], x[1]), cvtpk(x[2], x[3]), cvtpk(x[4], x[5]), cvtpk(x[6], x[7])}; return *reinterpret_cast<bf16x8*>(&w); } };

__device__ __forceinline__ void partialSM(f32x16& p0, f32x16& p1, f32x16& negm, float& alpha, bool first) {
  float pmax = p0[0]; for (int r = 1; r < 16; ++r) pmax = fmaxf(pmax, p0[r]); for (int r = 0; r < 16; ++r) pmax = fmaxf(pmax, p1[r]);
  { auto rr = __builtin_amdgcn_permlane32_swap(__float_as_uint(pmax), __float_as_uint(pmax), false, false);
    pmax = fmaxf(__uint_as_float(rr[0]), __uint_as_float(rr[1])); }
  if (__builtin_expect(!first && __all(pmax <= THR2 + 4.f), 1)) alpha = 1.f;
  else { const float delta = first ? pmax - 4.f : fmaxf(pmax - 4.f, 0.f);
    alpha = __builtin_amdgcn_exp2f(-delta);
    for (int r = 0; r < 16; ++r) { p0[r] -= delta; p1[r] -= delta; negm[r] -= delta; } }
  for (int r = 0; r < 16; ++r) p0[r] = __builtin_amdgcn_exp2f(p0[r]);
}
__device__ __forceinline__ void finishSM(f32x16& p0, f32x16& p1, float alpha, float& l_reg, v8i_t& pa) {
  for (int r = 0; r < 16; ++r) p1[r] = __builtin_amdgcn_exp2f(p1[r]);
  float ps = 0; for (int r = 0; r < 16; ++r) ps += p0[r]; for (int r = 0; r < 16; ++r) ps += p1[r];
  { auto rr = __builtin_amdgcn_permlane32_swap(__float_as_uint(ps), __float_as_uint(ps), false, false);
    ps = __uint_as_float(rr[0]) + __uint_as_float(rr[1]); }
  l_reg = l_reg * alpha + ps;
#pragma unroll
  for (int i = 0; i < 4; ++i) { int w = 0; w = __builtin_amdgcn_cvt_pk_fp8_f32(p0[4 * i], p0[4 * i + 1], w, false); w = __builtin_amdgcn_cvt_pk_fp8_f32(p0[4 * i + 2], p0[4 * i + 3], w, true); pa[i] = w;
    int x = 0; x = __builtin_amdgcn_cvt_pk_fp8_f32(p1[4 * i], p1[4 * i + 1], x, false); x = __builtin_amdgcn_cvt_pk_fp8_f32(p1[4 * i + 2], p1[4 * i + 3], x, true); pa[4 + i] = x; }
}
__device__ __forceinline__ void qkt(f32x16& p0, f32x16& p1, const char* Ks, const v8i_t* qr, const f32x16& negm, int r32, int hi) {
  const int sw = r32 & 7;
  const char* k0 = Ks + r32 * 128; const char* k1 = Ks + (32 + r32) * 128;
  { v8i_t a0, a1;
    a0.lo = *reinterpret_cast<const v4i_t*>(k0 + (((2 * hi) ^ sw) << 4)); a0.hi = *reinterpret_cast<const v4i_t*>(k0 + (((2 * hi + 1) ^ sw) << 4));
    a1.lo = *reinterpret_cast<const v4i_t*>(k1 + (((2 * hi) ^ sw) << 4)); a1.hi = *reinterpret_cast<const v4i_t*>(k1 + (((2 * hi + 1) ^ sw) << 4));
    p0 = __builtin_amdgcn_mfma_scale_f32_32x32x64_f8f6f4(a0, qr[0], negm, 0, 0, 0, 0x7F7F7F7F, 0, 0x7F7F7F7F);
    p1 = __builtin_amdgcn_mfma_scale_f32_32x32x64_f8f6f4(a1, qr[0], negm, 0, 0, 0, 0x7F7F7F7F, 0, 0x7F7F7F7F); }
  SBAR();
  { v8i_t b0, b1;
    b0.lo = *reinterpret_cast<const v4i_t*>(k0 + (((4 + 2 * hi) ^ sw) << 4)); b0.hi = *reinterpret_cast<const v4i_t*>(k0 + (((5 + 2 * hi) ^ sw) << 4));
    b1.lo = *reinterpret_cast<const v4i_t*>(k1 + (((4 + 2 * hi) ^ sw) << 4)); b1.hi = *reinterpret_cast<const v4i_t*>(k1 + (((5 + 2 * hi) ^ sw) << 4));
    p0 = __builtin_amdgcn_mfma_scale_f32_32x32x64_f8f6f4(b0, qr[1], p0, 0, 0, 0, 0x7F7F7F7F, 0, 0x7F7F7F7F);
    p1 = __builtin_amdgcn_mfma_scale_f32_32x32x64_f8f6f4(b1, qr[1], p1, 0, 0, 0, 0x7F7F7F7F, 0, 0x7F7F7F7F); }
}
__device__ __forceinline__ void pv_d0(f32x16* o, const char* Vs, const v8i_t& pa, int r32, int hi) {
  const int sw = (r32 >> 2) & 3;
#pragma unroll
  for (int db = 0; db < 4; ++db) { const char* row = Vs + (db * 32 + r32) * 64; v8i_t b;
    b.lo = *reinterpret_cast<const v4i_t*>(row + (((2 * hi) ^ sw) << 4)); b.hi = *reinterpret_cast<const v4i_t*>(row + (((2 * hi + 1) ^ sw) << 4));
    o[db] = __builtin_amdgcn_mfma_scale_f32_32x32x64_f8f6f4(pa, b, o[db], 0, 0, 0, 0x7F7F7F7F, 0, 0x7F7F7F7F); }
}

__device__ __forceinline__ int undef_i() { int w; asm volatile("" : "=v"(w)); return w; }
#define ATT_MFMA(a_, b_, c_) __builtin_amdgcn_mfma_scale_f32_32x32x64_f8f6f4(a_, b_, c_, 0, 0, 0, 0x7F7F7F7F, 0, 0x7F7F7F7F)
#ifndef ATT_PLIM
#define ATT_PLIM 448.f
#endif
template <bool HASN>
__device__ __forceinline__ void att_redo(f32x16& pO0, f32x16& pO1, f32x16& pN0, f32x16& pN1, f32x16* o, f32x16& negm, float& l_reg, float& ps_lane, float* al_l, int r32, int hi) {
  float pmax = pO0[0];
#pragma unroll
  for (int r = 1; r < 16; ++r) pmax = fmaxf(pmax, pO0[r]);
#pragma unroll
  for (int r = 0; r < 16; ++r) pmax = fmaxf(pmax, pO1[r]);
  { auto rr = __builtin_amdgcn_permlane32_swap(__float_as_uint(pmax), __float_as_uint(pmax), false, false); pmax = fmaxf(__uint_as_float(rr[0]), __uint_as_float(rr[1])); }
  const float delta = fmaxf(__builtin_amdgcn_logf(pmax) - 4.f, 0.f), alpha = __builtin_amdgcn_exp2f(-delta);
#pragma unroll
  for (int r = 0; r < 16; ++r) { pO0[r] *= alpha; pO1[r] *= alpha; negm[r] -= delta; }
  if constexpr (HASN) {
#pragma unroll
    for (int r = 0; r < 16; ++r) { pN0[r] -= delta; pN1[r] -= delta; } }
  ps_lane *= alpha; l_reg *= alpha;
  if (hi == 0) al_l[r32] = alpha; asm volatile("s_waitcnt lgkmcnt(0)" ::: "memory");
#pragma unroll
  for (int d = 0; d < 4; ++d)
#pragma unroll
    for (int r = 0; r < 16; ++r) o[d][r] *= al_l[crow(r, hi)];
}
__device__ __forceinline__ void att_pack(const f32x16& p0, const f32x16& p1, v8i_t& pa) {
#pragma unroll
  for (int i = 0; i < 4; ++i) { int w = undef_i(); w = __builtin_amdgcn_cvt_pk_fp8_f32(p0[4 * i], p0[4 * i + 1], w, false); w = __builtin_amdgcn_cvt_pk_fp8_f32(p0[4 * i + 2], p0[4 * i + 3], w, true); pa[i] = w;
    int x = undef_i(); x = __builtin_amdgcn_cvt_pk_fp8_f32(p1[4 * i], p1[4 * i + 1], x, false); x = __builtin_amdgcn_cvt_pk_fp8_f32(p1[4 * i + 2], p1[4 * i + 3], x, true); pa[4 + i] = x; }
}
__device__ __forceinline__ void att_step(f32x16& pN0, f32x16& pN1, f32x16& pO0, f32x16& pO1, f32x16* o, const v8i_t* qr, f32x16& negm, float& l_reg,
                                         const char* Ks, const char* KsO, const char* Vs, float* al_l, int r32, int hi) {
  v8i_t a0, a1, b0, b1, pa;
  { const int sw = r32 & 7; const char* k0 = Ks + r32 * 128; const char* k1 = Ks + (32 + r32) * 128;
    a0.lo = *reinterpret_cast<const v4i_t*>(k0 + (((2 * hi) ^ sw) << 4)); a0.hi = *reinterpret_cast<const v4i_t*>(k0 + (((2 * hi + 1) ^ sw) << 4));
    a1.lo = *reinterpret_cast<const v4i_t*>(k1 + (((2 * hi) ^ sw) << 4)); a1.hi = *reinterpret_cast<const v4i_t*>(k1 + (((2 * hi + 1) ^ sw) << 4));
    b0.lo = *reinterpret_cast<const v4i_t*>(k0 + (((4 + 2 * hi) ^ sw) << 4)); b0.hi = *reinterpret_cast<const v4i_t*>(k0 + (((5 + 2 * hi) ^ sw) << 4));
    b1.lo = *reinterpret_cast<const v4i_t*>(k1 + (((4 + 2 * hi) ^ sw) << 4)); b1.hi = *reinterpret_cast<const v4i_t*>(k1 + (((5 + 2 * hi) ^ sw) << 4)); }
  SBAR();
#pragma unroll
  for (int r = 0; r < 16; ++r) pO1[r] = __builtin_amdgcn_exp2f(pO1[r]);
  SBAR();
  pN0 = ATT_MFMA(a0, qr[0], negm); SBAR();
  float s0 = pO0[0], s1 = pO0[1], s2 = pO0[2], s3 = pO0[3];
  s0 += pO0[4]; s1 += pO0[5]; s2 += pO0[6]; s3 += pO0[7]; s0 += pO0[8]; s1 += pO0[9]; s2 += pO0[10]; s3 += pO0[11]; s0 += pO0[12]; s1 += pO0[13]; s2 += pO0[14]; s3 += pO0[15];
  SBAR();
  pN1 = ATT_MFMA(a1, qr[0], negm); SBAR();
  s0 += pO1[0]; s1 += pO1[1]; s2 += pO1[2]; s3 += pO1[3]; s0 += pO1[4]; s1 += pO1[5]; s2 += pO1[6]; s3 += pO1[7]; s0 += pO1[8]; s1 += pO1[9]; s2 += pO1[10]; s3 += pO1[11];
  SBAR();
  pN0 = ATT_MFMA(b0, qr[1], pN0); SBAR();
  s0 += pO1[12]; s1 += pO1[13]; s2 += pO1[14]; s3 += pO1[15];
  float ps_lane = (s0 + s1) + (s2 + s3);
  if (__builtin_expect(__any(!(ps_lane <= ATT_PLIM)), 0)) att_redo<true>(pO0, pO1, pN0, pN1, o, negm, l_reg, ps_lane, al_l, r32, hi);
  { auto rr = __builtin_amdgcn_permlane32_swap(__float_as_uint(ps_lane), __float_as_uint(ps_lane), false, false);
    l_reg += __uint_as_float(rr[0]) + __uint_as_float(rr[1]); }
#pragma unroll
  for (int i = 0; i < 4; ++i) { int w = undef_i(); w = __builtin_amdgcn_cvt_pk_fp8_f32(pO0[4 * i], pO0[4 * i + 1], w, false); w = __builtin_amdgcn_cvt_pk_fp8_f32(pO0[4 * i + 2], pO0[4 * i + 3], w, true); pa[i] = w; }
  SBAR();
  pN1 = ATT_MFMA(b1, qr[1], pN1); SBAR();
#pragma unroll
  for (int i = 0; i < 4; ++i) { int x = undef_i(); x = __builtin_amdgcn_cvt_pk_fp8_f32(pO1[4 * i], pO1[4 * i + 1], x, false); x = __builtin_amdgcn_cvt_pk_fp8_f32(pO1[4 * i + 2], pO1[4 * i + 3], x, true); pa[4 + i] = x; }
  asm volatile("" : "+v"(pa));
  v8i_t vb[4];
  { const int sw = (r32 >> 2) & 3;
#pragma unroll
    for (int db = 0; db < 4; ++db) { const char* row = Vs + (db * 32 + r32) * 64;
      vb[db].lo = *reinterpret_cast<const v4i_t*>(row + (((2 * hi) ^ sw) << 4)); vb[db].hi = *reinterpret_cast<const v4i_t*>(row + (((2 * hi + 1) ^ sw) << 4)); } }
  SBAR();
#pragma unroll
  for (int db = 0; db < 4; ++db) {
    o[db] = ATT_MFMA(pa, vb[db], o[db]); SBAR();
#pragma unroll
    for (int r = 0; r < 4; ++r) pN0[4 * db + r] = __builtin_amdgcn_exp2f(pN0[4 * db + r]);
    asm volatile("" : "+v"(pN0));
    SBAR(); }
}
__device__ __forceinline__ void att_last(f32x16& pO0, f32x16& pO1, f32x16* o, const v8i_t* qr, f32x16& negm, float& l_reg, const char* KsO, const char* Vs, float* al_l, int r32, int hi) {
  float ps_lane = 0.f; v8i_t pa;
#pragma unroll
  for (int r = 0; r < 16; ++r) { pO1[r] = __builtin_amdgcn_exp2f(pO1[r]); ps_lane += pO0[r] + pO1[r]; }
  if (__builtin_expect(__any(!(ps_lane <= ATT_PLIM)), 0)) att_redo<false>(pO0, pO1, pO0, pO1, o, negm, l_reg, ps_lane, al_l, r32, hi);
  { auto rr = __builtin_amdgcn_permlane32_swap(__float_as_uint(ps_lane), __float_as_uint(ps_lane), false, false);
    l_reg += __uint_as_float(rr[0]) + __uint_as_float(rr[1]); }
  att_pack(pO0, pO1, pa); SBAR();
  pv_d0(o, Vs, pa, r32, hi);
}

__device__ __forceinline__ void attn_dense_body(const unsigned char* __restrict__ Qb, const unsigned char* __restrict__ Kh, const unsigned char* __restrict__ Vh, unsigned char* Ob, int ldo, float oscale, int seq, char* lds) {
  int tid = threadIdx.x; asm volatile("" : "+v"(tid));
  const int wid = tid >> 6, lane = tid & 63, r32 = lane & 31, hi = lane >> 5;
  char* V_lds = lds; char* K_lds = lds + NBUF * SHM_V;
  float* ws = (float*)(lds + NBUF * SHM_V + NBUF * SHM_K) + wid * 64; float* li_l = ws; float* al_l = ws + 32;
  float l_reg = 0; f32x16 o[4] = {}; v8i_t qr[2]; f32x16 negm;
#pragma unroll
  for (int r = 0; r < 16; ++r) negm[r] = 4.f;
  const unsigned char* Qw = Qb + (long)(wid * QBLK + r32) * LDQ + hi * 32;
#pragma unroll
  for (int sq = 0; sq < 2; ++sq) { qr[sq].lo = *reinterpret_cast<const v4i_t*>(Qw + sq * 64); qr[sq].hi = *reinterpret_cast<const v4i_t*>(Qw + sq * 64 + 16); }
  const int kkey = tid >> 3, ksrc = (long)kkey * LDK + (((tid & 7) ^ (kkey & 7)) << 4);
  typedef __attribute__((address_space(3))) unsigned lds_u32;
  const unsigned ldsK = (unsigned)(uintptr_t)K_lds + (unsigned)wid * 1024u, ldsV = (unsigned)(uintptr_t)V_lds + (unsigned)wid * 1024u;
#define DMA_TILE(t_, slot_) do { \
    __builtin_amdgcn_global_load_lds((const unsigned*)(Kh + (long)(t_) * KVBLK * LDK + ksrc), (lds_u32*)(uintptr_t)(unsigned)__builtin_amdgcn_readfirstlane((int)(ldsK + (unsigned)(slot_))), 16, 0, 0); \
    __builtin_amdgcn_global_load_lds((const unsigned*)(Vh + (long)(t_) * VTS + tid * 16), (lds_u32*)(uintptr_t)(unsigned)__builtin_amdgcn_readfirstlane((int)(ldsV + (unsigned)(slot_))), 16, 0, 0); } while (0)
#define RESC(a) do { if (__any((a) < 1.f)) { if (hi == 0) al_l[r32] = (a); asm volatile("s_waitcnt lgkmcnt(0)" ::: "memory"); \
    for (int d = 0; d < 4; ++d) for (int r = 0; r < 16; ++r) o[d][r] *= al_l[crow(r, hi)]; } } while (0)
  f32x16 pA0, pA1, pB0, pB1; float alA, alB; v8i_t pa; const int NT = seq / KVBLK;
  int c6 = 1;
#define SL6(d_) ((unsigned)((c6 + (d_) >= 6 ? c6 + (d_) - 6 : c6 + (d_)) << 13))
  DMA_TILE(0, 0); DMA_TILE(1, SHM_K); DMA_TILE(2, 2 * SHM_K); asm volatile("s_waitcnt vmcnt(0)" ::: "memory"); __syncthreads();
  qkt(pA0, pA1, K_lds, qr, negm, r32, hi); partialSM(pA0, pA1, negm, alA, true);
  for (int j = 1; j + 1 < NT; j += 2) {
    DMA_TILE(j + 2, SL6(2)); if (j + 3 < NT) DMA_TILE(j + 3, SL6(3));
    att_step(pB0, pB1, pA0, pA1, o, qr, negm, l_reg, K_lds + SL6(0), K_lds + SL6(5), V_lds + SL6(5), al_l, r32, hi);
    att_step(pA0, pA1, pB0, pB1, o, qr, negm, l_reg, K_lds + SL6(1), K_lds + SL6(0), V_lds + SL6(0), al_l, r32, hi);
    asm volatile("s_waitcnt vmcnt(0)" ::: "memory"); __syncthreads();
    c6 = c6 + 2 >= 6 ? c6 + 2 - 6 : c6 + 2;
  }
  att_step(pB0, pB1, pA0, pA1, o, qr, negm, l_reg, K_lds + SL6(0), K_lds + SL6(5), V_lds + SL6(5), al_l, r32, hi);
  att_last(pB0, pB1, o, qr, negm, l_reg, K_lds + SL6(0), V_lds + SL6(0), al_l, r32, hi);
#undef SL6
  if (hi == 0) li_l[r32] = l_reg; asm volatile("s_waitcnt lgkmcnt(0)" ::: "memory");
  float rli[16];
#pragma unroll
  for (int r = 0; r < 16; ++r) rli[r] = __builtin_amdgcn_rcpf(li_l[crow(r, hi)]) * (1.f / V8);
  __syncthreads();
  { unsigned char* stg = (unsigned char*)(lds + wid * 4096);
#pragma unroll
    for (int r = 0; r < 16; ++r) { const int orow = crow(r, hi);
#pragma unroll
      for (int d0 = 0; d0 < 4; ++d0) { const float v = fminf(fmaxf(o[d0][r] * rli[r] * oscale, -448.f), 448.f); stg[orow * 128 + d0 * 32 + r32] = (unsigned char)__builtin_amdgcn_cvt_pk_fp8_f32(v, v, 0, false); } }
    asm volatile("s_waitcnt lgkmcnt(0)" ::: "memory");
    int rb = (lane >> 3) * 128 + (lane & 7) * 16; asm volatile("" : "+v"(rb));
    const unsigned char* rp = stg + rb;
    unsigned char* op = (unsigned char*)Ob + (long)(wid * QBLK + (rb >> 7)) * ldo + ((rb >> 4) & 7) * 16;
#pragma unroll
    for (int i = 0; i < 4; ++i) { const u32x4 v = *(const u32x4*)(rp + i * 1024); *(u32x4*)op = v; op += 8 * ldo; } }
  __syncthreads();
#undef DMA_TILE
#undef RESC
}
#undef KSWZ
#undef SBAR
}
constexpr int NWAVES = 8;
constexpr int DM = 2048, BATCH = 4, SEQ = 4096, CTXL = 256, NLAT = BATCH * SEQ, NCTX = BATCH * CTXL, MALL = NLAT + NCTX;
constexpr int INW = 13312, KVW = 512, SKV = SEQ + CTXL;
constexpr int C_Q = 0, C_K = 2048, C_V = 2560, C_U = 3072, C_GB = 5120, C_GC = 7168, C_GA = 9216, C_GV = 11264;
constexpr int NEXP = 16384;
constexpr float EPS = 1e-6f;
#ifndef PROBE_GMODE
#define PROBE_GMODE 0
#endif
#ifndef PROBE_DUP
#define PROBE_DUP 0
#endif
#ifndef MK_ONE_LAUNCH
#define MK_ONE_LAUNCH 1
#endif
constexpr int NPH_LAYER = 12, NPH = 3 + 2 * NPH_LAYER;

constexpr size_t MiB = 1u << 20;
constexpr size_t WS_CTL = 0, CTL_ZERO_BYTES = 1 * MiB;
constexpr size_t CTL_MOD = 65536;
constexpr size_t WS_K1B = 1 * MiB, WS_K2B = WS_K1B + 524288;
constexpr size_t WS_WIN = 2 * MiB  , WS_W2 = 106 * MiB, WS_WO = 138 * MiB, WS_WQ = 154 * MiB;
constexpr size_t WS_PU = 170 * MiB, WS_PV = 234 * MiB;
constexpr size_t WS_Q = 300 * MiB;
constexpr float G8_SCALE = 16.f;
constexpr float AT8_SCALE = 32.f, CV8_SCALE = 8.f;
constexpr size_t WS_HS = 299 * MiB;
constexpr float W8_SCALE = 1024.f, MG8_SCALE = 64.f;
constexpr float W8_SCALE_UNUSED = 0.f;
constexpr size_t WS_SU = 298 * MiB, WS_SV = WS_SU + 131072;
constexpr size_t WS_XS = 336 * MiB;
constexpr size_t WS_H = 434 * MiB;
constexpr size_t WS_KB = 502 * MiB, WS_VB = 519 * MiB;
constexpr size_t WS_A2 = 536 * MiB;
constexpr size_t WS_P = 672 * MiB;
constexpr size_t WS_PQ = WS_P, WS_IDX = WS_P + 68 * MiB, WS_GW = WS_P + 80 * MiB;
constexpr size_t WS_MODP = 1114 * MiB;
constexpr size_t WS_END = 1122 * MiB;
constexpr int CW_BAR = 4096;

constexpr int PHASE_LDS = 149504, MISC_OFF = PHASE_LDS, LDS_BYTES = PHASE_LDS + 1024;

#define GAS __attribute__((address_space(1)))
#define LAS __attribute__((address_space(3)))
typedef unsigned short bf16;
typedef unsigned v4u __attribute__((ext_vector_type(4)));
typedef unsigned v2u __attribute__((ext_vector_type(2)));
typedef float v4f __attribute__((ext_vector_type(4)));
typedef __bf16 bf16x2_t __attribute__((ext_vector_type(2)));
#define LDS_WAIT() asm volatile("s_waitcnt lgkmcnt(0)" ::: "memory")
#define VM_WAIT() asm volatile("s_waitcnt vmcnt(0)" ::: "memory")
__device__ __forceinline__ unsigned f2bf(float f) { unsigned u = __builtin_bit_cast(unsigned, f); return (u + 0x7fffu + ((u >> 16) & 1u)) >> 16; }
__device__ __forceinline__ unsigned pk2(float lo, float hi) { return f2bf(lo) | (f2bf(hi) << 16); }
__device__ __forceinline__ float bflo(unsigned w) { return __uint_as_float(w << 16); }
__device__ __forceinline__ float bfhi(unsigned w) { return __uint_as_float(w & 0xffff0000u); }
__device__ __forceinline__ float dot2bf(unsigned a, unsigned b, float c) { return __builtin_amdgcn_fdot2_f32_bf16(__builtin_bit_cast(bf16x2_t, a), __builtin_bit_cast(bf16x2_t, b), c, false); }
template <int CTRL> __device__ __forceinline__ float dppf(float v) { return __builtin_bit_cast(float, __builtin_amdgcn_update_dpp(0, __builtin_bit_cast(int, v), CTRL, 0xF, 0xF, true)); }
template <int CTRL> __device__ __forceinline__ unsigned dppu(unsigned v) { return (unsigned)__builtin_amdgcn_update_dpp(0, (int)v, CTRL, 0xF, 0xF, true); }
constexpr int DPP_X1 = 0xB1, DPP_X2 = 0x4E, DPP_HMIR = 0x141, DPP_MIR = 0x140, DPP_ROR8 = 0x128;
__device__ __forceinline__ float wave_sum(float v) {
#pragma unroll
    for (int o = 1; o < 64; o <<= 1) v += __shfl_xor(v, o);
    return v;
}
__device__ __forceinline__ float sum16(float v) {
    v += dppf<DPP_X1>(v); v += dppf<DPP_X2>(v); v += dppf<DPP_HMIR>(v); v += dppf<DPP_MIR>(v); return v;
}
__device__ __forceinline__ unsigned max32u(unsigned v) {
    v = max(v, dppu<DPP_X1>(v)); v = max(v, dppu<DPP_X2>(v)); v = max(v, dppu<DPP_HMIR>(v)); v = max(v, dppu<DPP_MIR>(v));
    v = max(v, (unsigned)__shfl_xor((int)v, 16)); return v;
}
__device__ __forceinline__ float gelu_erf(float v) {
    const float av = fabsf(v), t = __builtin_amdgcn_rcpf(av * 0.2316418882f + 1.0f);
    float q = t * 0.5307027145f + (-0.7265760135f); q = q * t + 0.7107068705f; q = q * t + (-0.142248368f); q = q * t + 0.127414796f; q = q * t;
    const float e = __builtin_amdgcn_exp2f((v * v) * (-0.72134752044f));
    const float m = v * (q * e); return v < 0.f ? m : v - m;
}
#define XB_TMO      128
#define XB_XCNT(j)  (256  + 64 * (j))
#define XB_XSUB(j)  (1280 + 64 * (j))
#define XB_XGEN(j)  (2304 + 64 * (j))
#define XB_TOP      3328
#define XB_TOPGEN   3392
#define XCD_BAR_WORDS 3456
#define XB_SPIN_CAP (1u << 18)

__device__ __forceinline__ unsigned xb_ld(unsigned* p)              { return __hip_atomic_load(p, __ATOMIC_RELAXED, __HIP_MEMORY_SCOPE_AGENT); }
__device__ __forceinline__ unsigned xb_add(unsigned* p, unsigned v) { return __hip_atomic_fetch_add(p, v, __ATOMIC_RELAXED, __HIP_MEMORY_SCOPE_AGENT); }
__device__ __forceinline__ unsigned xb_xcc_id() { return (unsigned)__builtin_amdgcn_s_getreg((3 << 11) | 20) & 0xFu; }
#define XB_SPIN(cond, bar) do { unsigned _sp = 0; while (cond) { __builtin_amdgcn_s_sleep(1); \
    if ((++_sp & 255u) == 0u) { if (xb_ld(&(bar)[XB_TMO])) break; if (_sp > XB_SPIN_CAP) { atomicAdd(&(bar)[XB_TMO], 1u); break; } } } } while (0)

struct XcdBarrier {
    unsigned* bar; unsigned x;
    volatile LAS unsigned* st;
};

__device__ __forceinline__ XcdBarrier xcd_barrier_post(unsigned* bar, volatile LAS unsigned* st) {
    XcdBarrier b; b.bar = bar; b.x = xb_xcc_id(); b.st = st;
    if (threadIdx.x == 0) (void)xb_add(&bar[XB_XCNT(b.x)], 1u);
    return b;
}
__device__ __forceinline__ void xcd_barrier_complete(unsigned* bar, unsigned x, unsigned& nloc, unsigned& nx) {
    const unsigned G = gridDim.x * gridDim.y * gridDim.z;
    unsigned sum, cnt, mine, sp = 0u;
    for (;;) {
        sum = 0u; cnt = 0u; mine = 0u;
#pragma unroll
        for (unsigned j = 0; j < 16; ++j) { const unsigned c = xb_ld(&bar[XB_XCNT(j)]); sum += c; cnt += (c > 0u) ? 1u : 0u; mine = (j == x) ? c : mine; }
        if (sum == G) break;
        __builtin_amdgcn_s_sleep(1);
        if ((++sp & 255u) == 0u) { if (xb_ld(&bar[XB_TMO])) break; if (sp > XB_SPIN_CAP) { atomicAdd(&bar[XB_TMO], 1u); break; } }
    }
    nloc = mine > 0u ? mine : 1u; nx = cnt > 0u ? cnt : 1u;
}

__device__ __forceinline__ void xcd_barrier(const XcdBarrier& b) {
    asm volatile("s_waitcnt vmcnt(0)" ::: "memory");
    __syncthreads();
    if (threadIdx.x == 0) {
        unsigned* bar = b.bar;
        __builtin_amdgcn_s_waitcnt(0);
        unsigned nloc = b.st[0], nx = b.st[1];
        if (nloc == 0u) { xcd_barrier_complete(bar, b.x, nloc, nx); b.st[0] = nloc; b.st[1] = nx; }
        const unsigned old = xb_add(&bar[XB_XSUB(b.x)], 1u);
        const unsigned gen = old / nloc;
        if (old + 1u == (gen + 1u) * nloc) {
            __builtin_amdgcn_fence(__ATOMIC_RELEASE, "agent");
            asm volatile("s_waitcnt vmcnt(0)" ::: "memory");
            const unsigned og = xb_add(&bar[XB_TOP], 1u);
            const unsigned tg = og / nx;
            if (og + 1u == (tg + 1u) * nx) xb_add(&bar[XB_TOPGEN], 1u);
            else XB_SPIN(xb_ld(&bar[XB_TOPGEN]) == tg, bar);
            __builtin_amdgcn_fence(__ATOMIC_ACQUIRE, "agent");
            xb_add(&bar[XB_XGEN(b.x)], 1u);
            asm volatile("s_waitcnt vmcnt(0)" ::: "memory");
        } else {
            XB_SPIN(xb_ld(&bar[XB_XGEN(b.x)]) == gen, bar);
            __builtin_amdgcn_fence(__ATOMIC_ACQUIRE, "agent");
            asm volatile("s_waitcnt vmcnt(0)" ::: "memory");
        }
    }
    __syncthreads();
}
struct Frame {
    LAS unsigned char* lds; unsigned char* ldsg;
    int tid, lane, wave, vcu, G, gw, NGW;
    const float *x, *c, *ctx, *c_ctx, *ada_w, *ada_b, *norm1_g, *norm2_g, *w_in, *b_gate, *q_norm_g, *k_norm_g, *conv_w, *w_ao, *w_co, *w_o, *peer_wq, *peer_k1, *peer_k2, *peer_u, *peer_v, *final_g;
    float* out; unsigned char* ws;
    float* mod;
};

__device__ __forceinline__ void frame_refresh(Frame& F) {
    int tid = threadIdx.x; asm volatile("" : "+v"(tid));
    F.tid = tid; F.lane = tid & 63; F.wave = __builtin_amdgcn_readfirstlane(tid >> 6);
    int bx = blockIdx.x; asm volatile("" : "+s"(bx));
    F.vcu = (F.G % 8 == 0) ? (bx % 8) * (F.G / 8) + bx / 8 : bx;
    F.gw = F.vcu * NWAVES + F.wave; F.NGW = F.G * NWAVES;
}
__device__ __forceinline__ void p0_transpose_item(const float* W, int N, bf16* WT, int ldk, int koff, LAS float* scr, int item, int lane) {
    const int nblk = N / 32, kb = item / nblk, nb = item % nblk, k0 = 64 * kb, n0 = 32 * nb;
#pragma unroll 8
    for (int i = 0; i < 32; ++i) { const int kk = 2 * i + (lane >> 5); scr[kk * 33 + (lane & 31)] = W[(size_t)(k0 + kk) * N + n0 + (lane & 31)]; }
    LDS_WAIT(); asm volatile("" ::: "memory");
    const int c = lane & 7;
#pragma unroll
    for (int j = 0; j < 4; ++j) { const int n = (lane >> 3) + 8 * j; const LAS float* s = scr + (8 * c) * 33 + n;
        v4u o; o.x = pk2(s[0 * 33], s[1 * 33]); o.y = pk2(s[2 * 33], s[3 * 33]); o.z = pk2(s[4 * 33], s[5 * 33]); o.w = pk2(s[6 * 33], s[7 * 33]);
        *(GAS v4u*)(WT + (size_t)(n0 + n) * ldk + koff + k0 + 8 * c) = o; }
    LDS_WAIT(); asm volatile("" ::: "memory");
}
__device__ __forceinline__ void p0_transpose_item8(const float* W, int N, unsigned char* WT, int ldk, LAS float* scr, int item, int lane) {
    const int nblk = N / 32, kb = item / nblk, nb = item % nblk, k0 = 64 * kb, n0 = 32 * nb;
#pragma unroll 8
    for (int i = 0; i < 32; ++i) { const int kk = 2 * i + (lane >> 5); scr[kk * 33 + (lane & 31)] = W[(size_t)(k0 + kk) * N + n0 + (lane & 31)]; }
    LDS_WAIT(); asm volatile("" ::: "memory");
    const int c = lane & 7;
#pragma unroll
    for (int j = 0; j < 4; ++j) { const int n = (lane >> 3) + 8 * j; const LAS float* s = scr + (8 * c) * 33 + n; float f[8];
#pragma unroll
        for (int i = 0; i < 8; ++i) f[i] = fminf(fmaxf(s[i * 33] * W8_SCALE, -448.f), 448.f);
        int w0 = 0, w1 = 0; w0 = __builtin_amdgcn_cvt_pk_fp8_f32(f[0], f[1], w0, false); w0 = __builtin_amdgcn_cvt_pk_fp8_f32(f[2], f[3], w0, true);
        w1 = __builtin_amdgcn_cvt_pk_fp8_f32(f[4], f[5], w1, false); w1 = __builtin_amdgcn_cvt_pk_fp8_f32(f[6], f[7], w1, true);
        v2u o; o.x = (unsigned)w0; o.y = (unsigned)w1; *(GAS v2u*)(WT + (size_t)(n0 + n) * ldk + k0 + 8 * c) = o; }
    LDS_WAIT(); asm volatile("" ::: "memory");
}
__device__ __forceinline__ void p0_cvt_item(const float* src, bf16* dst, size_t item, int lane) {
    const float* s = src + item * 4096 + lane * 8; bf16* d = dst + item * 4096 + lane * 8;
#pragma unroll
    for (int j = 0; j < 8; ++j) { const v4f a = *(const GAS v4f*)(s + j * 512), b = *(const GAS v4f*)(s + j * 512 + 4);
        v4u o; o.x = pk2(a.x, a.y); o.y = pk2(a.z, a.w); o.z = pk2(b.x, b.y); o.w = pk2(b.z, b.w); *(GAS v4u*)(d + j * 512) = o; }
}
__device__ __forceinline__ void p0_fp8_row(const float* src, unsigned char* dst, float* scale, int lane) {
    const GAS v4f* xr = (const GAS v4f*)src + lane; v4f v[8]; float am = 0.f;
#pragma unroll
    for (int j = 0; j < 8; ++j) { v[j] = xr[64 * j]; am = fmaxf(am, fmaxf(fmaxf(fabsf(v[j].x), fabsf(v[j].y)), fmaxf(fabsf(v[j].z), fabsf(v[j].w)))); }
#pragma unroll
    for (int o = 1; o < 64; o <<= 1) am = fmaxf(am, __shfl_xor(am, o));
    const float inv = am > 0.f ? 448.f / am : 0.f;
    if (lane == 0) *scale = am * (1.f / 448.f);
#pragma unroll
    for (int j = 0; j < 8; ++j) { int w = 0; w = __builtin_amdgcn_cvt_pk_fp8_f32(v[j].x * inv, v[j].y * inv, w, false); w = __builtin_amdgcn_cvt_pk_fp8_f32(v[j].z * inv, v[j].w * inv, w, true);
        *(GAS int*)(dst + (size_t)(2 * j + (lane >> 5)) * ((size_t)16384 * 128) + 4 * (lane & 31)) = w; }
}
__device__ __forceinline__ void p0_ada_item(Frame& F, const LAS float* sl, int item) {
    const int kc = item & 15, nb = (item >> 4) % 48, l = item / (16 * 48);
    const float* W = F.ada_w + ((size_t)l * DM + kc * 128) * 12288 + nb * 256 + F.lane * 4;
    v4f acc[5];
#pragma unroll
    for (int r = 0; r < 5; ++r) acc[r] = (v4f){0.f, 0.f, 0.f, 0.f};
#pragma unroll 4
    for (int k = 0; k < 128; ++k) { const v4f w = *(const GAS v4f*)(W + (size_t)k * 12288);
#pragma unroll
        for (int r = 0; r < 5; ++r) acc[r] += w * sl[r * DM + kc * 128 + k]; }
    float* m = (float*)(F.ws + WS_MODP) + ((size_t)kc * 2 + l) * 5 * 12288 + nb * 256 + F.lane * 4;
#pragma unroll
    for (int r = 0; r < 5; ++r) *(GAS v4f*)(m + r * 12288) = acc[r];
}
__device__ __forceinline__ void mod_reduce_phase(Frame& F) {
    frame_refresh(F);
    const float* mp = (const float*)(F.ws + WS_MODP);
    for (int i = F.gw * 64 + F.lane; i < 2 * 5 * 12288 / 4; i += F.NGW * 64) { v4f s = (v4f){0.f, 0.f, 0.f, 0.f};
#pragma unroll
        for (int kc = 0; kc < 16; ++kc) s += *(const GAS v4f*)(mp + (size_t)kc * 2 * 5 * 12288 + (size_t)i * 4);
        *(GAS v4f*)(F.mod + (size_t)i * 4) = s; }
}
__device__ __forceinline__ void p0_prologue(Frame& F) {
    frame_refresh(F);
    LAS float* scr = (LAS float*)(F.lds + F.wave * 9216);
    LAS float* sl = (LAS float*)(F.lds + 8 * 9216);
    for (int i = F.tid; i < 5 * DM; i += NWAVES * 64) { const float v = (i < 4 * DM) ? F.c[i] : F.c_ctx[i - 4 * DM]; sl[i] = v / (1.f + __expf(-v)); }
    __syncthreads();
    constexpr int I_ADA = 2 * 48 * 16;
    constexpr int I_WIN = 2 * 32 * (INW / 32);
    constexpr int I_SQ = 2 * 32 * 64;
    constexpr int I_UV = 2 * NEXP;
    constexpr int I_KEY = 2 * 8 * 128 * 128 / 4096;
    constexpr int NITEMS = I_ADA + I_WIN + 4 * I_SQ + 2 * I_UV + 2 * I_KEY;
    for (int it = F.gw; it < NITEMS; it += F.NGW) {
        int r = it;
        if (r < I_ADA) { p0_ada_item(F, sl, r); continue; } r -= I_ADA;
        if (r < I_WIN) { const int l = r / (I_WIN / 2), q = r % (I_WIN / 2); p0_transpose_item8(F.w_in + (size_t)l * DM * INW, INW, F.ws + WS_WIN + (size_t)l * INW * DM, DM, scr, q, F.lane); continue; } r -= I_WIN;
        if (r < 4 * I_SQ) { const int mtx = r / I_SQ, rr = r % I_SQ, l = rr / (I_SQ / 2), q = rr % (I_SQ / 2);
            const size_t mo = (size_t)l * DM * DM;
            if (mtx == 0) p0_transpose_item8(F.w_ao + mo, DM, F.ws + WS_W2 + (size_t)l * DM * 4096, 4096, scr, q, F.lane);
            else if (mtx == 1) p0_transpose_item8(F.w_co + mo, DM, F.ws + WS_W2 + (size_t)l * DM * 4096 + DM, 4096, scr, q, F.lane);
            else if (mtx == 2) p0_transpose_item8(F.w_o + mo, DM, F.ws + WS_WO + mo, DM, scr, q, F.lane);
            else p0_transpose_item(F.peer_wq + mo, DM, (bf16*)(F.ws + WS_WQ) + mo, DM, 0, scr, q, F.lane);
            continue; } r -= 4 * I_SQ;
        if (r < 2 * I_UV) { const int tb = r / I_UV, row = r % I_UV; p0_fp8_row((tb ? F.peer_v : F.peer_u) + (size_t)row * DM, F.ws + (tb ? WS_PV : WS_PU) + (size_t)(row / NEXP) * NEXP * DM + (size_t)(row % NEXP) * 128, (float*)(F.ws + (tb ? WS_SV : WS_SU)) + row, F.lane); continue; } r -= 2 * I_UV;
        { const int tb = r / I_KEY; p0_cvt_item(tb ? F.peer_k2 : F.peer_k1, (bf16*)(F.ws + (tb ? WS_K2B : WS_K1B)), (size_t)(r % I_KEY), F.lane); }
    }
}

__device__ __forceinline__ const float* xrow_ptr(const float* xlat, const float* xctx, int row) { return row < NLAT ? xlat + (size_t)row * DM : xctx + (size_t)(row - NLAT) * DM; }
template <bool IN16> __device__ __forceinline__ int row_col(int j, int lane) { return IN16 ? 8 * lane + 512 * (j >> 1) + 4 * (j & 1) : 4 * lane + 256 * j; }
template <bool IN16>
__device__ __forceinline__ void quant_row8(const v4f (&y)[8], unsigned char* orow8, float* hs, int lane) {
    float am = 0.f;
#pragma unroll
    for (int j = 0; j < 8; ++j) am = fmaxf(am, fmaxf(fmaxf(fabsf(y[j].x), fabsf(y[j].y)), fmaxf(fabsf(y[j].z), fabsf(y[j].w))));
#pragma unroll
    for (int o = 1; o < 64; o <<= 1) am = fmaxf(am, __shfl_xor(am, o));
    const float inv = am > 0.f ? 448.f / am : 0.f;
    if (lane == 0) *hs = am * (1.f / 448.f);
#pragma unroll
    for (int j = 0; j < 8; ++j) { int w = 0; w = __builtin_amdgcn_cvt_pk_fp8_f32(y[j].x * inv, y[j].y * inv, w, false); w = __builtin_amdgcn_cvt_pk_fp8_f32(y[j].z * inv, y[j].w * inv, w, true);
        *(GAS int*)(orow8 + row_col<IN16>(j, lane)) = w; }
}
template <bool IN16> __device__ __forceinline__ void load_row(v4f (&d)[8], const float* xlat, const float* xctx, const bf16* xs, int row, int lane) {
    if constexpr (IN16) { const GAS v4u* p = (const GAS v4u*)(xs + (size_t)row * DM) + lane;
#pragma unroll
        for (int j = 0; j < 4; ++j) { const v4u w = p[64 * j]; d[2 * j] = (v4f){bflo(w.x), bfhi(w.x), bflo(w.y), bfhi(w.y)}; d[2 * j + 1] = (v4f){bflo(w.z), bfhi(w.z), bflo(w.w), bfhi(w.w)}; }
    } else { const GAS v4f* xr = (const GAS v4f*)(row < NLAT ? xlat + (size_t)row * DM : xctx + (size_t)(row - NLAT) * DM) + lane;
#pragma unroll
        for (int j = 0; j < 8; ++j) d[j] = xr[64 * j]; }
}
template <int F8, bool IN16>
__device__ __forceinline__ void norm_phase(Frame& F, const float* xlat, const float* xctx, int nrows, int l, const float* g, int csh, int csc) {
    frame_refresh(F); asm volatile("" : "+s"(l));
    bf16* H = (bf16*)(F.ws + WS_H); const bf16* XS = (const bf16*)(F.ws + WS_XS);
    const float* modl = F.mod + (size_t)l * 5 * 12288; const float* bl = F.ada_b + (size_t)l * 12288;
    const int lane = F.lane;
    const int r0 = (int)(((long)F.gw * nrows) / F.NGW), r1 = (int)(((long)(F.gw + 1) * nrows) / F.NGW);
    if (r0 >= r1) return;
    v4f cur[8], nxt[8], Av[8], Bv[8]; int have = -1;
    load_row<IN16>(cur, xlat, xctx, XS, r0, lane);
    for (int row = r0; row < r1; ++row) {
        if (row + 1 < r1) load_row<IN16>(nxt, xlat, xctx, XS, row + 1, lane);
        const int mr = row < NLAT ? row / SEQ : 4;
        if (mr != have) { have = mr;
            const float* msh = modl + mr * 12288 + csh * DM; const float* msc = modl + mr * 12288 + csc * DM; const float* bsh = bl + csh * DM; const float* bsc = bl + csc * DM;
#pragma unroll
            for (int j = 0; j < 8; ++j) { const int cidx = row_col<IN16>(j, lane);
                Av[j] = *(const v4f*)(g + cidx) * (*(const v4f*)(msc + cidx) + *(const v4f*)(bsc + cidx) + 1.f); Bv[j] = *(const v4f*)(msh + cidx) + *(const v4f*)(bsh + cidx); } }
        float s = 0.f;
#pragma unroll
        for (int j = 0; j < 8; ++j) s += (cur[j].x * cur[j].x + cur[j].y * cur[j].y) + (cur[j].z * cur[j].z + cur[j].w * cur[j].w);
        const float rstd = rsqrtf(wave_sum(s) * (1.f / DM) + EPS);
        bf16* orow = H + (size_t)row * DM; v4f yv[8];
#pragma unroll
        for (int j = 0; j < 8; ++j) { const int cidx = row_col<IN16>(j, lane);
            const v4f y = (cur[j] * rstd) * Av[j] + Bv[j]; yv[j] = y;
            if (!F8) { v2u o; o.x = pk2(y.x, y.y); o.y = pk2(y.z, y.w); *(GAS v2u*)(orow + cidx) = o; } }
        if (F8) quant_row8<IN16>(yv, (unsigned char*)H + (size_t)row * DM, (float*)(F.ws + WS_HS) + row, lane);
#pragma unroll
        for (int j = 0; j < 8; ++j) cur[j] = nxt[j];
    }
}
__device__ __forceinline__ void unpack8(const v2u w, float (&f)[8]) {
    typedef float f2_t __attribute__((ext_vector_type(2))); const float k = 1.f / G8_SCALE;
    const f2_t a = __builtin_amdgcn_cvt_pk_f32_fp8((int)w.x, false), b = __builtin_amdgcn_cvt_pk_f32_fp8((int)w.x, true), c = __builtin_amdgcn_cvt_pk_f32_fp8((int)w.y, false), d = __builtin_amdgcn_cvt_pk_f32_fp8((int)w.y, true);
    f[0] = a.x * k; f[1] = a.y * k; f[2] = b.x * k; f[3] = b.y * k; f[4] = c.x * k; f[5] = c.y * k; f[6] = d.x * k; f[7] = d.y * k; }
__device__ __forceinline__ void unpack8(const v4u w, float (&f)[8]) { f[0] = bflo(w.x); f[1] = bfhi(w.x); f[2] = bflo(w.y); f[3] = bfhi(w.y); f[4] = bflo(w.z); f[5] = bfhi(w.z); f[6] = bflo(w.w); f[7] = bfhi(w.w); }
__device__ __forceinline__ v4u pack8(const float (&f)[8]) { v4u o; o.x = pk2(f[0], f[1]); o.y = pk2(f[2], f[3]); o.z = pk2(f[4], f[5]); o.w = pk2(f[6], f[7]); return o; }
__device__ __forceinline__ v2u pack8_fp8(const float (&f)[8], float scale) { float c[8];
#pragma unroll
    for (int i = 0; i < 8; ++i) c[i] = fminf(fmaxf(f[i] * scale, -448.f), 448.f);
    int w0 = 0, w1 = 0; w0 = __builtin_amdgcn_cvt_pk_fp8_f32(c[0], c[1], w0, false); w0 = __builtin_amdgcn_cvt_pk_fp8_f32(c[2], c[3], w0, true);
    w1 = __builtin_amdgcn_cvt_pk_fp8_f32(c[4], c[5], w1, false); w1 = __builtin_amdgcn_cvt_pk_fp8_f32(c[6], c[7], w1, true);
    v2u o; o.x = (unsigned)w0; o.y = (unsigned)w1; return o; }
template <class W>
__device__ __forceinline__ v2u head_norm_rope(const W in, const float (&g)[8], bool rope, const float (&cs)[8], const float (&sn)[8], bool second) {
    float f[8]; unpack8(in, f); float ss = 0.f;
#pragma unroll
    for (int i = 0; i < 8; ++i) ss += f[i] * f[i];
    ss = sum16(ss);
    const float rstd = rsqrtf(ss * (1.f / 128.f) + EPS);
#pragma unroll
    for (int i = 0; i < 8; ++i) f[i] = f[i] * rstd * g[i];
    if (rope) {
        float o[8];
#pragma unroll
        for (int i = 0; i < 8; ++i) { const float pv = __shfl_xor(f[i], 4); o[i] = second ? f[i] * cs[i] + pv * sn[i] : f[i] * cs[i] - pv * sn[i]; }
        return pack8_fp8(o, att::QK8);
    }
    return pack8_fp8(f, att::QK8);
}
template <int VARX = 0>
__device__ __forceinline__ void split_phase(Frame& F, int l, int nfull, int nrows) {
    frame_refresh(F); asm volatile("" : "+s"(l));
    const unsigned char* P = F.ws + WS_P;     unsigned char* A2 = F.ws + WS_A2; unsigned char* QB = F.ws + WS_Q; unsigned char* KB = F.ws + WS_KB; unsigned char* VT = F.ws + WS_VB;
    const int lane = F.lane, l16 = lane & 15;
    float qg[8], kg[8];
#pragma unroll
    for (int i = 0; i < 8; ++i) { qg[i] = F.q_norm_g[l * 128 + l16 * 8 + i]; kg[i] = F.k_norm_g[l * 128 + l16 * 8 + i]; }
    const bool second = (lane >> 2) & 1; const int blk = (lane >> 3) & 1;
    float inv[8];
#pragma unroll
    for (int i = 0; i < 8; ++i) inv[i] = __builtin_amdgcn_exp2f(-(float)((lane & 3) * 8 + i) * (13.287712379549449f / 32.f));
    const float* cw = F.conv_w + (size_t)l * 3 * DM;
    { int row = F.gw;
      if (row < nrows) {
        v2u cq[4], ck, nq[4], nk;
#define QK_LD(q_, k_, r_) do { const unsigned char* pr_ = P + (size_t)(r_) * INW + lane * 8; k_ = *(const GAS v2u*)(pr_ + C_K); \
        if ((r_) < nfull) { _Pragma("unroll") for (int p = 0; p < 4; ++p) q_[p] = *(const GAS v2u*)(pr_ + C_Q + p * 512); } } while (0)
        QK_LD(cq, ck, row);
        for (; row < nrows; row += F.NGW) {
            const int nr = row + F.NGW; if (nr < nrows) QK_LD(nq, nk, nr);
            const bool lat = row < NLAT; const int b = lat ? row / SEQ : (row - NLAT) / CTXL, t = lat ? row % SEQ : (row - NLAT) % CTXL;
            const size_t kvrow = (size_t)b * SKV + (lat ? t : SEQ + t);
            float cs[8], sn[8];
            if (lat) { const float pos = (float)(blk ? (t & 63) : (t >> 6));
#pragma unroll
                for (int i = 0; i < 8; ++i) { const float a = pos * inv[i]; cs[i] = __cosf(a); sn[i] = __sinf(a); } }
            else {
#pragma unroll
                for (int i = 0; i < 8; ++i) { cs[i] = 1.f; sn[i] = 0.f; } }
            *(GAS v2u*)(KB + kvrow * KVW + lane * 8) = head_norm_rope(ck, kg, lat, cs, sn, second);
            if (row < nfull) {
#pragma unroll
                for (int p = 0; p < 4; ++p) *(GAS v2u*)(QB + (size_t)row * DM + p * 512 + lane * 8) = head_norm_rope(cq[p], qg, lat, cs, sn, second); }
#pragma unroll
            for (int p = 0; p < 4; ++p) cq[p] = nq[p];
            ck = nk;
        }
#undef QK_LD
      }
    }
    {
        const float* cw = F.conv_w + (size_t)l * 3 * DM;
        const int r0 = (int)(((long)F.gw * nfull) / F.NGW), r1 = (int)(((long)(F.gw + 1) * nfull) / F.NGW);
        auto seqid = [](int r) { return r < NLAT ? r / SEQ : 4 + (r - NLAT) / CTXL; };
        if (r0 < r1)
        for (int pp = 0; pp < 2; ++pp) {
            float w0[2][8], w1[2][8], w2[2][8];
#pragma unroll
            for (int h = 0; h < 2; ++h)
#pragma unroll
                for (int i = 0; i < 8; ++i) { const int cc = (2 * pp + h) * 512 + lane * 8 + i; w0[h][i] = cw[cc]; w1[h][i] = cw[DM + cc]; w2[h][i] = cw[2 * DM + cc]; }
            const unsigned char* pc = P + (2 * pp) * 512 + lane * 8;
#define CV_LD(U_, G_, B_, r_) do { const unsigned char* q_ = pc + (size_t)(r_) * INW; _Pragma("unroll") for (int h = 0; h < 2; ++h) { U_[h] = *(const GAS v2u*)(q_ + h * 512 + C_U); G_[h] = *(const GAS v2u*)(q_ + h * 512 + C_GC); B_[h] = *(const GAS v2u*)(q_ + h * 512 + C_GB); } } while (0)
            float mp[2][8], mc[2][8], f0[8], f1[8];
            v2u un[2], gn[2], bn_[2], u2[2], g2[2], b2[2], bc[2];
            const bool hp0 = r0 > 0 && seqid(r0 - 1) == seqid(r0);
            { v2u a[2], g[2], bb[2]; CV_LD(a, g, bb, hp0 ? r0 - 1 : r0);
#pragma unroll
              for (int h = 0; h < 2; ++h) { unpack8(a[h], f0); unpack8(g[h], f1);
#pragma unroll
                for (int i = 0; i < 8; ++i) mp[h][i] = hp0 ? f0[i] * f1[i] : 0.f; } }
            { v2u a[2], g[2]; CV_LD(a, g, bc, r0);
#pragma unroll
              for (int h = 0; h < 2; ++h) { unpack8(a[h], f0); unpack8(g[h], f1);
#pragma unroll
                for (int i = 0; i < 8; ++i) mc[h][i] = f0[i] * f1[i]; } }
            const int rlast = nfull - 1;
            CV_LD(un, gn, bn_, min(r0 + 1, rlast));
            for (int row = r0; row < r1; ++row) {
                CV_LD(u2, g2, b2, min(row + 2, rlast));
                const int sid = seqid(row); const bool hp = row > 0 && seqid(row - 1) == sid, hn = row + 1 < nfull && seqid(row + 1) == sid;
#pragma unroll
                for (int h = 0; h < 2; ++h) { float mn[8], gb[8], o[8]; unpack8(un[h], f0); unpack8(gn[h], f1); unpack8(bc[h], gb);
#pragma unroll
                    for (int i = 0; i < 8; ++i) mn[i] = f0[i] * f1[i];
#pragma unroll
                    for (int i = 0; i < 8; ++i) o[i] = gb[i] * (w0[h][i] * (hp ? mp[h][i] : 0.f) + w1[h][i] * mc[h][i] + w2[h][i] * (hn ? mn[i] : 0.f));
                    *(GAS v2u*)(A2 + (size_t)row * 4096 + 2048 + (2 * pp + h) * 512 + lane * 8) = pack8_fp8(o, CV8_SCALE);
#pragma unroll
                    for (int i = 0; i < 8; ++i) { mp[h][i] = mc[h][i]; mc[h][i] = mn[i]; }
                    bc[h] = bn_[h]; un[h] = u2[h]; gn[h] = g2[h]; bn_[h] = b2[h]; }
            }
#undef CV_LD
        }
    }
    { LAS unsigned char* Vt = F.lds; const int tid = F.tid, wave = F.wave;
      for (int T = F.vcu; T < BATCH * (SKV / 64); T += F.G) {
        const int b = T / (SKV / 64), tile = T % (SKV / 64);
#pragma unroll
        for (int j = 0; j < 8; ++j) { const int i = wave * 8 + j, kk = tile * 64 + i; const size_t row = kk < SEQ ? (size_t)b * SEQ + kk : (size_t)NLAT + b * CTXL + (kk - SEQ);
            float f[8]; unpack8(*(const GAS v2u*)(P + row * INW + C_V + lane * 8), f);
            *(LAS v2u*)(Vt + i * 512 + lane * 8) = pack8_fp8(f, att::V8); }
        LDS_WAIT(); __syncthreads();
#pragma unroll
        for (int n = 0; n < 4; ++n) { const int c = tid + 512 * n, d = c & 127, rest = c >> 7, jj = rest & 1, hh = (rest >> 1) & 1, kvh = rest >> 2;
            v4u w;
#pragma unroll
            for (int q = 0; q < 4; ++q) { unsigned x = 0u;
#pragma unroll
                for (int e = 0; e < 4; ++e) { const int i = 4 * q + e, key = jj * 32 + (i & 3) + 8 * (i >> 2) + 4 * hh; x |= (unsigned)Vt[key * 512 + kvh * 128 + d] << (8 * e); }
                w[q] = x; }
            *(GAS v4u*)(VT + ((size_t)(b * (SKV / 64) + tile) * 4 + kvh) * 8192 + d * 64 + ((((hh * 2 + jj) ^ ((d >> 2) & 3))) << 4)) = w; }
        __syncthreads();
      }
    }
}
__device__ __forceinline__ void attn_phase(Frame& F, bool with_ctx, bool dry = false) {
    frame_refresh(F);
    unsigned char* A2 = F.ws + WS_A2; const unsigned char* Q = F.ws + WS_Q; const unsigned char* KB = F.ws + WS_KB; const unsigned char* VT = F.ws + WS_VB;
    const int nunits = 1024 + (with_ctx ? 64 : 0);
    for (int u = F.vcu; u < nunits; u += F.G) {
        size_t row0, ko, vo; int seq, h;
        if (u < 1024) { const int b = u >> 8, kvh = (u >> 6) & 3, g = (u >> 4) & 3, qb = u & 15; h = kvh * 4 + g;
            row0 = (size_t)b * SEQ + qb * 256; ko = (size_t)b * SKV * KVW + kvh * 128; vo = ((size_t)b * (SKV / 64) * 4 + kvh) * 8192; seq = SKV;
        } else { const int v = u - 1024, b = v >> 4; h = v & 15; const int kvh = h >> 2;
            row0 = (size_t)NLAT + b * CTXL; ko = ((size_t)b * SKV + SEQ) * KVW + kvh * 128; vo = ((size_t)(b * (SKV / 64) + SEQ / 64) * 4 + kvh) * 8192; seq = CTXL; }
        unsigned char* od = dry ? F.ws + 404 * MiB + row0 * 2048 + h * 128 : A2 + row0 * 4096 + h * 128;
        att::attn_dense_body(Q + row0 * DM + h * 128, KB + ko, VT + vo, od, dry ? 2048 : 4096, AT8_SCALE, seq, (char*)F.ldsg);
    }
}
__device__ __forceinline__ unsigned f2ord(float f) { const unsigned u = __float_as_uint(f); return u ^ ((u >> 31) ? 0xFFFFFFFFu : 0x80000000u); }
__device__ __forceinline__ float ord2f(unsigned o) { return __uint_as_float(o ^ ((o >> 31) ? 0x80000000u : 0xFFFFFFFFu)); }
typedef short s16x8 __attribute__((ext_vector_type(8)));
typedef float f32x16 __attribute__((ext_vector_type(16)));
__device__ __forceinline__ int crow16(int r, int hi) { return (r & 3) + 8 * (r >> 2) + 4 * hi; }
__device__ __forceinline__ unsigned max16u(unsigned v) {
    v = max(v, dppu<DPP_X1>(v)); v = max(v, dppu<DPP_X2>(v)); v = max(v, dppu<DPP_HMIR>(v)); v = max(v, dppu<DPP_MIR>(v)); return v;
}
#define CSWAP(a_, b_) do { const unsigned hi_ = max(a_, b_), lo_ = min(a_, b_); a_ = hi_; b_ = lo_; } while (0)
__device__ __forceinline__ void topk_phase(Frame& F, int l, int nrows) {
    frame_refresh(F); asm volatile("" : "+s"(l));
    const bf16* PQ = (const bf16*)(F.ws + WS_PQ);
    const bf16* K1 = (const bf16*)(F.ws + WS_K1B) + (size_t)l * 8 * 128 * 128; const bf16* K2 = (const bf16*)(F.ws + WS_K2B) + (size_t)l * 8 * 128 * 128;
    int* IDX = (int*)(F.ws + WS_IDX); float* GW = (float*)(F.ws + WS_GW);
    LAS float* S = (LAS float*)(F.lds + F.wave * 18688);
    LAS unsigned* T1 = (LAS unsigned*)(F.lds + F.wave * 18688 + 16384);
    LAS unsigned* T2 = T1 + 512;
    const int lane = F.lane, r32 = lane & 31, hi = lane >> 5, l16 = lane & 15, qd = lane >> 4;
    int ct[4] = {0xFF, 0xFF, 0xFF, 0xFF};
    { int cnt = 0;
      for (int i = 0; i < 16; ++i) for (int j = 0; j < 16; ++j) if ((i + 1) * (j + 1) <= 16) {
#pragma unroll
          for (int s = 0; s < 4; ++s) if (cnt == l16 * 4 + s) ct[s] = (i << 4) | j;
          ++cnt; } }
    const int nitems = (nrows / 32) * 8;
    for (int it = F.gw; it < nitems; it += F.NGW) {
        const int h = it & 7, tok0 = (it >> 3) * 32;
        for (int half = 0; half < 2; ++half) {
            f32x16 acc[4];
#pragma unroll
            for (int nb = 0; nb < 4; ++nb) acc[nb] = (f32x16){};
            const bf16* qp = PQ + (size_t)(tok0 + r32) * DM + h * 256 + half * 128 + hi * 8;
            const bf16* kp = (half ? K2 : K1) + ((size_t)h * 128 + r32) * 128 + hi * 8;
#pragma unroll
            for (int d0 = 0; d0 < 8; ++d0) { const s16x8 a = *(const GAS s16x8*)(qp + d0 * 16);
#pragma unroll
                for (int nb = 0; nb < 4; ++nb) { const s16x8 bb = *(const GAS s16x8*)(kp + (size_t)nb * 32 * 128 + d0 * 16); acc[nb] = __builtin_amdgcn_mfma_f32_32x32x16_bf16(a, bb, acc[nb], 0, 0, 0); } }
#pragma unroll
            for (int nb = 0; nb < 4; ++nb)
#pragma unroll
                for (int r = 0; r < 16; ++r) S[crow16(r, hi) * 128 + nb * 32 + r32] = acc[nb][r];
            LDS_WAIT();
            for (int ps = 0; ps < 8; ++ps) {
                const int tok = ps * 4 + qd;
                unsigned k[8];
#pragma unroll
                for (int j = 0; j < 8; ++j) k[j] = (f2ord(S[tok * 128 + j * 16 + l16]) & ~127u) | (unsigned)(127 - (j * 16 + l16));
                CSWAP(k[0], k[1]); CSWAP(k[2], k[3]); CSWAP(k[4], k[5]); CSWAP(k[6], k[7]);
                CSWAP(k[0], k[2]); CSWAP(k[1], k[3]); CSWAP(k[4], k[6]); CSWAP(k[5], k[7]);
                CSWAP(k[1], k[2]); CSWAP(k[5], k[6]); CSWAP(k[0], k[4]); CSWAP(k[3], k[7]);
                CSWAP(k[1], k[5]); CSWAP(k[2], k[6]);
                CSWAP(k[1], k[4]); CSWAP(k[3], k[6]);
                CSWAP(k[2], k[4]); CSWAP(k[3], k[5]);
                CSWAP(k[3], k[4]);
                unsigned mine = 0u;
                for (int rnd = 0; rnd < 16; ++rnd) {
                    const unsigned m = max16u(k[0]);
                    if (l16 == rnd) mine = m;
                    const bool pop = (k[0] == m);
#pragma unroll
                    for (int j = 0; j < 7; ++j) k[j] = pop ? k[j + 1] : k[j];
                    k[7] = pop ? 0u : k[7];
                }
                if (half == 0) T1[tok * 16 + l16] = mine;
                else {
                    T2[qd * 16 + l16] = mine;
                    LDS_WAIT();
                    unsigned ck[4];
#pragma unroll
                    for (int s = 0; s < 4; ++s) { const int i = (ct[s] >> 4) & 15, j = ct[s] & 15;
                        const float c = ord2f(T1[tok * 16 + i] & ~127u) + ord2f(T2[qd * 16 + j] & ~127u);
                        ck[s] = (ct[s] == 0xFF) ? 0u : ((f2ord(c) & ~255u) | (unsigned)(255 - ct[s])); }
                    CSWAP(ck[0], ck[1]); CSWAP(ck[2], ck[3]); CSWAP(ck[0], ck[2]); CSWAP(ck[1], ck[3]); CSWAP(ck[1], ck[2]);
                    unsigned win = 0u, m0 = 0u;
                    for (int rnd = 0; rnd < 16; ++rnd) {
                        const unsigned m = max16u(ck[0]);
                        if (rnd == 0) m0 = m;
                        if (l16 == rnd) win = m;
                        const bool pop = (ck[0] == m);
                        ck[0] = pop ? ck[1] : ck[0]; ck[1] = pop ? ck[2] : ck[1]; ck[2] = pop ? ck[3] : ck[2]; ck[3] = pop ? 0u : ck[3];
                    }
                    const float sv = ord2f(win & ~255u), smax = ord2f(m0 & ~255u);
                    const int ij = 255 - (int)(win & 255u), ci = (ij >> 4) & 15, cj = ij & 15;
                    const int e = (127 - (int)(T1[tok * 16 + ci] & 127u)) * 128 + (127 - (int)(T2[qd * 16 + cj] & 127u));
                    const float p = __expf(sv - smax);
                    const float den = sum16(p);
                    { const size_t o = (size_t)(tok0 + tok) * 128 + h * 16 + l16; IDX[o] = e; GW[o] = p / den; }
                    LDS_WAIT();
                }
            }
        }
    }
}
#undef CSWAP

typedef float f32x2_t __attribute__((ext_vector_type(2)));
constexpr int NSL = 16;
constexpr size_t WS_PART = WS_P + 96 * MiB, WS_WT = WS_P + 240 * MiB, WS_SSQ = WS_P + 250 * MiB;
#define PS_IDX2(dst, src, tok_) do { const GAS unsigned* p_ = (const GAS unsigned*)((src) + (size_t)(tok_) * 128 + grp * 16 + c8); dst[0] = p_[0]; dst[1] = p_[8]; } while (0)
#define PS_BC(v, II) __builtin_amdgcn_ds_swizzle((int)(v), ((II) << 5) | 0x18)
#define PS_LD1(buf, II, ev_) { const unsigned e_ = (unsigned)PS_BC(ev_, II); buf[II] = *(const GAS v4u*)(tbl + ((MODE == 2 ? (e_ & 63u) : e_) * 128u + loff)); }
#define PS_LOAD(buf, ev, C_) do { const unsigned ev_ = ev[C_]; PS_LD1(buf, 0, ev_) PS_LD1(buf, 1, ev_) PS_LD1(buf, 2, ev_) PS_LD1(buf, 3, ev_) PS_LD1(buf, 4, ev_) PS_LD1(buf, 5, ev_) PS_LD1(buf, 6, ev_) PS_LD1(buf, 7, ev_) } while (0)
template <int MODE>
__device__ __forceinline__ void peer_up_phase(Frame& F, int l, int nrows) {
    frame_refresh(F); asm volatile("" : "+s"(l));
    const int lane = F.lane, grp = lane >> 3, c8 = lane & 7;
    const int xg = blockIdx.x & 7, wg = (blockIdx.x >> 3) * NWAVES + F.wave, nwg = (F.G >> 3) * NWAVES;
    const unsigned char* tbl = F.ws + WS_PU + (size_t)l * NEXP * DM;
    const unsigned* IDX = (const unsigned*)(F.ws + WS_IDX); const bf16* H = (const bf16*)(F.ws + WS_H); bf16* PART = (bf16*)(F.ws + WS_PART);
    for (int sub = 0; sub < 2; ++sub) {
        const int slice = xg + 8 * sub; const unsigned loff = (unsigned)(slice * (NEXP * 128) + c8 * 16);
        int tok = wg; if (tok >= nrows) continue;
        unsigned e0[2], e1[2], e2[2], h0, h1 = 0u; v4u bufA[8], bufB[8];
        const GAS unsigned* H32 = (const GAS unsigned*)H + slice * 64 + lane;
        PS_IDX2(e0, IDX, tok); h0 = H32[(size_t)tok * (DM / 2)];
        if (tok + nwg < nrows) PS_IDX2(e1, IDX, tok + nwg); else { e1[0] = e0[0]; e1[1] = e0[1]; }
        PS_LOAD(bufA, e0, 0);
        for (; tok < nrows; tok += nwg) {
            const int t1 = tok + nwg, t2 = tok + 2 * nwg;
            if (t2 < nrows) PS_IDX2(e2, IDX, t2);
            if (t1 < nrows) h1 = H32[(size_t)t1 * (DM / 2)];
            PS_LOAD(bufB, e0, 1);
            f32x2_t hf[8];
#pragma unroll
            for (int k = 0; k < 8; ++k) { const unsigned w = (unsigned)__builtin_amdgcn_ds_bpermute((c8 * 8 + k) * 4, (int)h0); hf[k] = (f32x2_t){bflo(w), bfhi(w)}; }
            float keep[2] = {0.f, 0.f};
#define PS_UPCOMP(buf, C_) do { _Pragma("unroll") for (int ii = 0; ii < 8; ++ii) { const v4u uv = buf[ii]; f32x2_t s0 = {0.f, 0.f}, s1 = {0.f, 0.f}; \
                if (MODE == 1) { s0.x = __uint_as_float((uv.x ^ uv.y) & 0x3fffffffu); s1.x = __uint_as_float((uv.z ^ uv.w) & 0x3fffffffu); } else { \
                _Pragma("unroll") for (int q = 0; q < 4; ++q) { const f32x2_t lo = __builtin_amdgcn_cvt_pk_f32_fp8((int)uv[q], false), hi = __builtin_amdgcn_cvt_pk_f32_fp8((int)uv[q], true); \
                    s0 += lo * hf[q * 2]; s1 += hi * hf[q * 2 + 1]; } } \
                s0 += s1; float d = s0.x + s0.y; d += dppf<DPP_X1>(d); d += dppf<DPP_X2>(d); d += dppf<DPP_HMIR>(d); \
                if (c8 == ii) keep[C_] = d; } } while (0)
            PS_UPCOMP(bufA, 0);
            if (t1 < nrows) PS_LOAD(bufA, e1, 0);
            PS_UPCOMP(bufB, 1);
            bf16* pp = PART + ((size_t)slice * MALL + tok) * 128 + grp * 16 + c8;
            pp[0] = (bf16)f2bf(keep[0]); pp[8] = (bf16)f2bf(keep[1]);
            e0[0] = e1[0]; e0[1] = e1[1]; e1[0] = e2[0]; e1[1] = e2[1]; h0 = h1;
        }
    }
}
__device__ __forceinline__ void peer_combine_phase(Frame& F, int l, int nrows) {
    frame_refresh(F); asm volatile("" : "+s"(l));
    const bf16* PART = (const bf16*)(F.ws + WS_PART); const int* IDX = (const int*)(F.ws + WS_IDX); const float* GW = (const float*)(F.ws + WS_GW); float* WT = (float*)(F.ws + WS_WT);
    const float* SU = (const float*)(F.ws + WS_SU) + (size_t)l * NEXP; const float* SV = (const float*)(F.ws + WS_SV) + (size_t)l * NEXP;
    const int n = nrows * 128, step = F.NGW * 64;
    for (int i = F.gw * 64 + F.lane; i < n; i += 2 * step) {
        const int i2 = i + step; const bool h2 = i2 < n;
        float d = 0.f, dd = 0.f;
#pragma unroll
        for (int s = 0; s < NSL; ++s) { d += __uint_as_float((unsigned)PART[(size_t)s * MALL * 128 + i] << 16); if (h2) dd += __uint_as_float((unsigned)PART[(size_t)s * MALL * 128 + i2] << 16); }
        const int e = IDX[i]; const int e2 = h2 ? IDX[i2] : 0;
        const float a = gelu_erf(d * SU[e]) * GW[i] * SV[e];
        WT[i] = a;
        if (h2) WT[i2] = gelu_erf(dd * SU[e2]) * GW[i2] * SV[e2];
    }
}
template <int MODE>
__device__ __forceinline__ void peer_down_phase(Frame& F, int l, int nrows) {
    frame_refresh(F); asm volatile("" : "+s"(l));
    const int lane = F.lane, grp = lane >> 3, c8 = lane & 7;
    const bool b4 = (lane >> 4) & 1, b3 = (lane >> 3) & 1;
    const int xg = blockIdx.x & 7, wg = (blockIdx.x >> 3) * NWAVES + F.wave, nwg = (F.G >> 3) * NWAVES;
    const unsigned char* tbl = F.ws + WS_PV + (size_t)l * NEXP * DM;
    const unsigned* IDX = (const unsigned*)(F.ws + WS_IDX); const unsigned* WT = (const unsigned*)(F.ws + WS_WT); float* SSQ = (float*)(F.ws + WS_SSQ);
    bf16* XS = (bf16*)(F.ws + WS_XS);
    const float* modl = F.mod + (size_t)l * 5 * 12288 + 5 * DM; const float* bl = F.ada_b + (size_t)l * 12288 + 5 * DM;
    for (int sub = 0; sub < 2; ++sub) {
        const int slice = xg + 8 * sub; const unsigned loff = (unsigned)(slice * (NEXP * 128) + c8 * 16);
        int tok = wg; if (tok >= nrows) continue;
        unsigned e0[2], e1[2], e2[2], w0[2], w1[2], w2[2]; v4u bufA[8], bufB[8];
        PS_IDX2(e0, IDX, tok); PS_IDX2(w0, WT, tok);
        if (tok + nwg < nrows) { PS_IDX2(e1, IDX, tok + nwg); PS_IDX2(w1, WT, tok + nwg); } else { e1[0] = e0[0]; e1[1] = e0[1]; w1[0] = w0[0]; w1[1] = w0[1]; }
        PS_LOAD(bufA, e0, 0);
        for (; tok < nrows; tok += nwg) {
            const int t1 = tok + nwg, t2 = tok + 2 * nwg;
            if (t2 < nrows) { PS_IDX2(e2, IDX, t2); PS_IDX2(w2, WT, t2); }
            PS_LOAD(bufB, e0, 1);
            f32x2_t o2[8];
#pragma unroll
            for (int i = 0; i < 8; ++i) o2[i] = (f32x2_t){0.f, 0.f};
#define PS_DN1(buf, II, wv_) { const v4u vv = buf[II]; const float w = __uint_as_float((unsigned)PS_BC(wv_, II)); \
                if (MODE == 1) { o2[0].x += w * __uint_as_float((vv.x ^ vv.y) & 0x3fffffffu); o2[0].y += w * __uint_as_float((vv.z ^ vv.w) & 0x3fffffffu); } else { \
                _Pragma("unroll") for (int q = 0; q < 4; ++q) { const f32x2_t lo = __builtin_amdgcn_cvt_pk_f32_fp8((int)vv[q], false), hi = __builtin_amdgcn_cvt_pk_f32_fp8((int)vv[q], true); \
                    o2[q * 2] += lo * w; o2[q * 2 + 1] += hi * w; } } }
#define PS_DNCOMP(buf, C_) do { const unsigned wv_ = w0[C_]; PS_DN1(buf, 0, wv_) PS_DN1(buf, 1, wv_) PS_DN1(buf, 2, wv_) PS_DN1(buf, 3, wv_) PS_DN1(buf, 4, wv_) PS_DN1(buf, 5, wv_) PS_DN1(buf, 6, wv_) PS_DN1(buf, 7, wv_) } while (0)
            PS_DNCOMP(bufA, 0);
            if (t1 < nrows) PS_LOAD(bufA, e1, 0);
            PS_DNCOMP(bufB, 1);
            float o[16];
#pragma unroll
            for (int i = 0; i < 8; ++i) { o[2 * i] = o2[i].x; o[2 * i + 1] = o2[i].y; }
            float r1[8], r2[4], r3[2];
#pragma unroll
            for (int k = 0; k < 8; ++k) { auto rr = __builtin_amdgcn_permlane32_swap(__float_as_uint(o[k]), __float_as_uint(o[k + 8]), false, false); r1[k] = __uint_as_float(rr[0]) + __uint_as_float(rr[1]); }
#pragma unroll
            for (int k = 0; k < 4; ++k) { const float keep = b4 ? r1[k + 4] : r1[k], send = b4 ? r1[k] : r1[k + 4]; r2[k] = keep + __shfl_xor(send, 16); }
#pragma unroll
            for (int k = 0; k < 2; ++k) { const float keep = b3 ? r2[k + 2] : r2[k], send = b3 ? r2[k] : r2[k + 2]; r3[k] = keep + dppf<DPP_ROR8>(send); }
            const int mr = tok < NLAT ? tok / SEQ : 4; const int col = slice * 128 + c8 * 16 + grp * 2;
            GAS unsigned* xr = (GAS unsigned*)(XS + (size_t)tok * DM + col);
            const unsigned xw = *xr; const f32x2_t xv = {bflo(xw), bfhi(xw)}, gg = *(const f32x2_t*)(modl + mr * 12288 + col) + *(const f32x2_t*)(bl + col);
            const f32x2_t x2f = xv + gg * (f32x2_t){r3[0], r3[1]};
            const unsigned xo = pk2(x2f.x, x2f.y); const f32x2_t x2 = {bflo(xo), bfhi(xo)};
            if (MODE == 0) *xr = xo;
            const float ss = wave_sum(x2.x * x2.x + x2.y * x2.y);
            if (MODE == 0) { if (lane == 0) SSQ[(size_t)slice * MALL + tok] = ss; }
            else if (lane == 0) ((float*)(F.ws + WS_MODP))[(F.gw & 511) * 64] = ss;
            e0[0] = e1[0]; e0[1] = e1[1]; e1[0] = e2[0]; e1[1] = e2[1]; w0[0] = w1[0]; w0[1] = w1[1]; w1[0] = w2[0]; w1[1] = w2[1];
        }
    }
}
#undef PS_IDX2
#undef PS_BC
#undef PS_LD1
#undef PS_DN1
#undef PS_LOAD
#undef PS_UPCOMP
#undef PS_DNCOMP
__device__ __forceinline__ void post_norm_phase(Frame& F, int l, int nrows, bool last) {
    frame_refresh(F); asm volatile("" : "+s"(l));
    bf16* H = (bf16*)(F.ws + WS_H); const float* SSQ = (const float*)(F.ws + WS_SSQ); const bf16* XS = (const bf16*)(F.ws + WS_XS);
    const float* modn = F.mod + (size_t)(l + 1) * 5 * 12288; const float* bn = F.ada_b + (size_t)(l + 1) * 12288;
    const int lane = F.lane;
    const bool bad = last && __hip_atomic_load((unsigned*)(F.ws + WS_CTL) + 24, __ATOMIC_RELAXED, __HIP_MEMORY_SCOPE_AGENT) != 0u;
    const int r0 = (int)(((long)F.gw * nrows) / F.NGW), r1 = (int)(((long)(F.gw + 1) * nrows) / F.NGW);
    if (r0 >= r1) return;
    v4f cur[8], nxt[8], Av[8], Bv[8]; float scur, snxt = 0.f; int have = -1;
    load_row<true>(cur, nullptr, nullptr, XS, r0, lane); scur = (lane < NSL) ? SSQ[(size_t)lane * MALL + r0] : 0.f;
    for (int row = r0; row < r1; ++row) {
        if (row + 1 < r1) { load_row<true>(nxt, nullptr, nullptr, XS, row + 1, lane); snxt = (lane < NSL) ? SSQ[(size_t)lane * MALL + row + 1] : 0.f; }
        const int mr = row < NLAT ? row / SEQ : 4;
        if (mr != have) { have = mr;
#pragma unroll
            for (int j = 0; j < 8; ++j) { const int cidx = row_col<true>(j, lane);
                if (!last) { Av[j] = *(const v4f*)(F.norm1_g + (size_t)(l + 1) * DM + cidx) * (*(const v4f*)(modn + mr * 12288 + DM + cidx) + *(const v4f*)(bn + DM + cidx) + 1.f);
                    Bv[j] = *(const v4f*)(modn + mr * 12288 + cidx) + *(const v4f*)(bn + cidx); }
                else { Av[j] = *(const v4f*)(F.final_g + cidx); Bv[j] = (v4f){0.f, 0.f, 0.f, 0.f}; } } }
        const float rstd = rsqrtf(wave_sum(scur) * (1.f / DM) + EPS);
        v4f yv[8];
#pragma unroll
        for (int j = 0; j < 8; ++j) { const int cidx = row_col<true>(j, lane); yv[j] = (cur[j] * rstd) * Av[j] + Bv[j];
            if (last) *(GAS v4f*)(F.out + (size_t)row * DM + cidx) = bad ? (v4f){0.f, 0.f, 0.f, 0.f} : yv[j]; }
        if (!last) quant_row8<true>(yv, (unsigned char*)H + (size_t)row * DM, (float*)(F.ws + WS_HS) + row, lane);
#pragma unroll
        for (int j = 0; j < 8; ++j) cur[j] = nxt[j];
        scur = snxt;
    }
}
__device__ __forceinline__ bool mfma8_selftest(int lane) {
    typedef int v8i_t __attribute__((ext_vector_type(8)));
    const int idx = lane & 15, kb = lane >> 4;
    v8i_t X, Y;
#pragma unroll
    for (int w = 0; w < 8; ++w) { float xa[4], yb[4];
#pragma unroll
        for (int t = 0; t < 4; ++t) { const int k = 32 * kb + 4 * w + t; xa[t] = (float)(((idx * 3 + k * 5) % 7) - 3); yb[t] = (float)(((k * 2 + idx * 7) % 5) - 2); }
        int xw = 0, yw = 0; xw = __builtin_amdgcn_cvt_pk_fp8_f32(xa[0], xa[1], xw, false); xw = __builtin_amdgcn_cvt_pk_fp8_f32(xa[2], xa[3], xw, true);
        yw = __builtin_amdgcn_cvt_pk_fp8_f32(yb[0], yb[1], yw, false); yw = __builtin_amdgcn_cvt_pk_fp8_f32(yb[2], yb[3], yw, true); X[w] = xw; Y[w] = yw; }
    v4f d = {0.f, 0.f, 0.f, 0.f};
    d = __builtin_amdgcn_mfma_scale_f32_16x16x128_f8f6f4(X, Y, d, 0, 0, 0, 0x7F7F7F7F, 0, 0x7F7F7F7F);
    bool ok = true;
#pragma unroll
    for (int r = 0; r < 4; ++r) { const int i = 4 * kb + r, j = idx; int e = 0;
        for (int k = 0; k < 128; ++k) e += (((i * 3 + k * 5) % 7) - 3) * (((k * 2 + j * 7) % 5) - 2);
        ok = ok && (d[r] == (float)e); }
    return __all(ok);
}
struct Args { const float* in[22]; float* out; unsigned char* ws; int ph_lo, ph_hi, use_bar, pad; };
__global__ void __launch_bounds__(NWAVES * 64, 2) mk_fwd(Args args) {
    extern __shared__ __attribute__((aligned(16))) unsigned char lds[];
    Frame F;
    F.lds = (LAS unsigned char*)lds; F.ldsg = lds;
    F.tid = threadIdx.x; F.lane = F.tid & 63; F.wave = __builtin_amdgcn_readfirstlane(F.tid >> 6);
    F.G = gridDim.x; { const int bx = blockIdx.x; F.vcu = (F.G % 8 == 0) ? (bx % 8) * (F.G / 8) + bx / 8 : bx; }
    F.gw = F.vcu * NWAVES + F.wave; F.NGW = F.G * NWAVES;
    F.x = args.in[0]; F.c = args.in[1]; F.ctx = args.in[2]; F.c_ctx = args.in[3]; F.ada_w = args.in[4]; F.ada_b = args.in[5]; F.norm1_g = args.in[6]; F.norm2_g = args.in[7];
    F.w_in = args.in[8]; F.b_gate = args.in[9]; F.q_norm_g = args.in[10]; F.k_norm_g = args.in[11]; F.conv_w = args.in[12]; F.w_ao = args.in[13]; F.w_co = args.in[14]; F.w_o = args.in[15];
    F.peer_wq = args.in[16]; F.peer_k1 = args.in[17]; F.peer_k2 = args.in[18]; F.peer_u = args.in[19]; F.peer_v = args.in[20]; F.final_g = args.in[21];
    F.out = args.out; F.ws = args.ws; F.mod = (float*)(args.ws + WS_CTL + CTL_MOD);
    volatile LAS unsigned* MISC = (volatile LAS unsigned*)(F.lds + MISC_OFF);
    for (int u = F.tid; u < (LDS_BYTES - MISC_OFF) / 4; u += NWAVES * 64) MISC[u] = 0u;
    __syncthreads();
    XcdBarrier bar; bar.bar = (unsigned*)(args.ws + WS_CTL) + CW_BAR; bar.x = 0; bar.st = nullptr;
    if (args.use_bar) bar = xcd_barrier_post((unsigned*)(args.ws + WS_CTL) + CW_BAR, MISC + 8);
    const int lo = args.ph_lo, hi = args.ph_hi;
#ifndef PHASE_MASK
#define PHASE_MASK 0xFFFFFFFFu
#endif
#define PHK(k) ((k) < 3 ? (k) : 3 + ((k) - 3) % NPH_LAYER)
#define IN(k) (((PHASE_MASK >> PHK(k)) & 1u) && lo <= (k) && (k) < hi)
#define SEAM(k) do { if (IN(k) && IN((k) + 1)) xcd_barrier(bar); } while (0)
    bf16* H = (bf16*)(F.ws + WS_H); bf16* P = (bf16*)(F.ws + WS_P); bf16* A2 = (bf16*)(F.ws + WS_A2); bf16* XS = (bf16*)(F.ws + WS_XS);

#if PROBE_DUP & 0x200
    if (IN(0)) { p0_prologue(F); __syncthreads(); }
#endif
    if (IN(0) && blockIdx.x == 0 && F.wave == 0) { if (!mfma8_selftest(F.lane) && F.lane == 0) __hip_atomic_store((unsigned*)(args.ws + WS_CTL) + 24, 1u, __ATOMIC_RELAXED, __HIP_MEMORY_SCOPE_AGENT); }
    if (IN(0)) { p0_prologue(F); __syncthreads(); } SEAM(0);
    if (IN(1)) { mod_reduce_phase(F); } SEAM(1);
    if (IN(2)) { norm_phase<1, false>(F, F.x, F.ctx, MALL, 0, F.norm1_g, 0, 1); } SEAM(2);
    for (int l = 0; l < 2; ++l) {
        const int base = 3 + NPH_LAYER * l, Ml = (l == 0) ? MALL : NLAT;
        if (IN(base + 0)) {
            pg8::Gemm g{H, (const bf16*)(F.ws + WS_WIN + (size_t)l * INW * DM), Ml, INW, DM / 2}; pg8::OrderX S; S.init(Ml, INW, F.G, (int)blockIdx.x, l == 1 ? 16 : 0);
            pg8::EpiStore8 E{F.ws + WS_P, INW, (const float*)(F.ws + WS_HS), G8_SCALE / W8_SCALE};
            for (int rep = 0; rep < ((PROBE_DUP & 0x1) ? 2 : 1); ++rep) pg8::gemm_phase<pg8::EpiStore8, pg8::OrderX, true, true, true>(F.lds, g, S, E);
        } SEAM(base + 0);
#if PROBE_DUP & 0x2
        if (IN(base + 1)) { split_phase(F, l, Ml, MALL); }
#endif
        if (IN(base + 1)) { split_phase(F, l, Ml, MALL); } SEAM(base + 1);
#if PROBE_DUP & 0x4
        if (IN(base + 2)) { attn_phase(F, l == 0, true); }
#endif
        if (IN(base + 2)) { attn_phase(F, l == 0); } SEAM(base + 2);
        if (IN(base + 3)) {
            pg8::Gemm g{(const bf16*)(F.ws + WS_A2), (const bf16*)(F.ws + WS_W2 + (size_t)l * DM * 4096), Ml, DM, 2048}; pg8::OrderX S; S.init(Ml, DM, F.G, (int)blockIdx.x, 0);
            pg8::EpiGate<true> E{H, DM  , MG8_SCALE, CV8_SCALE / AT8_SCALE, 1.f / (CV8_SCALE * W8_SCALE), (const unsigned char*)P, INW, C_GA, C_GA + 2048, 1.f / G8_SCALE, F.b_gate + (size_t)l * 4096};
            for (int rep = 0; rep < ((PROBE_DUP & 0x8) ? 2 : 1); ++rep) pg8::gemm_phase<pg8::EpiGate<true>, pg8::OrderX, true, true, true>(F.lds, g, S, E);
        } SEAM(base + 3);
        if (IN(base + 4)) {
            pg8::Gemm g{H, (const bf16*)(F.ws + WS_WO + (size_t)l * DM * DM), Ml, DM, DM / 2}; pg8::OrderX S; S.init(Ml, DM, F.G, (int)blockIdx.x, 0);
            if (l == 0) { pg8::EpiResid<false> E{F.x, F.ctx, XS, F.mod + (size_t)l * 5 * 12288 + 2 * DM, F.ada_b + (size_t)l * 12288 + 2 * DM, 1.f / (MG8_SCALE * W8_SCALE)};
                pg8::gemm_phase<pg8::EpiResid<false>, pg8::OrderX, true, true, true>(F.lds, g, S, E); }
            else { pg8::EpiResid<true> E{nullptr, nullptr, XS, F.mod + (size_t)l * 5 * 12288 + 2 * DM, F.ada_b + (size_t)l * 12288 + 2 * DM, 1.f / (MG8_SCALE * W8_SCALE)};
                pg8::gemm_phase<pg8::EpiResid<true>, pg8::OrderX, true, true, true>(F.lds, g, S, E); }
        } SEAM(base + 4);
#if PROBE_DUP & 0x20
        if (IN(base + 5)) { norm_phase<0, true>(F, nullptr, nullptr, Ml, l, F.norm2_g + (size_t)l * DM, 3, 4); }
#endif
        if (IN(base + 5)) { norm_phase<0, true>(F, nullptr, nullptr, Ml, l, F.norm2_g + (size_t)l * DM, 3, 4); } SEAM(base + 5);
        if (IN(base + 6)) {
            pg8::Gemm g{H, (const bf16*)(F.ws + WS_WQ) + (size_t)l * DM * DM, Ml, DM, DM}; pg8::OrderX S; S.init(Ml, DM, F.G, (int)blockIdx.x, 0);
            pg8::EpiStore E{(bf16*)(F.ws + WS_PQ), DM};
            for (int rep = 0; rep < ((PROBE_DUP & 0x40) ? 2 : 1); ++rep) pg8::gemm_phase<pg8::EpiStore, pg8::OrderX, true, true>(F.lds, g, S, E);
        } SEAM(base + 6);
#if PROBE_DUP & 0x80
        if (IN(base + 7)) { topk_phase(F, l, Ml); }
#endif
        if (IN(base + 7)) { topk_phase(F, l, Ml); } SEAM(base + 7);
#if PROBE_DUP & 0x100
        if (IN(base + 8)) { peer_up_phase<PROBE_GMODE>(F, l, Ml); }
#endif
        if (IN(base + 8)) { peer_up_phase<0>(F, l, Ml); } SEAM(base + 8);
#if PROBE_DUP & 0x400
        if (IN(base + 9)) { peer_combine_phase(F, l, Ml); }
#endif
        if (IN(base + 9)) { peer_combine_phase(F, l, Ml); } SEAM(base + 9);
#if PROBE_DUP & 0x100
        if (IN(base + 10)) { peer_down_phase<PROBE_GMODE ? PROBE_GMODE : 3>(F, l, Ml); }
#endif
        if (IN(base + 10)) { peer_down_phase<0>(F, l, Ml); } SEAM(base + 10);
#if PROBE_DUP & 0x800
        if (IN(base + 11) && l == 0) { post_norm_phase(F, l, Ml, false); }
#endif
        if (IN(base + 11)) { post_norm_phase(F, l, Ml, l == 1); }
        if (l == 0) SEAM(base + 11);
    }
#undef IN
#undef SEAM
}

extern "C" void kernel_launch(void* const* d_in, const int* in_sizes, int n_in, void* d_out, int out_size, void* d_ws, size_t ws_size, hipStream_t stream) {
    static int grid = 0;
    if (grid == 0) {
        if (n_in != 22 || out_size != NLAT * DM || ws_size < WS_END) { fprintf(stderr, "kernel_launch: unexpected shapes: n_in %d out %d ws %zu (need %zu)\n", n_in, out_size, ws_size, (size_t)WS_END); grid = -1; return; }
        int dev = 0, cus = 0, per_cu = 0;
        if (hipGetDevice(&dev) != hipSuccess || hipDeviceGetAttribute(&cus, hipDeviceAttributeMultiprocessorCount, dev) != hipSuccess) { grid = -1; return; }
        if (hipFuncSetAttribute((const void*)mk_fwd, hipFuncAttributeMaxDynamicSharedMemorySize, LDS_BYTES) != hipSuccess) { fprintf(stderr, "kernel_launch: hipFuncSetAttribute failed\n"); grid = -1; return; }
        if (hipOccupancyMaxActiveBlocksPerMultiprocessor(&per_cu, (const void*)mk_fwd, NWAVES * 64, LDS_BYTES) != hipSuccess || per_cu < 1) fprintf(stderr, "kernel_launch: occupancy query reports %d\n", per_cu);
        (void)hipGetLastError();
        grid = cus;
    }
    if (grid < 0) return;
    if (hipMemsetAsync((char*)d_ws + WS_CTL, 0, CTL_ZERO_BYTES, stream) != hipSuccess) return;
    Args a{};
    for (int i = 0; i < 22; ++i) a.in[i] = (const float*)d_in[i];
    a.out = (float*)d_out; a.ws = (unsigned char*)d_ws; a.pad = 0;
#if MK_ONE_LAUNCH
    a.ph_lo = 0; a.ph_hi = NPH; a.use_bar = 1;
    hipLaunchKernelGGL(mk_fwd, dim3(grid), dim3(NWAVES * 64), LDS_BYTES, stream, a);
#else
    for (int p = 0; p < NPH; ++p) { a.ph_lo = p; a.ph_hi = p + 1; a.use_bar = 0;
        hipLaunchKernelGGL(mk_fwd, dim3(grid), dim3(NWAVES * 64), LDS_BYTES, stream, a); }
#endif
    const hipError_t le = hipPeekAtLastError();
    if (le != hipSuccess) fprintf(stderr, "kernel_launch: launch failed: %s\n", hipGetErrorName(le));
}
```

```cpp
#include <hip/hip_runtime.h>
#include <hip/hip_bf16.h>
#include <cstdio>
#include <cstdint>
namespace pg8 {
#define PG8_LAS __attribute__((address_space(3)))
typedef unsigned short bf16_t;
typedef short bf16x8 __attribute__((ext_vector_type(8)));
typedef float f32x4 __attribute__((ext_vector_type(4)));
typedef unsigned u32x4 __attribute__((ext_vector_type(4)));
constexpr int BM = 256, BK = 64, HALF = 128, HTB = HALF * BK * 2  , STAGE_BYTES = 8 * HTB, NXCD = 8, WGM = 4;

__host__ __device__ __forceinline__ int lds_byte(int r, int c) { const int st = (r >> 4) * 2 + (c >> 5), rr = r & 15, cc = c & 31, ob = rr * 64 + cc * 2; return st * 1024 + (ob ^ (((ob >> 9) & 1) << 5)); }
__host__ __device__ __forceinline__ void stage_rc(int b, int& R, int& C) { const int st = b / 1024, sb = b % 1024, swz = sb ^ (((sb >> 9) & 1) << 5); R = (st >> 1) * 16 + swz / 64; C = (st & 1) * 32 + (swz % 64) / 2; }
__host__ __device__ __forceinline__ int perm32(int rho) { const int n = rho >> 4, i = rho & 15; return 8 * (i >> 2) + 4 * n + (i & 3); }

struct Unit { int pm, pn; };
struct Gemm { const bf16_t* A; const bf16_t* Bt; int M, N, K; };

struct StaticOrder {
    int nM, nN, nwg, G, c;
    __host__ __device__ void init(int M, int N, int G_, int c_) { nM = M / BM; nN = N / BM; nwg = nM * nN; G = G_; c = c_; }
    __host__ __device__ bool next(int i, Unit& u) const {
        const long L = (long)i * G + c; if (L >= nwg) return false;
        int wgid = (int)L; { const int q = nwg / NXCD, r = nwg % NXCD, xcd = wgid % NXCD, off = wgid / NXCD; wgid = (xcd < r ? xcd * (q + 1) : r * (q + 1) + (xcd - r) * q) + off; }
        const int nig = WGM * nN, gid = wgid / nig, fm = gid * WGM, gsz = (nM - fm) < WGM ? (nM - fm) : WGM;
        u.pm = fm + ((wgid % nig) % gsz); u.pn = (wgid % nig) / gsz; return true;
    }
    __device__ __forceinline__ void a_ready(const Unit&) const {}
    __device__ __forceinline__ void done(const Unit&) const {}
};

__device__ __forceinline__ unsigned cvt_pk_bf16(float lo, float hi) { unsigned r; asm volatile("v_cvt_pk_bf16_f32 %0, %1, %2" : "=v"(r) : "v"(lo), "v"(hi)); return r; }
typedef float f32x2 __attribute__((ext_vector_type(2)));
__device__ __forceinline__ f32x2 gelu_pk(f32x2 v) {
    const f32x2 av = __builtin_elementwise_abs(v), d = av * 0.2316418882f + 1.0f;
    f32x2 t; t.x = __builtin_amdgcn_rcpf(d.x); t.y = __builtin_amdgcn_rcpf(d.y);
    f32x2 q = t * 0.5307027145f + (-0.7265760135f); q = q * t + 0.7107068705f; q = q * t + (-0.142248368f); q = q * t + 0.127414796f; q = q * t;
    const f32x2 s = (v * v) * (-0.72134752044f);
    f32x2 e; e.x = __builtin_amdgcn_exp2f(s.x); e.y = __builtin_amdgcn_exp2f(s.y);
    const f32x2 m = v * (q * e), r = v - m;
    f32x2 o; o.x = v.x < 0.f ? m.x : r.x; o.y = v.y < 0.f ? m.y : r.y; return o;
}


__device__ __forceinline__ float bf_lo(unsigned w) { return __uint_as_float(w << 16); }
__device__ __forceinline__ float bf_hi(unsigned w) { return __uint_as_float(w & 0xffff0000u); }
struct EpiStore {
    static constexpr bool PERM = true, AFTER_DRAIN = false, HAS_MID = false;
    bf16_t* O; int ldc;
    __device__ __forceinline__ void mid(f32x4 (&)[2][2][4][2], const Unit&, int, int, int, int) const {}
    __device__ __forceinline__ void operator()(const f32x4 (&acc)[2][2][4][2], const Unit& u, int wr, int wc, int fr, int fq) const {
        const int row0 = u.pm * BM + wr * 64 + fr, col0 = u.pn * BM + wc * 32 + 8 * fq;
#pragma unroll
        for (int ai = 0; ai < 2; ++ai)
#pragma unroll
            for (int m = 0; m < 4; ++m) { bf16_t* rowp = O + (size_t)(row0 + ai * HALF + m * 16) * ldc + col0;
#pragma unroll
                for (int bj = 0; bj < 2; ++bj) { const f32x4 v0 = acc[ai][bj][m][0], v1 = acc[ai][bj][m][1];
                    u32x4 w; w.x = cvt_pk_bf16(v0[0], v0[1]); w.y = cvt_pk_bf16(v0[2], v0[3]); w.z = cvt_pk_bf16(v1[0], v1[1]); w.w = cvt_pk_bf16(v1[2], v1[3]);
                    *(u32x4*)(rowp + bj * HALF) = w; } }
    }
};
struct EpiStore8 {
    static constexpr bool PERM = true, AFTER_DRAIN = false, HAS_MID = false;
    unsigned char* O; int ldc; const float* rs; float cs;
    __device__ __forceinline__ void mid(f32x4 (&)[2][2][4][2], const Unit&, int, int, int, int) const {}
    __device__ __forceinline__ void operator()(const f32x4 (&acc)[2][2][4][2], const Unit& u, int wr, int wc, int fr, int fq) const {
        int fr_ = fr, fq_ = fq; asm volatile("" : "+v"(fr_), "+v"(fq_));
        const int row0 = u.pm * BM + wr * 64 + fr_, col0 = u.pn * BM + wc * 32 + 8 * fq_;
        typedef unsigned u32x2 __attribute__((ext_vector_type(2)));
#pragma unroll
        for (int ai = 0; ai < 2; ++ai)
#pragma unroll
            for (int m = 0; m < 4; ++m) { const int row = row0 + ai * HALF + m * 16; unsigned char* rowp = O + (size_t)row * ldc + col0; const float sc = rs[row] * cs;
#pragma unroll
                for (int bj = 0; bj < 2; ++bj) { const f32x4 v0 = acc[ai][bj][m][0] * sc, v1 = acc[ai][bj][m][1] * sc;
                    float c8[8] = {v0[0], v0[1], v0[2], v0[3], v1[0], v1[1], v1[2], v1[3]};
#pragma unroll
                    for (int e = 0; e < 8; ++e) c8[e] = fminf(fmaxf(c8[e], -448.f), 448.f);
                    int w0 = 0, w1 = 0; w0 = __builtin_amdgcn_cvt_pk_fp8_f32(c8[0], c8[1], w0, false); w0 = __builtin_amdgcn_cvt_pk_fp8_f32(c8[2], c8[3], w0, true);
                    w1 = __builtin_amdgcn_cvt_pk_fp8_f32(c8[4], c8[5], w1, false); w1 = __builtin_amdgcn_cvt_pk_fp8_f32(c8[6], c8[7], w1, true);
                    u32x2 w; w.x = (unsigned)w0; w.y = (unsigned)w1;
                    *(u32x2*)(rowp + bj * HALF) = w; } }
    }
};
template <bool OUT8>
struct EpiGate {
    static constexpr bool PERM = true, AFTER_DRAIN = false, HAS_MID = true;
    bf16_t* O; int ldc; float oscale; float midf, endf; const unsigned char* G; int ldg; int ga_off, gc_off; float ginv; const float* bgate;
    __device__ __forceinline__ void mid(f32x4 (&acc)[2][2][4][2], const Unit& u, int wr, int wc, int fr, int fq) const {
        int rowv = u.pm * BM + wr * 64 + fr; asm volatile("" : "+v"(rowv));
        const int col0 = u.pn * BM + wc * 32 + 8 * fq;
        const unsigned char* pbase = G + (size_t)rowv * ldg + col0;
        typedef unsigned u32x2 __attribute__((ext_vector_type(2))); typedef float f32x2 __attribute__((ext_vector_type(2)));
#pragma unroll
        for (int bj = 0; bj < 2; ++bj) {
            const f32x4 ba0 = *(const f32x4*)(bgate + col0 + bj * HALF), ba1 = *(const f32x4*)(bgate + col0 + bj * HALF + 4), bc0 = *(const f32x4*)(bgate + 2048 + col0 + bj * HALF), bc1 = *(const f32x4*)(bgate + 2048 + col0 + bj * HALF + 4);
#pragma unroll
            for (int ai = 0; ai < 2; ++ai) { u32x2 gav[4], gcv[4];
                const unsigned char* pq = pbase + (size_t)(ai * HALF) * ldg + bj * HALF; asm volatile("" : "+v"(pq) :: "memory");
#pragma unroll
                for (int m = 0; m < 4; ++m) { const unsigned char* pr = pq + (size_t)(m * 16) * ldg; gav[m] = *(const u32x2*)(pr + ga_off); gcv[m] = *(const u32x2*)(pr + gc_off); }
#pragma unroll
                for (int m = 0; m < 4; ++m) { const u32x2 ga = gav[m], gc = gcv[m];
                    const f32x2 a0 = __builtin_amdgcn_cvt_pk_f32_fp8((int)ga.x, false), a1 = __builtin_amdgcn_cvt_pk_f32_fp8((int)ga.x, true), a2 = __builtin_amdgcn_cvt_pk_f32_fp8((int)ga.y, false), a3 = __builtin_amdgcn_cvt_pk_f32_fp8((int)ga.y, true);
                    const f32x2 c0 = __builtin_amdgcn_cvt_pk_f32_fp8((int)gc.x, false), c1 = __builtin_amdgcn_cvt_pk_f32_fp8((int)gc.x, true), c2 = __builtin_amdgcn_cvt_pk_f32_fp8((int)gc.y, false), c3 = __builtin_amdgcn_cvt_pk_f32_fp8((int)gc.y, true);
                    float a[8] = {a0.x * ginv, a0.y * ginv, a1.x * ginv, a1.y * ginv, a2.x * ginv, a2.y * ginv, a3.x * ginv, a3.y * ginv};
                    float c[8] = {c0.x * ginv, c0.y * ginv, c1.x * ginv, c1.y * ginv, c2.x * ginv, c2.y * ginv, c3.x * ginv, c3.y * ginv};
#pragma unroll
                    for (int e = 0; e < 8; ++e) { const float av = a[e] + (e < 4 ? ba0[e & 3] : ba1[e & 3]), cv = c[e] + (e < 4 ? bc0[e & 3] : bc1[e & 3]);
                        const float ratio = midf * (1.f + __expf(-cv)) * __builtin_amdgcn_rcpf(1.f + __expf(-av));
                        acc[ai][bj][m][e >> 2][e & 3] *= ratio; } } } }
    }
    __device__ __forceinline__ void operator()(const f32x4 (&acc)[2][2][4][2], const Unit& u, int wr, int wc, int fr, int fq) const {
        int rowv = u.pm * BM + wr * 64 + fr; asm volatile("" : "+v"(rowv));
        const int col0 = u.pn * BM + wc * 32 + 8 * fq;
        const unsigned char* pbase = G + (size_t)rowv * ldg + col0 + gc_off; typedef unsigned u32x2g __attribute__((ext_vector_type(2))); typedef float f32x2 __attribute__((ext_vector_type(2))); bf16_t* obase = OUT8 ? (bf16_t*)((unsigned char*)O + (size_t)rowv * ldc + col0) : O + (size_t)rowv * ldc + col0;
#pragma unroll
        for (int bj = 0; bj < 2; ++bj) {
            const f32x4 bc0 = *(const f32x4*)(bgate + 2048 + col0 + bj * HALF), bc1 = *(const f32x4*)(bgate + 2048 + col0 + bj * HALF + 4);
#pragma unroll
            for (int ai = 0; ai < 2; ++ai) { u32x2g gcv[4];
                const unsigned char* pq = pbase + (size_t)(ai * HALF) * ldg + bj * HALF; unsigned char* oq = (unsigned char*)obase + ((size_t)(ai * HALF) * ldc + bj * HALF) * (OUT8 ? 1 : 2);
                asm volatile("" : "+v"(pq), "+v"(oq) :: "memory");
#pragma unroll
                for (int m = 0; m < 4; ++m) gcv[m] = *(const u32x2g*)(pq + (size_t)(m * 16) * ldg);
#pragma unroll
                for (int m = 0; m < 4; ++m) { const u32x2g gc = gcv[m]; unsigned char* orow = oq + (size_t)(m * 16) * ldc * (OUT8 ? 1 : 2);
                    const f32x2 c0 = __builtin_amdgcn_cvt_pk_f32_fp8((int)gc.x, false), c1 = __builtin_amdgcn_cvt_pk_f32_fp8((int)gc.x, true), c2 = __builtin_amdgcn_cvt_pk_f32_fp8((int)gc.y, false), c3 = __builtin_amdgcn_cvt_pk_f32_fp8((int)gc.y, true);
                    float c[8] = {c0.x * ginv, c0.y * ginv, c1.x * ginv, c1.y * ginv, c2.x * ginv, c2.y * ginv, c3.x * ginv, c3.y * ginv};
                    float o[8];
#pragma unroll
                    for (int e = 0; e < 8; ++e) { const float cv = c[e] + (e < 4 ? bc0[e & 3] : bc1[e & 3]); o[e] = acc[ai][bj][m][e >> 2][e & 3] * endf * __builtin_amdgcn_rcpf(1.f + __expf(-cv)); }
                    if constexpr (OUT8) { float c8[8];
#pragma unroll
                        for (int e = 0; e < 8; ++e) c8[e] = fminf(fmaxf(o[e] * oscale, -448.f), 448.f);
                        int w0 = 0, w1 = 0; w0 = __builtin_amdgcn_cvt_pk_fp8_f32(c8[0], c8[1], w0, false); w0 = __builtin_amdgcn_cvt_pk_fp8_f32(c8[2], c8[3], w0, true);
                        w1 = __builtin_amdgcn_cvt_pk_fp8_f32(c8[4], c8[5], w1, false); w1 = __builtin_amdgcn_cvt_pk_fp8_f32(c8[6], c8[7], w1, true);
                        typedef unsigned u32x2 __attribute__((ext_vector_type(2))); u32x2 w; w.x = (unsigned)w0; w.y = (unsigned)w1; *(u32x2*)orow = w;
                    } else { u32x4 w; w.x = cvt_pk_bf16(o[0], o[1]); w.y = cvt_pk_bf16(o[2], o[3]); w.z = cvt_pk_bf16(o[4], o[5]); w.w = cvt_pk_bf16(o[6], o[7]);
                    *(u32x4*)orow = w; } } } }
    }
};
template <bool IN16>
struct EpiResid {
    static constexpr bool PERM = false, AFTER_DRAIN = false, HAS_MID = false;
    const float* xin_lat; const float* xin_ctx; bf16_t* xs; const float* mod; const float* bias; float ascale;
    __device__ __forceinline__ void mid(f32x4 (&)[2][2][4][2], const Unit&, int, int, int, int) const {}
    __device__ __forceinline__ void operator()(const f32x4 (&acc)[2][2][4][2], const Unit& u, int wr, int wc, int fr, int fq) const {
        const int modrow = u.pm < 64 ? (u.pm >> 4) : 4; const bool lat = u.pm < 64;
        const float* xi = lat ? xin_lat + (size_t)(u.pm * BM) * 2048 : xin_ctx + (size_t)((u.pm - 64) * BM) * 2048;
        bf16_t* xo = xs + (size_t)(u.pm * BM) * 2048;
        const float* md = mod + modrow * 12288;
        const int col0 = u.pn * BM + wc * 32 + 4 * fq;
        typedef unsigned u32x2 __attribute__((ext_vector_type(2)));
#pragma unroll
        for (int bj = 0; bj < 2; ++bj)
#pragma unroll
            for (int n = 0; n < 2; ++n) { const int col = col0 + bj * HALF + n * 16; const f32x4 g = (*(const f32x4*)(md + col) + *(const f32x4*)(bias + col)) * ascale;
#pragma unroll
                for (int ai = 0; ai < 2; ++ai)
#pragma unroll
                    for (int m = 0; m < 4; ++m) { const size_t off = (size_t)(ai * HALF + wr * 64 + m * 16 + fr) * 2048 + col;
                        f32x4 xv;
                        if constexpr (IN16) { const u32x2 w = *(const u32x2*)(xo + off); xv = (f32x4){bf_lo(w.x), bf_hi(w.x), bf_lo(w.y), bf_hi(w.y)}; } else xv = *(const f32x4*)(xi + off);
                        const f32x4 o = xv + g * acc[ai][bj][m][n];
                        u32x2 w; w.x = cvt_pk_bf16(o[0], o[1]); w.y = cvt_pk_bf16(o[2], o[3]); *(u32x2*)(xo + off) = w; } }
    }
};
struct OrderX {
    StaticOrder b; int nextra;
    __device__ __forceinline__ void init(int M, int N, int G, int c, int nextra_) { b.init(M, N, G, c); nextra = nextra_; }
    __device__ __forceinline__ bool next(int i, Unit& u) const {
        const long L = (long)i * b.G + b.c; if (L < b.nwg) return b.next(i, u);
        const int e = (int)(L - b.nwg); if (e >= nextra) return false; u.pm = 64 + (e >> 2); u.pn = 8 + (e & 3); return true; }
    __device__ __forceinline__ void a_ready(const Unit&) const {}
    __device__ __forceinline__ void done(const Unit&) const {}
};
typedef int pg8_v4i __attribute__((ext_vector_type(4))); typedef int pg8_v8i __attribute__((ext_vector_type(8)));
__device__ __forceinline__ pg8_v8i pg8_cat(bf16x8 lo, bf16x8 hi) { return __builtin_shufflevector(__builtin_bit_cast(pg8_v4i, lo), __builtin_bit_cast(pg8_v4i, hi), 0, 1, 2, 3, 4, 5, 6, 7); }
template <class Epi, class Sched, bool ALIGN_EPI = false, bool SP2 = false, bool FP8 = false>
__device__ __forceinline__ void gemm_phase(PG8_LAS unsigned char* lds, const Gemm g, const Sched& S, const Epi& E) {
    int tid = threadIdx.x; asm volatile("" : "+v"(tid));
    const int wid = __builtin_amdgcn_readfirstlane(tid >> 6), lane = tid & 63, wr = wid >> 2, wc = wid & 3, fr = lane & 15, fq = lane >> 4;
    const int K = g.K, nt = K / BK;
    unsigned voffA[2], voffB[2];
#pragma unroll
    for (int i = 0; i < 2; ++i) { int R, C; stage_rc(tid * 16 + i * 8192, R, C); const int Rb = Epi::PERM ? ((R & ~31) + perm32(R & 31)) : R;
        voffA[i] = (unsigned)(R * K + C) * 2u; voffB[i] = (unsigned)(Rb * K + C) * 2u; }
    const size_t kstep = (size_t)(BK * 2);
    const size_t hstep = (size_t)HALF * K * 2;
    const size_t tstep = 2 * hstep;
    const unsigned ldsw = (unsigned)wid * 1024u;
    const int aoff = FP8 ? lds_byte(wr * 64 + fr, 16 * (fq & 1)) + (fq >> 1) * 1024 : lds_byte(wr * 64 + fr, fq * 8), boff = FP8 ? lds_byte(wc * 32 + fr, 16 * (fq & 1)) + (fq >> 1) * 1024 : lds_byte(wc * 32 + fr, fq * 8);
    constexpr int KSTEP = FP8 ? 16 : 1024;
    int sc8 = 0x7F7F7F7F; asm volatile("" : "+v"(sc8));
    unsigned abase8 = (unsigned)(size_t)lds + (unsigned)aoff, bbase8 = (unsigned)(size_t)lds + (unsigned)boff + 4u * HTB; asm volatile("" : "+v"(abase8), "+v"(bbase8));
#define PG8_SA(b, h) (((b) * 2 + (h)) * HTB)
#define PG8_SB(b, h) ((4 + (b) * 2 + (h)) * HTB)
#define PG8_STAGE(bufoff, gbase, voff) do { _Pragma("unroll") for (int _i = 0; _i < 2; ++_i) \
        __builtin_amdgcn_global_load_lds((const unsigned*)((const char*)(gbase) + (voff)[_i]), (PG8_LAS unsigned*)(lds + (bufoff) + ldsw + _i * 8192), 16, 0, 0); } while (0)
#define PG8_LDA(dst, b, h) do { _Pragma("unroll") for (int m = 0; m < 4; ++m) _Pragma("unroll") for (int k = 0; k < 2; ++k) { if constexpr (FP8) { if (k == 0) dst##8[m].lo = *(const PG8_LAS pg8_v4i*)(size_t)(abase8 + (PG8_SA(b, h) + m * 2048)); else dst##8[m].hi = *(const PG8_LAS pg8_v4i*)(size_t)(abase8 + (PG8_SA(b, h) + m * 2048 + 16)); } else dst[m][k] = *(const PG8_LAS bf16x8*)(lds + PG8_SA(b, h) + aoff + m * 2048 + k * KSTEP); } } while (0)
#define PG8_LDB(dst, b, h) do { _Pragma("unroll") for (int n = 0; n < 2; ++n) _Pragma("unroll") for (int k = 0; k < 2; ++k) { if constexpr (FP8) { if (k == 0) dst##8[n].lo = *(const PG8_LAS pg8_v4i*)(size_t)(bbase8 + (PG8_SB(b, h) - 4 * HTB + n * 2048)); else dst##8[n].hi = *(const PG8_LAS pg8_v4i*)(size_t)(bbase8 + (PG8_SB(b, h) - 4 * HTB + n * 2048 + 16)); } else dst[n][k] = *(const PG8_LAS bf16x8*)(lds + PG8_SB(b, h) + boff + n * 2048 + k * KSTEP); } } while (0)
#define PG8_MMA(ai, bj, At, Bt) do { __builtin_amdgcn_s_setprio(1); if constexpr (FP8) { _Pragma("unroll") for (int m = 0; m < 4; ++m) _Pragma("unroll") for (int n = 0; n < 2; ++n) \
        asm volatile("v_mfma_scale_f32_16x16x128_f8f6f4 %0, %1, %2, %0, %3, %3 op_sel_hi:[0,0,0]" : "+v"(acc[ai][bj][m][n]) : "v"(Bt##8[n]), "v"(At##8[m]), "v"(sc8)); } else { \
        _Pragma("unroll") for (int m = 0; m < 4; ++m) _Pragma("unroll") for (int n = 0; n < 2; ++n) _Pragma("unroll") for (int k = 0; k < 2; ++k) \
        acc[ai][bj][m][n] = __builtin_amdgcn_mfma_f32_16x16x32_bf16(Bt[n][k], At[m][k], acc[ai][bj][m][n], 0, 0, 0); } __builtin_amdgcn_s_setprio(0); } while (0)
#define PG8_WAIT_V(n) asm volatile("s_waitcnt vmcnt(" #n ")" ::: "memory")
#define PG8_WAIT_L(n) asm volatile("s_waitcnt lgkmcnt(" #n ")" ::: "memory")
#define PG8_BAR __builtin_amdgcn_s_barrier()
#define PG8_SCHED __builtin_amdgcn_sched_barrier(0)
    Unit cur, nxt; int ui = 0;
    if (!S.next(0, cur)) return;
    f32x4 acc[2][2][4][2];
#pragma unroll
    for (int a = 0; a < 2; ++a)
#pragma unroll
        for (int b = 0; b < 2; ++b)
#pragma unroll
            for (int m = 0; m < 4; ++m)
#pragma unroll
                for (int n = 0; n < 2; ++n) acc[a][b][m][n] = (f32x4){0.f, 0.f, 0.f, 0.f};
    bf16x8 At[4][2], B0[2][2], B1[2][2]; pg8_v8i At8[4], B08[2], B18[2];
    const char* cA = (const char*)g.A + (size_t)cur.pm * tstep; const char* cB = (const char*)g.Bt + (size_t)cur.pn * tstep;
    S.a_ready(cur);
    if constexpr (SP2) {
        PG8_STAGE(PG8_SB(0, 0), cB, voffB); PG8_STAGE(PG8_SB(0, 1), cB + hstep, voffB); PG8_STAGE(PG8_SA(0, 0), cA, voffA); PG8_STAGE(PG8_SA(0, 1), cA + hstep, voffA);
        if (wr == 1) PG8_BAR;
        PG8_WAIT_V(2); PG8_BAR;
        PG8_STAGE(PG8_SB(1, 0), cB + kstep, voffB); PG8_STAGE(PG8_SA(1, 0), cA + kstep, voffA); PG8_STAGE(PG8_SB(1, 1), cB + hstep + kstep, voffB);
        PG8_WAIT_V(6); PG8_BAR;
    } else {
        PG8_STAGE(PG8_SB(0, 0), cB, voffB); PG8_STAGE(PG8_SA(0, 0), cA, voffA); PG8_STAGE(PG8_SB(0, 1), cB + hstep, voffB); PG8_STAGE(PG8_SA(0, 1), cA + hstep, voffA);
        if (wr == 1) PG8_BAR;
        PG8_WAIT_V(4); PG8_BAR;
        PG8_STAGE(PG8_SB(1, 0), cB + kstep, voffB); PG8_STAGE(PG8_SA(1, 0), cA + kstep, voffA); PG8_STAGE(PG8_SB(1, 1), cB + hstep + kstep, voffB);
        PG8_WAIT_V(6); PG8_BAR;
    }
    for (;;) {
        const bool has_next = S.next(ui + 1, nxt);
        const char* nA = has_next ? (const char*)g.A + (size_t)nxt.pm * tstep : cA; const char* nB = has_next ? (const char*)g.Bt + (size_t)nxt.pn * tstep : cB;
        constexpr int NPART = Epi::HAS_MID ? 2 : 1; const int tpp = nt / NPART;
        for (int part = 0; part < NPART; ++part) {
        if constexpr (Epi::HAS_MID) { if (part == 1) { if constexpr (FP8) asm volatile("s_nop 15\n\ts_nop 15\n\ts_nop 15\n\ts_nop 15" ::: "memory"); E.mid(acc, cur, wr, wc, fr, fq); } }
        for (int t = part * tpp; t < (part + 1) * tpp; t += 2) {
            const bool last = (t == nt - 2);
            const char* a1 = cA + (size_t)(t + 1) * kstep;
            const char* a2 = last ? nA : cA + (size_t)(t + 2) * kstep; const char* b2 = last ? nB : cB + (size_t)(t + 2) * kstep;
            const char* a3 = a2 + kstep; const char* b3 = b2 + kstep;
            if (last && has_next) S.a_ready(nxt);
            if constexpr (SP2) {
            PG8_LDB(B0, 0, 0); PG8_LDB(B1, 0, 1); PG8_SCHED; PG8_LDA(At, 0, 0); PG8_STAGE(PG8_SA(1, 1), a1 + hstep, voffA);
            PG8_WAIT_V(8); PG8_WAIT_L(0); PG8_BAR; PG8_MMA(0, 0, At, B0); PG8_MMA(0, 1, At, B1); PG8_BAR; PG8_SCHED;
            PG8_LDA(At, 0, 1); PG8_STAGE(PG8_SB(0, 0), b2, voffB); PG8_STAGE(PG8_SB(0, 1), b2 + hstep, voffB); PG8_STAGE(PG8_SA(0, 0), a2, voffA);
            PG8_WAIT_V(8); PG8_WAIT_L(0); PG8_BAR; PG8_MMA(1, 0, At, B0); PG8_MMA(1, 1, At, B1); PG8_BAR; PG8_SCHED;
            PG8_LDB(B0, 1, 0); PG8_LDB(B1, 1, 1); PG8_SCHED; PG8_LDA(At, 1, 0); PG8_STAGE(PG8_SA(0, 1), a2 + hstep, voffA);
            PG8_WAIT_V(8); PG8_WAIT_L(0); PG8_BAR; PG8_MMA(0, 0, At, B0); PG8_MMA(0, 1, At, B1); PG8_BAR; PG8_SCHED;
            PG8_LDA(At, 1, 1); PG8_STAGE(PG8_SB(1, 0), b3, voffB); PG8_STAGE(PG8_SB(1, 1), b3 + hstep, voffB); PG8_STAGE(PG8_SA(1, 0), a3, voffA);
            PG8_WAIT_V(8); PG8_WAIT_L(0); PG8_BAR; PG8_MMA(1, 0, At, B0); PG8_MMA(1, 1, At, B1); PG8_BAR; PG8_SCHED;
            } else {
            PG8_LDB(B0, 0, 0); PG8_SCHED; PG8_LDA(At, 0, 0); PG8_STAGE(PG8_SA(1, 1), a1 + hstep, voffA);
            PG8_WAIT_L(8); PG8_BAR; PG8_WAIT_L(0); PG8_MMA(0, 0, At, B0); PG8_BAR; PG8_SCHED;
            PG8_LDB(B1, 0, 1); PG8_STAGE(PG8_SB(0, 0), b2, voffB);
            PG8_BAR; PG8_WAIT_L(0); PG8_MMA(0, 1, At, B1); PG8_BAR;
            PG8_LDA(At, 0, 1); PG8_STAGE(PG8_SA(0, 0), a2, voffA);
            PG8_BAR; PG8_WAIT_L(0); PG8_MMA(1, 0, At, B0); PG8_BAR; PG8_SCHED;
            PG8_STAGE(PG8_SB(0, 1), b2 + hstep, voffB);
            PG8_WAIT_V(6); PG8_BAR; PG8_MMA(1, 1, At, B1); PG8_BAR;
            PG8_LDB(B0, 1, 0); PG8_SCHED; PG8_LDA(At, 1, 0); PG8_STAGE(PG8_SA(0, 1), a2 + hstep, voffA);
            PG8_WAIT_L(8); PG8_BAR; PG8_WAIT_L(0); PG8_MMA(0, 0, At, B0); PG8_BAR; PG8_SCHED;
            PG8_LDB(B1, 1, 1); PG8_STAGE(PG8_SB(1, 0), b3, voffB);
            PG8_BAR; PG8_WAIT_L(0); PG8_MMA(0, 1, At, B1); PG8_BAR;
            PG8_LDA(At, 1, 1); PG8_STAGE(PG8_SA(1, 0), a3, voffA);
            PG8_BAR; PG8_WAIT_L(0); PG8_MMA(1, 0, At, B0); PG8_BAR; PG8_SCHED;
            PG8_STAGE(PG8_SB(1, 1), b3 + hstep, voffB);
            PG8_WAIT_V(6); PG8_BAR; PG8_MMA(1, 1, At, B1); PG8_BAR;
            }
        }
        }
        if constexpr (FP8) asm volatile("s_nop 15\n\ts_nop 15\n\ts_nop 15\n\ts_nop 15" ::: "memory");
        if constexpr (ALIGN_EPI) { if (wr == 0) PG8_BAR; }
        if constexpr (!Epi::AFTER_DRAIN) { E(acc, cur, wr, wc, fr, fq); S.done(cur); }
        if (!has_next) break;
#pragma unroll
        for (int a = 0; a < 2; ++a)
#pragma unroll
            for (int b = 0; b < 2; ++b)
#pragma unroll
                for (int m = 0; m < 4; ++m)
#pragma unroll
                    for (int n = 0; n < 2; ++n) acc[a][b][m][n] = (f32x4){0.f, 0.f, 0.f, 0.f};
        cur = nxt; cA = nA; cB = nB; ++ui;
        if constexpr (ALIGN_EPI) { if (wr == 1) PG8_BAR; }
    }
    PG8_WAIT_V(0);
    if constexpr (!ALIGN_EPI) { if (wr == 0) PG8_BAR; }
    PG8_BAR;
    if constexpr (Epi::AFTER_DRAIN) { E.fused(acc, cur, wr, wc, fr, fq, lds, wid, lane); S.done(cur); }
#undef PG8_SA
#undef PG8_SB
#undef PG8_STAGE
#undef PG8_LDA
#undef PG8_LDB
#undef PG8_MMA
#undef PG8_WAIT_V
#undef PG8_WAIT_L
#undef PG8_BAR
#undef PG8_SCHED
}
}
namespace att {
using bf16 = __hip_bfloat16;
constexpr int   D = 128, NW = 8, QBLK = 32, KVBLK = 64;
constexpr float QK8 = 0.35709534f;
constexpr float THR2 = 4.3f;
constexpr float V8 = 32.f;
constexpr int VTS = 4 * 8192;
constexpr int SDEPTH = 2;
constexpr int LDQ = 2048, LDK = 512;
constexpr size_t SHM_V = KVBLK * D, SHM_K = KVBLK * D, NBUF = 6, SHM_ATTN = NBUF * SHM_V + NBUF * SHM_K + NW * 64 * 4;
typedef int v4i_t __attribute__((ext_vector_type(4))); typedef int v8i_t __attribute__((ext_vector_type(8)));
using bf16x8 = __attribute__((ext_vector_type(8))) short;
using s16x4  = __attribute__((ext_vector_type(4))) short;
using f32x16 = __attribute__((ext_vector_type(16))) float;
using f32x8  = __attribute__((ext_vector_type(8))) float;
using u32x4  = __attribute__((ext_vector_type(4))) unsigned;
#define KSWZ(row, colB) ((row) * 256 + ((colB) ^ (((row) & 7) << 4)))
#define SBAR() __builtin_amdgcn_sched_barrier(0)
__device__ __forceinline__ int crow(int r, int hi) { return (r & 3) + 8 * (r >> 2) + 4 * hi; }
__device__ __forceinline__ unsigned cvtpk(float lo, float hi) {
  unsigned r; asm volatile("v_cvt_pk_bf16_f32 %0, %1, %2" : "=v"(r) : "v"(lo), "v"(hi)); return r;
}
template <typename TIn> struct Stage;
template <> struct Stage<bf16>  { using T = bf16x8;
  __device__ static __forceinline__ T ld8(const bf16* p) { return *reinterpret_cast<const bf16x8*>(p); }
  __device__ static __forceinline__ bf16x8 tobf(T x) { return x; } };
template <> struct Stage<float> { using T = f32x8;
  __device__ static __forceinline__ T ld8(const float* p) { return *reinterpret_cast<const f32x8*>(p); }
  __device__ static __forceinline__ bf16x8 tobf(T x) {
    u32x4 w = {cvtpk(x[0], x[1]), cvtpk(x[2], x[3]), cvtpk(x[4], x[5]), cvtpk(x[6], x[7])}; return *reinterpret_cast<bf16x8*>(&w); } };

__device__ __forceinline__ void partialSM(f32x16& p0, f32x16& p1, f32x16& negm, float& alpha, bool first) {
  float pmax = p0[0]; for (int r = 1; r < 16; ++r) pmax = fmaxf(pmax, p0[r]); for (int r = 0; r < 16; ++r) pmax = fmaxf(pmax, p1[r]);
  { auto rr = __builtin_amdgcn_permlane32_swap(__float_as_uint(pmax), __float_as_uint(pmax), false, false);
    pmax = fmaxf(__uint_as_float(rr[0]), __uint_as_float(rr[1])); }
  if (__builtin_expect(!first && __all(pmax <= THR2 + 4.f), 1)) alpha = 1.f;
  else { const float delta = first ? pmax - 4.f : fmaxf(pmax - 4.f, 0.f);
    alpha = __builtin_amdgcn_exp2f(-delta);
    for (int r = 0; r < 16; ++r) { p0[r] -= delta; p1[r] -= delta; negm[r] -= delta; } }
  for (int r = 0; r < 16; ++r) p0[r] = __builtin_amdgcn_exp2f(p0[r]);
}
__device__ __forceinline__ void finishSM(f32x16& p0, f32x16& p1, float alpha, float& l_reg, v8i_t& pa) {
  for (int r = 0; r < 16; ++r) p1[r] = __builtin_amdgcn_exp2f(p1[r]);
  float ps = 0; for (int r = 0; r < 16; ++r) ps += p0[r]; for (int r = 0; r < 16; ++r) ps += p1[r];
  { auto rr = __builtin_amdgcn_permlane32_swap(__float_as_uint(ps), __float_as_uint(ps), false, false);
    ps = __uint_as_float(rr[0]) + __uint_as_float(rr[1]); }
  l_reg = l_reg * alpha + ps;
#pragma unroll
  for (int i = 0; i < 4; ++i) { int w = 0; w = __builtin_amdgcn_cvt_pk_fp8_f32(p0[4 * i], p0[4 * i + 1], w, false); w = __builtin_amdgcn_cvt_pk_fp8_f32(p0[4 * i + 2], p0[4 * i + 3], w, true); pa[i] = w;
    int x = 0; x = __builtin_amdgcn_cvt_pk_fp8_f32(p1[4 * i], p1[4 * i + 1], x, false); x = __builtin_amdgcn_cvt_pk_fp8_f32(p1[4 * i + 2], p1[4 * i + 3], x, true); pa[4 + i] = x; }
}
__device__ __forceinline__ void qkt(f32x16& p0, f32x16& p1, const char* Ks, const v8i_t* qr, const f32x16& negm, int r32, int hi) {
  const int sw = r32 & 7;
  const char* k0 = Ks + r32 * 128; const char* k1 = Ks + (32 + r32) * 128;
  { v8i_t a0, a1;
    a0.lo = *reinterpret_cast<const v4i_t*>(k0 + (((2 * hi) ^ sw) << 4)); a0.hi = *reinterpret_cast<const v4i_t*>(k0 + (((2 * hi + 1) ^ sw) << 4));
    a1.lo = *reinterpret_cast<const v4i_t*>(k1 + (((2 * hi) ^ sw) << 4)); a1.hi = *reinterpret_cast<const v4i_t*>(k1 + (((2 * hi + 1) ^ sw) << 4));
    p0 = __builtin_amdgcn_mfma_scale_f32_32x32x64_f8f6f4(a0, qr[0], negm, 0, 0, 0, 0x7F7F7F7F, 0, 0x7F7F7F7F);
    p1 = __builtin_amdgcn_mfma_scale_f32_32x32x64_f8f6f4(a1, qr[0], negm, 0, 0, 0, 0x7F7F7F7F, 0, 0x7F7F7F7F); }
  SBAR();
  { v8i_t b0, b1;
    b0.lo = *reinterpret_cast<const v4i_t*>(k0 + (((4 + 2 * hi) ^ sw) << 4)); b0.hi = *reinterpret_cast<const v4i_t*>(k0 + (((5 + 2 * hi) ^ sw) << 4));
    b1.lo = *reinterpret_cast<const v4i_t*>(k1 + (((4 + 2 * hi) ^ sw) << 4)); b1.hi = *reinterpret_cast<const v4i_t*>(k1 + (((5 + 2 * hi) ^ sw) << 4));
    p0 = __builtin_amdgcn_mfma_scale_f32_32x32x64_f8f6f4(b0, qr[1], p0, 0, 0, 0, 0x7F7F7F7F, 0, 0x7F7F7F7F);
    p1 = __builtin_amdgcn_mfma_scale_f32_32x32x64_f8f6f4(b1, qr[1], p1, 0, 0, 0, 0x7F7F7F7F, 0, 0x7F7F7F7F); }
}
__device__ __forceinline__ void pv_d0(f32x16* o, const char* Vs, const v8i_t& pa, int r32, int hi) {
  const int sw = (r32 >> 2) & 3;
#pragma unroll
  for (int db = 0; db < 4; ++db) { const char* row = Vs + (db * 32 + r32) * 64; v8i_t b;
    b.lo = *reinterpret_cast<const v4i_t*>(row + (((2 * hi) ^ sw) << 4)); b.hi = *reinterpret_cast<const v4i_t*>(row + (((2 * hi + 1) ^ sw) << 4));
    o[db] = __builtin_amdgcn_mfma_scale_f32_32x32x64_f8f6f4(pa, b, o[db], 0, 0, 0, 0x7F7F7F7F, 0, 0x7F7F7F7F); }
}

__device__ __forceinline__ int undef_i() { int w; asm volatile("" : "=v"(w)); return w; }
#define ATT_MFMA(a_, b_, c_) __builtin_amdgcn_mfma_scale_f32_32x32x64_f8f6f4(a_, b_, c_, 0, 0, 0, 0x7F7F7F7F, 0, 0x7F7F7F7F)
#ifndef ATT_PLIM
#define ATT_PLIM 448.f
#endif
template <bool HASN>
__device__ __forceinline__ void att_redo(f32x16& pO0, f32x16& pO1, f32x16& pN0, f32x16& pN1, f32x16* o, f32x16& negm, float& l_reg, float& ps_lane, float* al_l, int r32, int hi) {
  float pmax = pO0[0];
#pragma unroll
  for (int r = 1; r < 16; ++r) pmax = fmaxf(pmax, pO0[r]);
#pragma unroll
  for (int r = 0; r < 16; ++r) pmax = fmaxf(pmax, pO1[r]);
  { auto rr = __builtin_amdgcn_permlane32_swap(__float_as_uint(pmax), __float_as_uint(pmax), false, false); pmax = fmaxf(__uint_as_float(rr[0]), __uint_as_float(rr[1])); }
  const float delta = fmaxf(__builtin_amdgcn_logf(pmax) - 4.f, 0.f), alpha = __builtin_amdgcn_exp2f(-delta);
#pragma unroll
  for (int r = 0; r < 16; ++r) { pO0[r] *= alpha; pO1[r] *= alpha; negm[r] -= delta; }
  if constexpr (HASN) {
#pragma unroll
    for (int r = 0; r < 16; ++r) { pN0[r] -= delta; pN1[r] -= delta; } }
  ps_lane *= alpha; l_reg *= alpha;
  if (hi == 0) al_l[r32] = alpha; asm volatile("s_waitcnt lgkmcnt(0)" ::: "memory");
#pragma unroll
  for (int d = 0; d < 4; ++d)
#pragma unroll
    for (int r = 0; r < 16; ++r) o[d][r] *= al_l[crow(r, hi)];
}
__device__ __forceinline__ void att_pack(const f32x16& p0, const f32x16& p1, v8i_t& pa) {
#pragma unroll
  for (int i = 0; i < 4; ++i) { int w = undef_i(); w = __builtin_amdgcn_cvt_pk_fp8_f32(p0[4 * i], p0[4 * i + 1], w, false); w = __builtin_amdgcn_cvt_pk_fp8_f32(p0[4 * i + 2], p0[4 * i + 3], w, true); pa[i] = w;
    int x = undef_i(); x = __builtin_amdgcn_cvt_pk_fp8_f32(p1[4 * i], p1[4 * i + 1], x, false); x = __builtin_amdgcn_cvt_pk_fp8_f32(p1[4 * i + 2], p1[4 * i + 3], x, true); pa[4 + i] = x; }
}
__device__ __forceinline__ void att_step(f32x16& pN0, f32x16& pN1, f32x16& pO0, f32x16& pO1, f32x16* o, const v8i_t* qr, f32x16& negm, float& l_reg,
                                         const char* Ks, const char* KsO, const char* Vs, float* al_l, int r32, int hi) {
  v8i_t a0, a1, b0, b1, pa;
  { const int sw = r32 & 7; const char* k0 = Ks + r32 * 128; const char* k1 = Ks + (32 + r32) * 128;
    a0.lo = *reinterpret_cast<const v4i_t*>(k0 + (((2 * hi) ^ sw) << 4)); a0.hi = *reinterpret_cast<const v4i_t*>(k0 + (((2 * hi + 1) ^ sw) << 4));
    a1.lo = *reinterpret_cast<const v4i_t*>(k1 + (((2 * hi) ^ sw) << 4)); a1.hi = *reinterpret_cast<const v4i_t*>(k1 + (((2 * hi + 1) ^ sw) << 4));
    b0.lo = *reinterpret_cast<const v4i_t*>(k0 + (((4 + 2 * hi) ^ sw) << 4)); b0.hi = *reinterpret_cast<const v4i_t*>(k0 + (((5 + 2 * hi) ^ sw) << 4));
    b1.lo = *reinterpret_cast<const v4i_t*>(k1 + (((4 + 2 * hi) ^ sw) << 4)); b1.hi = *reinterpret_cast<const v4i_t*>(k1 + (((5 + 2 * hi) ^ sw) << 4)); }
  SBAR();
#pragma unroll
  for (int r = 0; r < 16; ++r) pO1[r] = __builtin_amdgcn_exp2f(pO1[r]);
  SBAR();
  pN0 = ATT_MFMA(a0, qr[0], negm); SBAR();
  float s0 = pO0[0], s1 = pO0[1], s2 = pO0[2], s3 = pO0[3];
  s0 += pO0[4]; s1 += pO0[5]; s2 += pO0[6]; s3 += pO0[7]; s0 += pO0[8]; s1 += pO0[9]; s2 += pO0[10]; s3 += pO0[11]; s0 += pO0[12]; s1 += pO0[13]; s2 += pO0[14]; s3 += pO0[15];
  SBAR();
  pN1 = ATT_MFMA(a1, qr[0], negm); SBAR();
  s0 += pO1[0]; s1 += pO1[1]; s2 += pO1[2]; s3 += pO1[3]; s0 += pO1[4]; s1 += pO1[5]; s2 += pO1[6]; s3 += pO1[7]; s0 += pO1[8]; s1 += pO1[9]; s2 += pO1[10]; s3 += pO1[11];
  SBAR();
  pN0 = ATT_MFMA(b0, qr[1], pN0); SBAR();
  s0 += pO1[12]; s1 += pO1[13]; s2 += pO1[14]; s3 += pO1[15];
  float ps_lane = (s0 + s1) + (s2 + s3);
  if (__builtin_expect(__any(!(ps_lane <= ATT_PLIM)), 0)) att_redo<true>(pO0, pO1, pN0, pN1, o, negm, l_reg, ps_lane, al_l, r32, hi);
  { auto rr = __builtin_amdgcn_permlane32_swap(__float_as_uint(ps_lane), __float_as_uint(ps_lane), false, false);
    l_reg += __uint_as_float(rr[0]) + __uint_as_float(rr[1]); }
#pragma unroll
  for (int i = 0; i < 4; ++i) { int w = undef_i(); w = __builtin_amdgcn_cvt_pk_fp8_f32(pO0[4 * i], pO0[4 * i + 1], w, false); w = __builtin_amdgcn_cvt_pk_fp8_f32(pO0[4 * i + 2], pO0[4 * i + 3], w, true); pa[i] = w; }
  SBAR();
  pN1 = ATT_MFMA(b1, qr[1], pN1); SBAR();
#pragma unroll
  for (int i = 0; i < 4; ++i) { int x = undef_i(); x = __builtin_amdgcn_cvt_pk_fp8_f32(pO1[4 * i], pO1[4 * i + 1], x, false); x = __builtin_amdgcn_cvt_pk_fp8_f32(pO1[4 * i + 2], pO1[4 * i + 3], x, true); pa[4 + i] = x; }
  asm volatile("" : "+v"(pa));
  v8i_t vb[4];
  { const int sw = (r32 >> 2) & 3;
#pragma unroll
    for (int db = 0; db < 4; ++db) { const char* row = Vs + (db * 32 + r32) * 64;
      vb[db].lo = *reinterpret_cast<const v4i_t*>(row + (((2 * hi) ^ sw) << 4)); vb[db].hi = *reinterpret_cast<const v4i_t*>(row + (((2 * hi + 1) ^ sw) << 4)); } }
  SBAR();
#pragma unroll
  for (int db = 0; db < 4; ++db) {
    o[db] = ATT_MFMA(pa, vb[db], o[db]); SBAR();
#pragma unroll
    for (int r = 0; r < 4; ++r) pN0[4 * db + r] = __builtin_amdgcn_exp2f(pN0[4 * db + r]);
    asm volatile("" : "+v"(pN0));
    SBAR(); }
}
__device__ __forceinline__ void att_last(f32x16& pO0, f32x16& pO1, f32x16* o, const v8i_t* qr, f32x16& negm, float& l_reg, const char* KsO, const char* Vs, float* al_l, int r32, int hi) {
  float ps_lane = 0.f; v8i_t pa;
#pragma unroll
  for (int r = 0; r < 16; ++r) { pO1[r] = __builtin_amdgcn_exp2f(pO1[r]); ps_lane += pO0[r] + pO1[r]; }
  if (__builtin_expect(__any(!(ps_lane <= ATT_PLIM)), 0)) att_redo<false>(pO0, pO1, pO0, pO1, o, negm, l_reg, ps_lane, al_l, r32, hi);
  { auto rr = __builtin_amdgcn_permlane32_swap(__float_as_uint(ps_lane), __float_as_uint(ps_lane), false, false);
    l_reg += __uint_as_float(rr[0]) + __uint_as_float(rr[1]); }
  att_pack(pO0, pO1, pa); SBAR();
  pv_d0(o, Vs, pa, r32, hi);
}

__device__ __forceinline__ void attn_dense_body(const unsigned char* __restrict__ Qb, const unsigned char* __restrict__ Kh, const unsigned char* __restrict__ Vh, unsigned char* Ob, int ldo, float oscale, int seq, char* lds) {
  int tid = threadIdx.x; asm volatile("" : "+v"(tid));
  const int wid = tid >> 6, lane = tid & 63, r32 = lane & 31, hi = lane >> 5;
  char* V_lds = lds; char* K_lds = lds + NBUF * SHM_V;
  float* ws = (float*)(lds + NBUF * SHM_V + NBUF * SHM_K) + wid * 64; float* li_l = ws; float* al_l = ws + 32;
  float l_reg = 0; f32x16 o[4] = {}; v8i_t qr[2]; f32x16 negm;
#pragma unroll
  for (int r = 0; r < 16; ++r) negm[r] = 4.f;
  const unsigned char* Qw = Qb + (long)(wid * QBLK + r32) * LDQ + hi * 32;
#pragma unroll
  for (int sq = 0; sq < 2; ++sq) { qr[sq].lo = *reinterpret_cast<const v4i_t*>(Qw + sq * 64); qr[sq].hi = *reinterpret_cast<const v4i_t*>(Qw + sq * 64 + 16); }
  const int kkey = tid >> 3, ksrc = (long)kkey * LDK + (((tid & 7) ^ (kkey & 7)) << 4);
  typedef __attribute__((address_space(3))) unsigned lds_u32;
  const unsigned ldsK = (unsigned)(uintptr_t)K_lds + (unsigned)wid * 1024u, ldsV = (unsigned)(uintptr_t)V_lds + (unsigned)wid * 1024u;
#define DMA_TILE(t_, slot_) do { \
    __builtin_amdgcn_global_load_lds((const unsigned*)(Kh + (long)(t_) * KVBLK * LDK + ksrc), (lds_u32*)(uintptr_t)(unsigned)__builtin_amdgcn_readfirstlane((int)(ldsK + (unsigned)(slot_))), 16, 0, 0); \
    __builtin_amdgcn_global_load_lds((const unsigned*)(Vh + (long)(t_) * VTS + tid * 16), (lds_u32*)(uintptr_t)(unsigned)__builtin_amdgcn_readfirstlane((int)(ldsV + (unsigned)(slot_))), 16, 0, 0); } while (0)
#define RESC(a) do { if (__any((a) < 1.f)) { if (hi == 0) al_l[r32] = (a); asm volatile("s_waitcnt lgkmcnt(0)" ::: "memory"); \
    for (int d = 0; d < 4; ++d) for (int r = 0; r < 16; ++r) o[d][r] *= al_l[crow(r, hi)]; } } while (0)
  f32x16 pA0, pA1, pB0, pB1; float alA, alB; v8i_t pa; const int NT = seq / KVBLK;
  int c6 = 1;
#define SL6(d_) ((unsigned)((c6 + (d_) >= 6 ? c6 + (d_) - 6 : c6 + (d_)) << 13))
  DMA_TILE(0, 0); DMA_TILE(1, SHM_K); DMA_TILE(2, 2 * SHM_K); asm volatile("s_waitcnt vmcnt(0)" ::: "memory"); __syncthreads();
  qkt(pA0, pA1, K_lds, qr, negm, r32, hi); partialSM(pA0, pA1, negm, alA, true);
  for (int j = 1; j + 1 < NT; j += 2) {
    DMA_TILE(j + 2, SL6(2)); if (j + 3 < NT) DMA_TILE(j + 3, SL6(3));
    att_step(pB0, pB1, pA0, pA1, o, qr, negm, l_reg, K_lds + SL6(0), K_lds + SL6(5), V_lds + SL6(5), al_l, r32, hi);
    att_step(pA0, pA1, pB0, pB1, o, qr, negm, l_reg, K_lds + SL6(1), K_lds + SL6(0), V_lds + SL6(0), al_l, r32, hi);
    asm volatile("s_waitcnt vmcnt(0)" ::: "memory"); __syncthreads();
    c6 = c6 + 2 >= 6 ? c6 + 2 - 6 : c6 + 2;
  }
  att_step(pB0, pB1, pA0, pA1, o, qr, negm, l_reg, K_lds + SL6(0), K_lds + SL6(5), V_lds + SL6(5), al_l, r32, hi);
  att_last(pB0, pB1, o, qr, negm, l_reg, K_lds + SL6(0), V_lds + SL6(0), al_l, r32, hi);
#undef SL6
  if (hi == 0) li_l[r32] = l_reg; asm volatile("s_waitcnt lgkmcnt(0)" ::: "memory");
  float rli[16];
#pragma unroll
  for (int r = 0; r < 16; ++r) rli[r] = __builtin_amdgcn_rcpf(li_l[crow(r, hi)]) * (1.f / V8);
  __syncthreads();
  { unsigned char* stg = (unsigned char*)(lds + wid * 4096);
#pragma unroll
    for (int r = 0; r < 16; ++r) { const int orow = crow(r, hi);
#pragma unroll
      for (int d0 = 0; d0 < 4; ++d0) { const float v = fminf(fmaxf(o[d0][r] * rli[r] * oscale, -448.f), 448.f); stg[orow * 128 + d0 * 32 + r32] = (unsigned char)__builtin_amdgcn_cvt_pk_fp8_f32(v, v, 0, false); } }
    asm volatile("s_waitcnt lgkmcnt(0)" ::: "memory");
    int rb = (lane >> 3) * 128 + (lane & 7) * 16; asm volatile("" : "+v"(rb));
    const unsigned char* rp = stg + rb;
    unsigned char* op = (unsigned char*)Ob + (long)(wid * QBLK + (rb >> 7)) * ldo + ((rb >> 4) & 7) * 16;
#pragma unroll
    for (int i = 0; i < 4; ++i) { const u32x4 v = *(const u32x4*)(rp + i * 1024); *(u32x4*)op = v; op += 8 * ldo; } }
  __syncthreads();
#undef DMA_TILE
#undef RESC
}
#undef KSWZ
#undef SBAR
}
constexpr int NWAVES = 8;
constexpr int DM = 2048, BATCH = 4, SEQ = 4096, CTXL = 256, NLAT = BATCH * SEQ, NCTX = BATCH * CTXL, MALL = NLAT + NCTX;
constexpr int INW = 13312, KVW = 512, SKV = SEQ + CTXL;
constexpr int C_Q = 0, C_K = 2048, C_V = 2560, C_U = 3072, C_GB = 5120, C_GC = 7168, C_GA = 9216, C_GV = 11264;
constexpr int NEXP = 16384;
constexpr float EPS = 1e-6f;
#ifndef PROBE_GMODE
#define PROBE_GMODE 0
#endif
#ifndef PROBE_DUP
#define PROBE_DUP 0
#endif
#ifndef MK_ONE_LAUNCH
#define MK_ONE_LAUNCH 1
#endif
constexpr int NPH_LAYER = 12, NPH = 3 + 2 * NPH_LAYER;

constexpr size_t MiB = 1u << 20;
constexpr size_t WS_CTL = 0, CTL_ZERO_BYTES = 1 * MiB;
constexpr size_t CTL_MOD = 65536;
constexpr size_t WS_K1B = 1 * MiB, WS_K2B = WS_K1B + 524288;
constexpr size_t WS_WIN = 2 * MiB  , WS_W2 = 106 * MiB, WS_WO = 138 * MiB, WS_WQ = 154 * MiB;
constexpr size_t WS_PU = 170 * MiB, WS_PV = 234 * MiB;
constexpr size_t WS_Q = 300 * MiB;
constexpr float G8_SCALE = 16.f;
constexpr float AT8_SCALE = 32.f, CV8_SCALE = 8.f;
constexpr size_t WS_HS = 299 * MiB;
constexpr float W8_SCALE = 1024.f, MG8_SCALE = 64.f;
constexpr float W8_SCALE_UNUSED = 0.f;
constexpr size_t WS_SU = 298 * MiB, WS_SV = WS_SU + 131072;
constexpr size_t WS_XS = 336 * MiB;
constexpr size_t WS_H = 434 * MiB;
constexpr size_t WS_KB = 502 * MiB, WS_VB = 519 * MiB;
constexpr size_t WS_A2 = 536 * MiB;
constexpr size_t WS_P = 672 * MiB;
constexpr size_t WS_PQ = WS_P, WS_IDX = WS_P + 68 * MiB, WS_GW = WS_P + 80 * MiB;
constexpr size_t WS_MODP = 1114 * MiB;
constexpr size_t WS_END = 1122 * MiB;
constexpr int CW_BAR = 4096;

constexpr int PHASE_LDS = 149504, MISC_OFF = PHASE_LDS, LDS_BYTES = PHASE_LDS + 1024;

#define GAS __attribute__((address_space(1)))
#define LAS __attribute__((address_space(3)))
typedef unsigned short bf16;
typedef unsigned v4u __attribute__((ext_vector_type(4)));
typedef unsigned v2u __attribute__((ext_vector_type(2)));
typedef float v4f __attribute__((ext_vector_type(4)));
typedef __bf16 bf16x2_t __attribute__((ext_vector_type(2)));
#define LDS_WAIT() asm volatile("s_waitcnt lgkmcnt(0)" ::: "memory")
#define VM_WAIT() asm volatile("s_waitcnt vmcnt(0)" ::: "memory")
__device__ __forceinline__ unsigned f2bf(float f) { unsigned u = __builtin_bit_cast(unsigned, f); return (u + 0x7fffu + ((u >> 16) & 1u)) >> 16; }
__device__ __forceinline__ unsigned pk2(float lo, float hi) { return f2bf(lo) | (f2bf(hi) << 16); }
__device__ __forceinline__ float bflo(unsigned w) { return __uint_as_float(w << 16); }
__device__ __forceinline__ float bfhi(unsigned w) { return __uint_as_float(w & 0xffff0000u); }
__device__ __forceinline__ float dot2bf(unsigned a, unsigned b, float c) { return __builtin_amdgcn_fdot2_f32_bf16(__builtin_bit_cast(bf16x2_t, a), __builtin_bit_cast(bf16x2_t, b), c, false); }
template <int CTRL> __device__ __forceinline__ float dppf(float v) { return __builtin_bit_cast(float, __builtin_amdgcn_update_dpp(0, __builtin_bit_cast(int, v), CTRL, 0xF, 0xF, true)); }
template <int CTRL> __device__ __forceinline__ unsigned dppu(unsigned v) { return (unsigned)__builtin_amdgcn_update_dpp(0, (int)v, CTRL, 0xF, 0xF, true); }
constexpr int DPP_X1 = 0xB1, DPP_X2 = 0x4E, DPP_HMIR = 0x141, DPP_MIR = 0x140, DPP_ROR8 = 0x128;
__device__ __forceinline__ float wave_sum(float v) {
#pragma unroll
    for (int o = 1; o < 64; o <<= 1) v += __shfl_xor(v, o);
    return v;
}
__device__ __forceinline__ float sum16(float v) {
    v += dppf<DPP_X1>(v); v += dppf<DPP_X2>(v); v += dppf<DPP_HMIR>(v); v += dppf<DPP_MIR>(v); return v;
}
__device__ __forceinline__ unsigned max32u(unsigned v) {
    v = max(v, dppu<DPP_X1>(v)); v = max(v, dppu<DPP_X2>(v)); v = max(v, dppu<DPP_HMIR>(v)); v = max(v, dppu<DPP_MIR>(v));
    v = max(v, (unsigned)__shfl_xor((int)v, 16)); return v;
}
__device__ __forceinline__ float gelu_erf(float v) {
    const float av = fabsf(v), t = __builtin_amdgcn_rcpf(av * 0.2316418882f + 1.0f);
    float q = t * 0.5307027145f + (-0.7265760135f); q = q * t + 0.7107068705f; q = q * t + (-0.142248368f); q = q * t + 0.127414796f; q = q * t;
    const float e = __builtin_amdgcn_exp2f((v * v) * (-0.72134752044f));
    const float m = v * (q * e); return v < 0.f ? m : v - m;
}
#define XB_TMO      128
#define XB_XCNT(j)  (256  + 64 * (j))
#define XB_XSUB(j)  (1280 + 64 * (j))
#define XB_XGEN(j)  (2304 + 64 * (j))
#define XB_TOP      3328
#define XB_TOPGEN   3392
#define XCD_BAR_WORDS 3456
#define XB_SPIN_CAP (1u << 18)

__device__ __forceinline__ unsigned xb_ld(unsigned* p)              { return __hip_atomic_load(p, __ATOMIC_RELAXED, __HIP_MEMORY_SCOPE_AGENT); }
__device__ __forceinline__ unsigned xb_add(unsigned* p, unsigned v) { return __hip_atomic_fetch_add(p, v, __ATOMIC_RELAXED, __HIP_MEMORY_SCOPE_AGENT); }
__device__ __forceinline__ unsigned xb_xcc_id() { return (unsigned)__builtin_amdgcn_s_getreg((3 << 11) | 20) & 0xFu; }
#define XB_SPIN(cond, bar) do { unsigned _sp = 0; while (cond) { __builtin_amdgcn_s_sleep(1); \
    if ((++_sp & 255u) == 0u) { if (xb_ld(&(bar)[XB_TMO])) break; if (_sp > XB_SPIN_CAP) { atomicAdd(&(bar)[XB_TMO], 1u); break; } } } } while (0)

struct XcdBarrier {
    unsigned* bar; unsigned x;
    volatile LAS unsigned* st;
};

__device__ __forceinline__ XcdBarrier xcd_barrier_post(unsigned* bar, volatile LAS unsigned* st) {
    XcdBarrier b; b.bar = bar; b.x = xb_xcc_id(); b.st = st;
    if (threadIdx.x == 0) (void)xb_add(&bar[XB_XCNT(b.x)], 1u);
    return b;
}
__device__ __forceinline__ void xcd_barrier_complete(unsigned* bar, unsigned x, unsigned& nloc, unsigned& nx) {
    const unsigned G = gridDim.x * gridDim.y * gridDim.z;
    unsigned sum, cnt, mine, sp = 0u;
    for (;;) {
        sum = 0u; cnt = 0u; mine = 0u;
#pragma unroll
        for (unsigned j = 0; j < 16; ++j) { const unsigned c = xb_ld(&bar[XB_XCNT(j)]); sum += c; cnt += (c > 0u) ? 1u : 0u; mine = (j == x) ? c : mine; }
        if (sum == G) break;
        __builtin_amdgcn_s_sleep(1);
        if ((++sp & 255u) == 0u) { if (xb_ld(&bar[XB_TMO])) break; if (sp > XB_SPIN_CAP) { atomicAdd(&bar[XB_TMO], 1u); break; } }
    }
    nloc = mine > 0u ? mine : 1u; nx = cnt > 0u ? cnt : 1u;
}

__device__ __forceinline__ void xcd_barrier(const XcdBarrier& b) {
    asm volatile("s_waitcnt vmcnt(0)" ::: "memory");
    __syncthreads();
    if (threadIdx.x == 0) {
        unsigned* bar = b.bar;
        __builtin_amdgcn_s_waitcnt(0);
        unsigned nloc = b.st[0], nx = b.st[1];
        if (nloc == 0u) { xcd_barrier_complete(bar, b.x, nloc, nx); b.st[0] = nloc; b.st[1] = nx; }
        const unsigned old = xb_add(&bar[XB_XSUB(b.x)], 1u);
        const unsigned gen = old / nloc;
        if (old + 1u == (gen + 1u) * nloc) {
            __builtin_amdgcn_fence(__ATOMIC_RELEASE, "agent");
            asm volatile("s_waitcnt vmcnt(0)" ::: "memory");
            const unsigned og = xb_add(&bar[XB_TOP], 1u);
            const unsigned tg = og / nx;
            if (og + 1u == (tg + 1u) * nx) xb_add(&bar[XB_TOPGEN], 1u);
            else XB_SPIN(xb_ld(&bar[XB_TOPGEN]) == tg, bar);
            __builtin_amdgcn_fence(__ATOMIC_ACQUIRE, "agent");
            xb_add(&bar[XB_XGEN(b.x)], 1u);
            asm volatile("s_waitcnt vmcnt(0)" ::: "memory");
        } else {
            XB_SPIN(xb_ld(&bar[XB_XGEN(b.x)]) == gen, bar);
            __builtin_amdgcn_fence(__ATOMIC_ACQUIRE, "agent");
            asm volatile("s_waitcnt vmcnt(0)" ::: "memory");
        }
    }
    __syncthreads();
}
struct Frame {
    LAS unsigned char* lds; unsigned char* ldsg;
    int tid, lane, wave, vcu, G, gw, NGW;
    const float *x, *c, *ctx, *c_ctx, *ada_w, *ada_b, *norm1_g, *norm2_g, *w_in, *b_gate, *q_norm_g, *k_norm_g, *conv_w, *w_ao, *w_co, *w_o, *peer_wq, *peer_k1, *peer_k2, *peer_u, *peer_v, *final_g;
    float* out; unsigned char* ws;
    float* mod;
};

__device__ __forceinline__ void frame_refresh(Frame& F) {
    int tid = threadIdx.x; asm volatile("" : "+v"(tid));
    F.tid = tid; F.lane = tid & 63; F.wave = __builtin_amdgcn_readfirstlane(tid >> 6);
    int bx = blockIdx.x; asm volatile("" : "+s"(bx));
    F.vcu = (F.G % 8 == 0) ? (bx % 8) * (F.G / 8) + bx / 8 : bx;
    F.gw = F.vcu * NWAVES + F.wave; F.NGW = F.G * NWAVES;
}
__device__ __forceinline__ void p0_transpose_item(const float* W, int N, bf16* WT, int ldk, int koff, LAS float* scr, int item, int lane) {
    const int nblk = N / 32, kb = item / nblk, nb = item % nblk, k0 = 64 * kb, n0 = 32 * nb;
#pragma unroll 8
    for (int i = 0; i < 32; ++i) { const int kk = 2 * i + (lane >> 5); scr[kk * 33 + (lane & 31)] = W[(size_t)(k0 + kk) * N + n0 + (lane & 31)]; }
    LDS_WAIT(); asm volatile("" ::: "memory");
    const int c = lane & 7;
#pragma unroll
    for (int j = 0; j < 4; ++j) { const int n = (lane >> 3) + 8 * j; const LAS float* s = scr + (8 * c) * 33 + n;
        v4u o; o.x = pk2(s[0 * 33], s[1 * 33]); o.y = pk2(s[2 * 33], s[3 * 33]); o.z = pk2(s[4 * 33], s[5 * 33]); o.w = pk2(s[6 * 33], s[7 * 33]);
        *(GAS v4u*)(WT + (size_t)(n0 + n) * ldk + koff + k0 + 8 * c) = o; }
    LDS_WAIT(); asm volatile("" ::: "memory");
}
__device__ __forceinline__ void p0_transpose_item8(const float* W, int N, unsigned char* WT, int ldk, LAS float* scr, int item, int lane) {
    const int nblk = N / 32, kb = item / nblk, nb = item % nblk, k0 = 64 * kb, n0 = 32 * nb;
#pragma unroll 8
    for (int i = 0; i < 32; ++i) { const int kk = 2 * i + (lane >> 5); scr[kk * 33 + (lane & 31)] = W[(size_t)(k0 + kk) * N + n0 + (lane & 31)]; }
    LDS_WAIT(); asm volatile("" ::: "memory");
    const int c = lane & 7;
#pragma unroll
    for (int j = 0; j < 4; ++j) { const int n = (lane >> 3) + 8 * j; const LAS float* s = scr + (8 * c) * 33 + n; float f[8];
#pragma unroll
        for (int i = 0; i < 8; ++i) f[i] = fminf(fmaxf(s[i * 33] * W8_SCALE, -448.f), 448.f);
        int w0 = 0, w1 = 0; w0 = __builtin_amdgcn_cvt_pk_fp8_f32(f[0], f[1], w0, false); w0 = __builtin_amdgcn_cvt_pk_fp8_f32(f[2], f[3], w0, true);
        w1 = __builtin_amdgcn_cvt_pk_fp8_f32(f[4], f[5], w1, false); w1 = __builtin_amdgcn_cvt_pk_fp8_f32(f[6], f[7], w1, true);
        v2u o; o.x = (unsigned)w0; o.y = (unsigned)w1; *(GAS v2u*)(WT + (size_t)(n0 + n) * ldk + k0 + 8 * c) = o; }
    LDS_WAIT(); asm volatile("" ::: "memory");
}
__device__ __forceinline__ void p0_cvt_item(const float* src, bf16* dst, size_t item, int lane) {
    const float* s = src + item * 4096 + lane * 8; bf16* d = dst + item * 4096 + lane * 8;
#pragma unroll
    for (int j = 0; j < 8; ++j) { const v4f a = *(const GAS v4f*)(s + j * 512), b = *(const GAS v4f*)(s + j * 512 + 4);
        v4u o; o.x = pk2(a.x, a.y); o.y = pk2(a.z, a.w); o.z = pk2(b.x, b.y); o.w = pk2(b.z, b.w); *(GAS v4u*)(d + j * 512) = o; }
}
__device__ __forceinline__ void p0_fp8_row(const float* src, unsigned char* dst, float* scale, int lane) {
    const GAS v4f* xr = (const GAS v4f*)src + lane; v4f v[8]; float am = 0.f;
#pragma unroll
    for (int j = 0; j < 8; ++j) { v[j] = xr[64 * j]; am = fmaxf(am, fmaxf(fmaxf(fabsf(v[j].x), fabsf(v[j].y)), fmaxf(fabsf(v[j].z), fabsf(v[j].w)))); }
#pragma unroll
    for (int o = 1; o < 64; o <<= 1) am = fmaxf(am, __shfl_xor(am, o));
    const float inv = am > 0.f ? 448.f / am : 0.f;
    if (lane == 0) *scale = am * (1.f / 448.f);
#pragma unroll
    for (int j = 0; j < 8; ++j) { int w = 0; w = __builtin_amdgcn_cvt_pk_fp8_f32(v[j].x * inv, v[j].y * inv, w, false); w = __builtin_amdgcn_cvt_pk_fp8_f32(v[j].z * inv, v[j].w * inv, w, true);
        *(GAS int*)(dst + (size_t)(2 * j + (lane >> 5)) * ((size_t)16384 * 128) + 4 * (lane & 31)) = w; }
}
__device__ __forceinline__ void p0_ada_item(Frame& F, const LAS float* sl, int item) {
    const int kc = item & 15, nb = (item >> 4) % 48, l = item / (16 * 48);
    const float* W = F.ada_w + ((size_t)l * DM + kc * 128) * 12288 + nb * 256 + F.lane * 4;
    v4f acc[5];
#pragma unroll
    for (int r = 0; r < 5; ++r) acc[r] = (v4f){0.f, 0.f, 0.f, 0.f};
#pragma unroll 4
    for (int k = 0; k < 128; ++k) { const v4f w = *(const GAS v4f*)(W + (size_t)k * 12288);
#pragma unroll
        for (int r = 0; r < 5; ++r) acc[r] += w * sl[r * DM + kc * 128 + k]; }
    float* m = (float*)(F.ws + WS_MODP) + ((size_t)kc * 2 + l) * 5 * 12288 + nb * 256 + F.lane * 4;
#pragma unroll
    for (int r = 0; r < 5; ++r) *(GAS v4f*)(m + r * 12288) = acc[r];
}
__device__ __forceinline__ void mod_reduce_phase(Frame& F) {
    frame_refresh(F);
    const float* mp = (const float*)(F.ws + WS_MODP);
    for (int i = F.gw * 64 + F.lane; i < 2 * 5 * 12288 / 4; i += F.NGW * 64) { v4f s = (v4f){0.f, 0.f, 0.f, 0.f};
#pragma unroll
        for (int kc = 0; kc < 16; ++kc) s += *(const GAS v4f*)(mp + (size_t)kc * 2 * 5 * 12288 + (size_t)i * 4);
        *(GAS v4f*)(F.mod + (size_t)i * 4) = s; }
}
__device__ __forceinline__ void p0_prologue(Frame& F) {
    frame_refresh(F);
    LAS float* scr = (LAS float*)(F.lds + F.wave * 9216);
    LAS float* sl = (LAS float*)(F.lds + 8 * 9216);
    for (int i = F.tid; i < 5 * DM; i += NWAVES * 64) { const float v = (i < 4 * DM) ? F.c[i] : F.c_ctx[i - 4 * DM]; sl[i] = v / (1.f + __expf(-v)); }
    __syncthreads();
    constexpr int I_ADA = 2 * 48 * 16;
    constexpr int I_WIN = 2 * 32 * (INW / 32);
    constexpr int I_SQ = 2 * 32 * 64;
    constexpr int I_UV = 2 * NEXP;
    constexpr int I_KEY = 2 * 8 * 128 * 128 / 4096;
    constexpr int NITEMS = I_ADA + I_WIN + 4 * I_SQ + 2 * I_UV + 2 * I_KEY;
    for (int it = F.gw; it < NITEMS; it += F.NGW) {
        int r = it;
        if (r < I_ADA) { p0_ada_item(F, sl, r); continue; } r -= I_ADA;
        if (r < I_WIN) { const int l = r / (I_WIN / 2), q = r % (I_WIN / 2); p0_transpose_item8(F.w_in + (size_t)l * DM * INW, INW, F.ws + WS_WIN + (size_t)l * INW * DM, DM, scr, q, F.lane); continue; } r -= I_WIN;
        if (r < 4 * I_SQ) { const int mtx = r / I_SQ, rr = r % I_SQ, l = rr / (I_SQ / 2), q = rr % (I_SQ / 2);
            const size_t mo = (size_t)l * DM * DM;
            if (mtx == 0) p0_transpose_item8(F.w_ao + mo, DM, F.ws + WS_W2 + (size_t)l * DM * 4096, 4096, scr, q, F.lane);
            else if (mtx == 1) p0_transpose_item8(F.w_co + mo, DM, F.ws + WS_W2 + (size_t)l * DM * 4096 + DM, 4096, scr, q, F.lane);
            else if (mtx == 2) p0_transpose_item8(F.w_o + mo, DM, F.ws + WS_WO + mo, DM, scr, q, F.lane);
            else p0_transpose_item(F.peer_wq + mo, DM, (bf16*)(F.ws + WS_WQ) + mo, DM, 0, scr, q, F.lane);
            continue; } r -= 4 * I_SQ;
        if (r < 2 * I_UV) { const int tb = r / I_UV, row = r % I_UV; p0_fp8_row((tb ? F.peer_v : F.peer_u) + (size_t)row * DM, F.ws + (tb ? WS_PV : WS_PU) + (size_t)(row / NEXP) * NEXP * DM + (size_t)(row % NEXP) * 128, (float*)(F.ws + (tb ? WS_SV : WS_SU)) + row, F.lane); continue; } r -= 2 * I_UV;
        { const int tb = r / I_KEY; p0_cvt_item(tb ? F.peer_k2 : F.peer_k1, (bf16*)(F.ws + (tb ? WS_K2B : WS_K1B)), (size_t)(r % I_KEY), F.lane); }
    }
}

__device__ __forceinline__ const float* xrow_ptr(const float* xlat, const float* xctx, int row) { return row < NLAT ? xlat + (size_t)row * DM : xctx + (size_t)(row - NLAT) * DM; }
template <bool IN16> __device__ __forceinline__ int row_col(int j, int lane) { return IN16 ? 8 * lane + 512 * (j >> 1) + 4 * (j & 1) : 4 * lane + 256 * j; }
template <bool IN16>
__device__ __forceinline__ void quant_row8(const v4f (&y)[8], unsigned char* orow8, float* hs, int lane) {
    float am = 0.f;
#pragma unroll
    for (int j = 0; j < 8; ++j) am = fmaxf(am, fmaxf(fmaxf(fabsf(y[j].x), fabsf(y[j].y)), fmaxf(fabsf(y[j].z), fabsf(y[j].w))));
#pragma unroll
    for (int o = 1; o < 64; o <<= 1) am = fmaxf(am, __shfl_xor(am, o));
    const float inv = am > 0.f ? 448.f / am : 0.f;
    if (lane == 0) *hs = am * (1.f / 448.f);
#pragma unroll
    for (int j = 0; j < 8; ++j) { int w = 0; w = __builtin_amdgcn_cvt_pk_fp8_f32(y[j].x * inv, y[j].y * inv, w, false); w = __builtin_amdgcn_cvt_pk_fp8_f32(y[j].z * inv, y[j].w * inv, w, true);
        *(GAS int*)(orow8 + row_col<IN16>(j, lane)) = w; }
}
template <bool IN16> __device__ __forceinline__ void load_row(v4f (&d)[8], const float* xlat, const float* xctx, const bf16* xs, int row, int lane) {
    if constexpr (IN16) { const GAS v4u* p = (const GAS v4u*)(xs + (size_t)row * DM) + lane;
#pragma unroll
        for (int j = 0; j < 4; ++j) { const v4u w = p[64 * j]; d[2 * j] = (v4f){bflo(w.x), bfhi(w.x), bflo(w.y), bfhi(w.y)}; d[2 * j + 1] = (v4f){bflo(w.z), bfhi(w.z), bflo(w.w), bfhi(w.w)}; }
    } else { const GAS v4f* xr = (const GAS v4f*)(row < NLAT ? xlat + (size_t)row * DM : xctx + (size_t)(row - NLAT) * DM) + lane;
#pragma unroll
        for (int j = 0; j < 8; ++j) d[j] = xr[64 * j]; }
}
template <int F8, bool IN16>
__device__ __forceinline__ void norm_phase(Frame& F, const float* xlat, const float* xctx, int nrows, int l, const float* g, int csh, int csc) {
    frame_refresh(F); asm volatile("" : "+s"(l));
    bf16* H = (bf16*)(F.ws + WS_H); const bf16* XS = (const bf16*)(F.ws + WS_XS);
    const float* modl = F.mod + (size_t)l * 5 * 12288; const float* bl = F.ada_b + (size_t)l * 12288;
    const int lane = F.lane;
    const int r0 = (int)(((long)F.gw * nrows) / F.NGW), r1 = (int)(((long)(F.gw + 1) * nrows) / F.NGW);
    if (r0 >= r1) return;
    v4f cur[8], nxt[8], Av[8], Bv[8]; int have = -1;
    load_row<IN16>(cur, xlat, xctx, XS, r0, lane);
    for (int row = r0; row < r1; ++row) {
        if (row + 1 < r1) load_row<IN16>(nxt, xlat, xctx, XS, row + 1, lane);
        const int mr = row < NLAT ? row / SEQ : 4;
        if (mr != have) { have = mr;
            const float* msh = modl + mr * 12288 + csh * DM; const float* msc = modl + mr * 12288 + csc * DM; const float* bsh = bl + csh * DM; const float* bsc = bl + csc * DM;
#pragma unroll
            for (int j = 0; j < 8; ++j) { const int cidx = row_col<IN16>(j, lane);
                Av[j] = *(const v4f*)(g + cidx) * (*(const v4f*)(msc + cidx) + *(const v4f*)(bsc + cidx) + 1.f); Bv[j] = *(const v4f*)(msh + cidx) + *(const v4f*)(bsh + cidx); } }
        float s = 0.f;
#pragma unroll
        for (int j = 0; j < 8; ++j) s += (cur[j].x * cur[j].x + cur[j].y * cur[j].y) + (cur[j].z * cur[j].z + cur[j].w * cur[j].w);
        const float rstd = rsqrtf(wave_sum(s) * (1.f / DM) + EPS);
        bf16* orow = H + (size_t)row * DM; v4f yv[8];
#pragma unroll
        for (int j = 0; j < 8; ++j) { const int cidx = row_col<IN16>(j, lane);
            const v4f y = (cur[j] * rstd) * Av[j] + Bv[j]; yv[j] = y;
            if (!F8) { v2u o; o.x = pk2(y.x, y.y); o.y = pk2(y.z, y.w); *(GAS v2u*)(orow + cidx) = o; } }
        if (F8) quant_row8<IN16>(yv, (unsigned char*)H + (size_t)row * DM, (float*)(F.ws + WS_HS) + row, lane);
#pragma unroll
        for (int j = 0; j < 8; ++j) cur[j] = nxt[j];
    }
}
__device__ __forceinline__ void unpack8(const v2u w, float (&f)[8]) {
    typedef float f2_t __attribute__((ext_vector_type(2))); const float k = 1.f / G8_SCALE;
    const f2_t a = __builtin_amdgcn_cvt_pk_f32_fp8((int)w.x, false), b = __builtin_amdgcn_cvt_pk_f32_fp8((int)w.x, true), c = __builtin_amdgcn_cvt_pk_f32_fp8((int)w.y, false), d = __builtin_amdgcn_cvt_pk_f32_fp8((int)w.y, true);
    f[0] = a.x * k; f[1] = a.y * k; f[2] = b.x * k; f[3] = b.y * k; f[4] = c.x * k; f[5] = c.y * k; f[6] = d.x * k; f[7] = d.y * k; }
__device__ __forceinline__ void unpack8(const v4u w, float (&f)[8]) { f[0] = bflo(w.x); f[1] = bfhi(w.x); f[2] = bflo(w.y); f[3] = bfhi(w.y); f[4] = bflo(w.z); f[5] = bfhi(w.z); f[6] = bflo(w.w); f[7] = bfhi(w.w); }
__device__ __forceinline__ v4u pack8(const float (&f)[8]) { v4u o; o.x = pk2(f[0], f[1]); o.y = pk2(f[2], f[3]); o.z = pk2(f[4], f[5]); o.w = pk2(f[6], f[7]); return o; }
__device__ __forceinline__ v2u pack8_fp8(const float (&f)[8], float scale) { float c[8];
#pragma unroll
    for (int i = 0; i < 8; ++i) c[i] = fminf(fmaxf(f[i] * scale, -448.f), 448.f);
    int w0 = 0, w1 = 0; w0 = __builtin_amdgcn_cvt_pk_fp8_f32(c[0], c[1], w0, false); w0 = __builtin_amdgcn_cvt_pk_fp8_f32(c[2], c[3], w0, true);
    w1 = __builtin_amdgcn_cvt_pk_fp8_f32(c[4], c[5], w1, false); w1 = __builtin_amdgcn_cvt_pk_fp8_f32(c[6], c[7], w1, true);
    v2u o; o.x = (unsigned)w0; o.y = (unsigned)w1; return o; }
template <class W>
__device__ __forceinline__ v2u head_norm_rope(const W in, const float (&g)[8], bool rope, const float (&cs)[8], const float (&sn)[8], bool second) {
    float f[8]; unpack8(in, f); float ss = 0.f;
#pragma unroll
    for (int i = 0; i < 8; ++i) ss += f[i] * f[i];
    ss = sum16(ss);
    const float rstd = rsqrtf(ss * (1.f / 128.f) + EPS);
#pragma unroll
    for (int i = 0; i < 8; ++i) f[i] = f[i] * rstd * g[i];
    if (rope) {
        float o[8];
#pragma unroll
        for (int i = 0; i < 8; ++i) { const float pv = __shfl_xor(f[i], 4); o[i] = second ? f[i] * cs[i] + pv * sn[i] : f[i] * cs[i] - pv * sn[i]; }
        return pack8_fp8(o, att::QK8);
    }
    return pack8_fp8(f, att::QK8);
}
template <int VARX = 0>
__device__ __forceinline__ void split_phase(Frame& F, int l, int nfull, int nrows) {
    frame_refresh(F); asm volatile("" : "+s"(l));
    const unsigned char* P = F.ws + WS_P;     unsigned char* A2 = F.ws + WS_A2; unsigned char* QB = F.ws + WS_Q; unsigned char* KB = F.ws + WS_KB; unsigned char* VT = F.ws + WS_VB;
    const int lane = F.lane, l16 = lane & 15;
    float qg[8], kg[8];
#pragma unroll
    for (int i = 0; i < 8; ++i) { qg[i] = F.q_norm_g[l * 128 + l16 * 8 + i]; kg[i] = F.k_norm_g[l * 128 + l16 * 8 + i]; }
    const bool second = (lane >> 2) & 1; const int blk = (lane >> 3) & 1;
    float inv[8];
#pragma unroll
    for (int i = 0; i < 8; ++i) inv[i] = __builtin_amdgcn_exp2f(-(float)((lane & 3) * 8 + i) * (13.287712379549449f / 32.f));
    const float* cw = F.conv_w + (size_t)l * 3 * DM;
    { int row = F.gw;
      if (row < nrows) {
        v2u cq[4], ck, nq[4], nk;
#define QK_LD(q_, k_, r_) do { const unsigned char* pr_ = P + (size_t)(r_) * INW + lane * 8; k_ = *(const GAS v2u*)(pr_ + C_K); \
        if ((r_) < nfull) { _Pragma("unroll") for (int p = 0; p < 4; ++p) q_[p] = *(const GAS v2u*)(pr_ + C_Q + p * 512); } } while (0)
        QK_LD(cq, ck, row);
        for (; row < nrows; row += F.NGW) {
            const int nr = row + F.NGW; if (nr < nrows) QK_LD(nq, nk, nr);
            const bool lat = row < NLAT; const int b = lat ? row / SEQ : (row - NLAT) / CTXL, t = lat ? row % SEQ : (row - NLAT) % CTXL;
            const size_t kvrow = (size_t)b * SKV + (lat ? t : SEQ + t);
            float cs[8], sn[8];
            if (lat) { const float pos = (float)(blk ? (t & 63) : (t >> 6));
#pragma unroll
                for (int i = 0; i < 8; ++i) { const float a = pos * inv[i]; cs[i] = __cosf(a); sn[i] = __sinf(a); } }
            else {
#pragma unroll
                for (int i = 0; i < 8; ++i) { cs[i] = 1.f; sn[i] = 0.f; } }
            *(GAS v2u*)(KB + kvrow * KVW + lane * 8) = head_norm_rope(ck, kg, lat, cs, sn, second);
            if (row < nfull) {
#pragma unroll
                for (int p = 0; p < 4; ++p) *(GAS v2u*)(QB + (size_t)row * DM + p * 512 + lane * 8) = head_norm_rope(cq[p], qg, lat, cs, sn, second); }
#pragma unroll
            for (int p = 0; p < 4; ++p) cq[p] = nq[p];
            ck = nk;
        }
#undef QK_LD
      }
    }
    {
        const float* cw = F.conv_w + (size_t)l * 3 * DM;
        const int r0 = (int)(((long)F.gw * nfull) / F.NGW), r1 = (int)(((long)(F.gw + 1) * nfull) / F.NGW);
        auto seqid = [](int r) { return r < NLAT ? r / SEQ : 4 + (r - NLAT) / CTXL; };
        if (r0 < r1)
        for (int pp = 0; pp < 2; ++pp) {
            float w0[2][8], w1[2][8], w2[2][8];
#pragma unroll
            for (int h = 0; h < 2; ++h)
#pragma unroll
                for (int i = 0; i < 8; ++i) { const int cc = (2 * pp + h) * 512 + lane * 8 + i; w0[h][i] = cw[cc]; w1[h][i] = cw[DM + cc]; w2[h][i] = cw[2 * DM + cc]; }
            const unsigned char* pc = P + (2 * pp) * 512 + lane * 8;
#define CV_LD(U_, G_, B_, r_) do { const unsigned char* q_ = pc + (size_t)(r_) * INW; _Pragma("unroll") for (int h = 0; h < 2; ++h) { U_[h] = *(const GAS v2u*)(q_ + h * 512 + C_U); G_[h] = *(const GAS v2u*)(q_ + h * 512 + C_GC); B_[h] = *(const GAS v2u*)(q_ + h * 512 + C_GB); } } while (0)
            float mp[2][8], mc[2][8], f0[8], f1[8];
            v2u un[2], gn[2], bn_[2], u2[2], g2[2], b2[2], bc[2];
            const bool hp0 = r0 > 0 && seqid(r0 - 1) == seqid(r0);
            { v2u a[2], g[2], bb[2]; CV_LD(a, g, bb, hp0 ? r0 - 1 : r0);
#pragma unroll
              for (int h = 0; h < 2; ++h) { unpack8(a[h], f0); unpack8(g[h], f1);
#pragma unroll
                for (int i = 0; i < 8; ++i) mp[h][i] = hp0 ? f0[i] * f1[i] : 0.f; } }
            { v2u a[2], g[2]; CV_LD(a, g, bc, r0);
#pragma unroll
              for (int h = 0; h < 2; ++h) { unpack8(a[h], f0); unpack8(g[h], f1);
#pragma unroll
                for (int i = 0; i < 8; ++i) mc[h][i] = f0[i] * f1[i]; } }
            const int rlast = nfull - 1;
            CV_LD(un, gn, bn_, min(r0 + 1, rlast));
            for (int row = r0; row < r1; ++row) {
                CV_LD(u2, g2, b2, min(row + 2, rlast));
                const int sid = seqid(row); const bool hp = row > 0 && seqid(row - 1) == sid, hn = row + 1 < nfull && seqid(row + 1) == sid;
#pragma unroll
                for (int h = 0; h < 2; ++h) { float mn[8], gb[8], o[8]; unpack8(un[h], f0); unpack8(gn[h], f1); unpack8(bc[h], gb);
#pragma unroll
                    for (int i = 0; i < 8; ++i) mn[i] = f0[i] * f1[i];
#pragma unroll
                    for (int i = 0; i < 8; ++i) o[i] = gb[i] * (w0[h][i] * (hp ? mp[h][i] : 0.f) + w1[h][i] * mc[h][i] + w2[h][i] * (hn ? mn[i] : 0.f));
                    *(GAS v2u*)(A2 + (size_t)row * 4096 + 2048 + (2 * pp + h) * 512 + lane * 8) = pack8_fp8(o, CV8_SCALE);
#pragma unroll
                    for (int i = 0; i < 8; ++i) { mp[h][i] = mc[h][i]; mc[h][i] = mn[i]; }
                    bc[h] = bn_[h]; un[h] = u2[h]; gn[h] = g2[h]; bn_[h] = b2[h]; }
            }
#undef CV_LD
        }
    }
    { LAS unsigned char* Vt = F.lds; const int tid = F.tid, wave = F.wave;
      for (int T = F.vcu; T < BATCH * (SKV / 64); T += F.G) {
        const int b = T / (SKV / 64), tile = T % (SKV / 64);
#pragma unroll
        for (int j = 0; j < 8; ++j) { const int i = wave * 8 + j, kk = tile * 64 + i; const size_t row = kk < SEQ ? (size_t)b * SEQ + kk : (size_t)NLAT + b * CTXL + (kk - SEQ);
            float f[8]; unpack8(*(const GAS v2u*)(P + row * INW + C_V + lane * 8), f);
            *(LAS v2u*)(Vt + i * 512 + lane * 8) = pack8_fp8(f, att::V8); }
        LDS_WAIT(); __syncthreads();
#pragma unroll
        for (int n = 0; n < 4; ++n) { const int c = tid + 512 * n, d = c & 127, rest = c >> 7, jj = rest & 1, hh = (rest >> 1) & 1, kvh = rest >> 2;
            v4u w;
#pragma unroll
            for (int q = 0; q < 4; ++q) { unsigned x = 0u;
#pragma unroll
                for (int e = 0; e < 4; ++e) { const int i = 4 * q + e, key = jj * 32 + (i & 3) + 8 * (i >> 2) + 4 * hh; x |= (unsigned)Vt[key * 512 + kvh * 128 + d] << (8 * e); }
                w[q] = x; }
            *(GAS v4u*)(VT + ((size_t)(b * (SKV / 64) + tile) * 4 + kvh) * 8192 + d * 64 + ((((hh * 2 + jj) ^ ((d >> 2) & 3))) << 4)) = w; }
        __syncthreads();
      }
    }
}
__device__ __forceinline__ void attn_phase(Frame& F, bool with_ctx, bool dry = false) {
    frame_refresh(F);
    unsigned char* A2 = F.ws + WS_A2; const unsigned char* Q = F.ws + WS_Q; const unsigned char* KB = F.ws + WS_KB; const unsigned char* VT = F.ws + WS_VB;
    const int nunits = 1024 + (with_ctx ? 64 : 0);
    for (int u = F.vcu; u < nunits; u += F.G) {
        size_t row0, ko, vo; int seq, h;
        if (u < 1024) { const int b = u >> 8, kvh = (u >> 6) & 3, g = (u >> 4) & 3, qb = u & 15; h = kvh * 4 + g;
            row0 = (size_t)b * SEQ + qb * 256; ko = (size_t)b * SKV * KVW + kvh * 128; vo = ((size_t)b * (SKV / 64) * 4 + kvh) * 8192; seq = SKV;
        } else { const int v = u - 1024, b = v >> 4; h = v & 15; const int kvh = h >> 2;
            row0 = (size_t)NLAT + b * CTXL; ko = ((size_t)b * SKV + SEQ) * KVW + kvh * 128; vo = ((size_t)(b * (SKV / 64) + SEQ / 64) * 4 + kvh) * 8192; seq = CTXL; }
        unsigned char* od = dry ? F.ws + 404 * MiB + row0 * 2048 + h * 128 : A2 + row0 * 4096 + h * 128;
        att::attn_dense_body(Q + row0 * DM + h * 128, KB + ko, VT + vo, od, dry ? 2048 : 4096, AT8_SCALE, seq, (char*)F.ldsg);
    }
}
__device__ __forceinline__ unsigned f2ord(float f) { const unsigned u = __float_as_uint(f); return u ^ ((u >> 31) ? 0xFFFFFFFFu : 0x80000000u); }
__device__ __forceinline__ float ord2f(unsigned o) { return __uint_as_float(o ^ ((o >> 31) ? 0x80000000u : 0xFFFFFFFFu)); }
typedef short s16x8 __attribute__((ext_vector_type(8)));
typedef float f32x16 __attribute__((ext_vector_type(16)));
__device__ __forceinline__ int crow16(int r, int hi) { return (r & 3) + 8 * (r >> 2) + 4 * hi; }
__device__ __forceinline__ unsigned max16u(unsigned v) {
    v = max(v, dppu<DPP_X1>(v)); v = max(v, dppu<DPP_X2>(v)); v = max(v, dppu<DPP_HMIR>(v)); v = max(v, dppu<DPP_MIR>(v)); return v;
}
#define CSWAP(a_, b_) do { const unsigned hi_ = max(a_, b_), lo_ = min(a_, b_); a_ = hi_; b_ = lo_; } while (0)
__device__ __forceinline__ void topk_phase(Frame& F, int l, int nrows) {
    frame_refresh(F); asm volatile("" : "+s"(l));
    const bf16* PQ = (const bf16*)(F.ws + WS_PQ);
    const bf16* K1 = (const bf16*)(F.ws + WS_K1B) + (size_t)l * 8 * 128 * 128; const bf16* K2 = (const bf16*)(F.ws + WS_K2B) + (size_t)l * 8 * 128 * 128;
    int* IDX = (int*)(F.ws + WS_IDX); float* GW = (float*)(F.ws + WS_GW);
    LAS float* S = (LAS float*)(F.lds + F.wave * 18688);
    LAS unsigned* T1 = (LAS unsigned*)(F.lds + F.wave * 18688 + 16384);
    LAS unsigned* T2 = T1 + 512;
    const int lane = F.lane, r32 = lane & 31, hi = lane >> 5, l16 = lane & 15, qd = lane >> 4;
    int ct[4] = {0xFF, 0xFF, 0xFF, 0xFF};
    { int cnt = 0;
      for (int i = 0; i < 16; ++i) for (int j = 0; j < 16; ++j) if ((i + 1) * (j + 1) <= 16) {
#pragma unroll
          for (int s = 0; s < 4; ++s) if (cnt == l16 * 4 + s) ct[s] = (i << 4) | j;
          ++cnt; } }
    const int nitems = (nrows / 32) * 8;
    for (int it = F.gw; it < nitems; it += F.NGW) {
        const int h = it & 7, tok0 = (it >> 3) * 32;
        for (int half = 0; half < 2; ++half) {
            f32x16 acc[4];
#pragma unroll
            for (int nb = 0; nb < 4; ++nb) acc[nb] = (f32x16){};
            const bf16* qp = PQ + (size_t)(tok0 + r32) * DM + h * 256 + half * 128 + hi * 8;
            const bf16* kp = (half ? K2 : K1) + ((size_t)h * 128 + r32) * 128 + hi * 8;
#pragma unroll
            for (int d0 = 0; d0 < 8; ++d0) { const s16x8 a = *(const GAS s16x8*)(qp + d0 * 16);
#pragma unroll
                for (int nb = 0; nb < 4; ++nb) { const s16x8 bb = *(const GAS s16x8*)(kp + (size_t)nb * 32 * 128 + d0 * 16); acc[nb] = __builtin_amdgcn_mfma_f32_32x32x16_bf16(a, bb, acc[nb], 0, 0, 0); } }
#pragma unroll
            for (int nb = 0; nb < 4; ++nb)
#pragma unroll
                for (int r = 0; r < 16; ++r) S[crow16(r, hi) * 128 + nb * 32 + r32] = acc[nb][r];
            LDS_WAIT();
            for (int ps = 0; ps < 8; ++ps) {
                const int tok = ps * 4 + qd;
                unsigned k[8];
#pragma unroll
                for (int j = 0; j < 8; ++j) k[j] = (f2ord(S[tok * 128 + j * 16 + l16]) & ~127u) | (unsigned)(127 - (j * 16 + l16));
                CSWAP(k[0], k[1]); CSWAP(k[2], k[3]); CSWAP(k[4], k[5]); CSWAP(k[6], k[7]);
                CSWAP(k[0], k[2]); CSWAP(k[1], k[3]); CSWAP(k[4], k[6]); CSWAP(k[5], k[7]);
                CSWAP(k[1], k[2]); CSWAP(k[5], k[6]); CSWAP(k[0], k[4]); CSWAP(k[3], k[7]);
                CSWAP(k[1], k[5]); CSWAP(k[2], k[6]);
                CSWAP(k[1], k[4]); CSWAP(k[3], k[6]);
                CSWAP(k[2], k[4]); CSWAP(k[3], k[5]);
                CSWAP(k[3], k[4]);
                unsigned mine = 0u;
                for (int rnd = 0; rnd < 16; ++rnd) {
                    const unsigned m = max16u(k[0]);
                    if (l16 == rnd) mine = m;
                    const bool pop = (k[0] == m);
#pragma unroll
                    for (int j = 0; j < 7; ++j) k[j] = pop ? k[j + 1] : k[j];
                    k[7] = pop ? 0u : k[7];
                }
                if (half == 0) T1[tok * 16 + l16] = mine;
                else {
                    T2[qd * 16 + l16] = mine;
                    LDS_WAIT();
                    unsigned ck[4];
#pragma unroll
                    for (int s = 0; s < 4; ++s) { const int i = (ct[s] >> 4) & 15, j = ct[s] & 15;
                        const float c = ord2f(T1[tok * 16 + i] & ~127u) + ord2f(T2[qd * 16 + j] & ~127u);
                        ck[s] = (ct[s] == 0xFF) ? 0u : ((f2ord(c) & ~255u) | (unsigned)(255 - ct[s])); }
                    CSWAP(ck[0], ck[1]); CSWAP(ck[2], ck[3]); CSWAP(ck[0], ck[2]); CSWAP(ck[1], ck[3]); CSWAP(ck[1], ck[2]);
                    unsigned win = 0u, m0 = 0u;
                    for (int rnd = 0; rnd < 16; ++rnd) {
                        const unsigned m = max16u(ck[0]);
                        if (rnd == 0) m0 = m;
                        if (l16 == rnd) win = m;
                        const bool pop = (ck[0] == m);
                        ck[0] = pop ? ck[1] : ck[0]; ck[1] = pop ? ck[2] : ck[1]; ck[2] = pop ? ck[3] : ck[2]; ck[3] = pop ? 0u : ck[3];
                    }
                    const float sv = ord2f(win & ~255u), smax = ord2f(m0 & ~255u);
                    const int ij = 255 - (int)(win & 255u), ci = (ij >> 4) & 15, cj = ij & 15;
                    const int e = (127 - (int)(T1[tok * 16 + ci] & 127u)) * 128 + (127 - (int)(T2[qd * 16 + cj] & 127u));
                    const float p = __expf(sv - smax);
                    const float den = sum16(p);
                    { const size_t o = (size_t)(tok0 + tok) * 128 + h * 16 + l16; IDX[o] = e; GW[o] = p / den; }
                    LDS_WAIT();
                }
            }
        }
    }
}
#undef CSWAP

typedef float f32x2_t __attribute__((ext_vector_type(2)));
constexpr int NSL = 16;
constexpr size_t WS_PART = WS_P + 96 * MiB, WS_WT = WS_P + 240 * MiB, WS_SSQ = WS_P + 250 * MiB;
#define PS_IDX2(dst, src, tok_) do { const GAS unsigned* p_ = (const GAS unsigned*)((src) + (size_t)(tok_) * 128 + grp * 16 + c8); dst[0] = p_[0]; dst[1] = p_[8]; } while (0)
#define PS_BC(v, II) __builtin_amdgcn_ds_swizzle((int)(v), ((II) << 5) | 0x18)
#define PS_LD1(buf, II, ev_) { const unsigned e_ = (unsigned)PS_BC(ev_, II); buf[II] = *(const GAS v4u*)(tbl + ((MODE == 2 ? (e_ & 63u) : e_) * 128u + loff)); }
#define PS_LOAD(buf, ev, C_) do { const unsigned ev_ = ev[C_]; PS_LD1(buf, 0, ev_) PS_LD1(buf, 1, ev_) PS_LD1(buf, 2, ev_) PS_LD1(buf, 3, ev_) PS_LD1(buf, 4, ev_) PS_LD1(buf, 5, ev_) PS_LD1(buf, 6, ev_) PS_LD1(buf, 7, ev_) } while (0)
template <int MODE>
__device__ __forceinline__ void peer_up_phase(Frame& F, int l, int nrows) {
    frame_refresh(F); asm volatile("" : "+s"(l));
    const int lane = F.lane, grp = lane >> 3, c8 = lane & 7;
    const int xg = blockIdx.x & 7, wg = (blockIdx.x >> 3) * NWAVES + F.wave, nwg = (F.G >> 3) * NWAVES;
    const unsigned char* tbl = F.ws + WS_PU + (size_t)l * NEXP * DM;
    const unsigned* IDX = (const unsigned*)(F.ws + WS_IDX); const bf16* H = (const bf16*)(F.ws + WS_H); bf16* PART = (bf16*)(F.ws + WS_PART);
    for (int sub = 0; sub < 2; ++sub) {
        const int slice = xg + 8 * sub; const unsigned loff = (unsigned)(slice * (NEXP * 128) + c8 * 16);
        int tok = wg; if (tok >= nrows) continue;
        unsigned e0[2], e1[2], e2[2], h0, h1 = 0u; v4u bufA[8], bufB[8];
        const GAS unsigned* H32 = (const GAS unsigned*)H + slice * 64 + lane;
        PS_IDX2(e0, IDX, tok); h0 = H32[(size_t)tok * (DM / 2)];
        if (tok + nwg < nrows) PS_IDX2(e1, IDX, tok + nwg); else { e1[0] = e0[0]; e1[1] = e0[1]; }
        PS_LOAD(bufA, e0, 0);
        for (; tok < nrows; tok += nwg) {
            const int t1 = tok + nwg, t2 = tok + 2 * nwg;
            if (t2 < nrows) PS_IDX2(e2, IDX, t2);
            if (t1 < nrows) h1 = H32[(size_t)t1 * (DM / 2)];
            PS_LOAD(bufB, e0, 1);
            f32x2_t hf[8];
#pragma unroll
            for (int k = 0; k < 8; ++k) { const unsigned w = (unsigned)__builtin_amdgcn_ds_bpermute((c8 * 8 + k) * 4, (int)h0); hf[k] = (f32x2_t){bflo(w), bfhi(w)}; }
            float keep[2] = {0.f, 0.f};
#define PS_UPCOMP(buf, C_) do { _Pragma("unroll") for (int ii = 0; ii < 8; ++ii) { const v4u uv = buf[ii]; f32x2_t s0 = {0.f, 0.f}, s1 = {0.f, 0.f}; \
                if (MODE == 1) { s0.x = __uint_as_float((uv.x ^ uv.y) & 0x3fffffffu); s1.x = __uint_as_float((uv.z ^ uv.w) & 0x3fffffffu); } else { \
                _Pragma("unroll") for (int q = 0; q < 4; ++q) { const f32x2_t lo = __builtin_amdgcn_cvt_pk_f32_fp8((int)uv[q], false), hi = __builtin_amdgcn_cvt_pk_f32_fp8((int)uv[q], true); \
                    s0 += lo * hf[q * 2]; s1 += hi * hf[q * 2 + 1]; } } \
                s0 += s1; float d = s0.x + s0.y; d += dppf<DPP_X1>(d); d += dppf<DPP_X2>(d); d += dppf<DPP_HMIR>(d); \
                if (c8 == ii) keep[C_] = d; } } while (0)
            PS_UPCOMP(bufA, 0);
            if (t1 < nrows) PS_LOAD(bufA, e1, 0);
            PS_UPCOMP(bufB, 1);
            bf16* pp = PART + ((size_t)slice * MALL + tok) * 128 + grp * 16 + c8;
            pp[0] = (bf16)f2bf(keep[0]); pp[8] = (bf16)f2bf(keep[1]);
            e0[0] = e1[0]; e0[1] = e1[1]; e1[0] = e2[0]; e1[1] = e2[1]; h0 = h1;
        }
    }
}
__device__ __forceinline__ int peer_slot_of_storage(int st) { return (2 * ((st >> 4) & 3) + (st & 1)) * 16 + 2 * ((st >> 1) & 7) + (st >> 6); }
__device__ __forceinline__ void peer_up_mfma(Frame& F, int l, int nrows) {
    frame_refresh(F); asm volatile("" : "+s"(l));
    typedef int v8i_t __attribute__((ext_vector_type(8))); typedef int v4i_t __attribute__((ext_vector_type(4)));
    const int lane = F.lane, i16 = lane & 15, kq = lane >> 4, ch = 2 * kq + (i16 & 1); const bool hsel = (i16 >> 1) & 1;
    const int xg = blockIdx.x & 7, wg = (blockIdx.x >> 3) * NWAVES + F.wave, nwg = (F.G >> 3) * NWAVES;
    const unsigned* IDX = (const unsigned*)(F.ws + WS_IDX); const unsigned char* Hb = F.ws + WS_H; bf16* PART = (bf16*)(F.ws + WS_PART);
    for (int sub = 0; sub < 2; ++sub) {
        const int slice = xg + 8 * sub;
        const unsigned char* tbl = F.ws + WS_PU + (size_t)l * NEXP * DM + (size_t)slice * (NEXP * 128) + ch * 16;
        int tok = wg; if (tok >= nrows) continue;
#define UM_LDE(e_, t_) do { e_ = *(const GAS v2u*)((const GAS unsigned*)IDX + (size_t)(t_) * 128 + 2 * lane); } while (0)
#define UM_LDH(h_, t_) do { h_ = *(const GAS unsigned*)(Hb + (size_t)(t_) * (DM * 2) + slice * 256 + 4 * lane); } while (0)
#define UM_LDA(A_, e_) do { _Pragma("unroll") for (int g = 0; g < 8; ++g) { const int src_ = ((i16 >> 1) * 8 + g) * 4; \
            const unsigned ea_ = (unsigned)__builtin_amdgcn_ds_bpermute(src_, (int)e_.x), eb_ = (unsigned)__builtin_amdgcn_ds_bpermute(src_, (int)e_.y); \
            A_[g].lo = *(const GAS v4i_t*)(tbl + ea_ * 128u); A_[g].hi = *(const GAS v4i_t*)(tbl + eb_ * 128u); } } while (0)
#define UM_COMP(A_, h_, t_, ok_) do { int hq[4]; \
            _Pragma("unroll") for (int q = 0; q < 4; ++q) { const unsigned wa = (unsigned)__builtin_amdgcn_ds_bpermute((ch * 8 + 2 * q) * 4, (int)h_), wb = (unsigned)__builtin_amdgcn_ds_bpermute((ch * 8 + 2 * q + 1) * 4, (int)h_); \
                int x0 = 0; x0 = __builtin_amdgcn_cvt_pk_fp8_f32(bflo(wa), bfhi(wa), x0, false); x0 = __builtin_amdgcn_cvt_pk_fp8_f32(bflo(wb), bfhi(wb), x0, true); hq[q] = x0; } \
            v8i_t hb; _Pragma("unroll") for (int q = 0; q < 4; ++q) { hb[q] = hsel ? 0 : hq[q]; hb[4 + q] = hsel ? hq[q] : 0; } \
            float keep[16]; \
            _Pragma("unroll") for (int g = 0; g < 8; ++g) { v4f d = {0.f, 0.f, 0.f, 0.f}; d = __builtin_amdgcn_mfma_scale_f32_16x16x128_f8f6f4(A_[g], hb, d, 0, 0, 0, 0x7F7F7F7F, 0, 0x7F7F7F7F); \
                keep[2 * g] = d.x + dppf<0xF5>(d.y); keep[2 * g + 1] = d.z + dppf<0xF5>(d.w); }         \
            if ((i16 & 13) == 0 && (ok_)) { GAS v4u* po_ = (GAS v4u*)(PART + ((size_t)slice * MALL + (t_)) * 128 + ((i16 >> 1) * 4 + kq) * 16); \
                v4u o0, o1; o0.x = pg8::cvt_pk_bf16(keep[0], keep[1]); o0.y = pg8::cvt_pk_bf16(keep[2], keep[3]); o0.z = pg8::cvt_pk_bf16(keep[4], keep[5]); o0.w = pg8::cvt_pk_bf16(keep[6], keep[7]); \
                o1.x = pg8::cvt_pk_bf16(keep[8], keep[9]); o1.y = pg8::cvt_pk_bf16(keep[10], keep[11]); o1.z = pg8::cvt_pk_bf16(keep[12], keep[13]); o1.w = pg8::cvt_pk_bf16(keep[14], keep[15]); \
                po_[0] = o0; po_[1] = o1; } } while (0)
        v2u e1, e2; unsigned h0, h1, h2, h3; v8i_t bufA[8], bufB[8]; const int tl = nrows - 1;
        UM_LDE(e2, tok); UM_LDH(h0, tok); UM_LDE(e1, min(tok + nwg, tl)); UM_LDH(h1, min(tok + nwg, tl)); __builtin_amdgcn_sched_barrier(0);
        UM_LDA(bufA, e2);
        for (; tok < nrows; tok += 2 * nwg) {
            const int t1 = tok + nwg, t2 = min(tok + 2 * nwg, tl), t3 = min(tok + 3 * nwg, tl);
            UM_LDE(e2, t2); UM_LDH(h2, t2); __builtin_amdgcn_sched_barrier(0);
            UM_LDA(bufB, e1); __builtin_amdgcn_sched_barrier(0);
            UM_COMP(bufA, h0, tok, true);
            UM_LDE(e1, t3); UM_LDH(h3, t3); __builtin_amdgcn_sched_barrier(0);
            UM_LDA(bufA, e2); __builtin_amdgcn_sched_barrier(0);
            UM_COMP(bufB, h1, min(t1, tl), t1 < nrows);
            h0 = h2; h1 = h3;
        }
#undef UM_LDE
#undef UM_LDH
#undef UM_LDA
#undef UM_COMP
    }
}
__device__ __forceinline__ void peer_combine_phase(Frame& F, int l, int nrows) {
    frame_refresh(F); asm volatile("" : "+s"(l));
    const bf16* PART = (const bf16*)(F.ws + WS_PART); const int* IDX = (const int*)(F.ws + WS_IDX); const float* GW = (const float*)(F.ws + WS_GW); float* WT = (float*)(F.ws + WS_WT);
    const float* SU = (const float*)(F.ws + WS_SU) + (size_t)l * NEXP; const float* SV = (const float*)(F.ws + WS_SV) + (size_t)l * NEXP;
    const int n = nrows * 128, step = F.NGW * 64;
    for (int i = F.gw * 64 + F.lane; i < n; i += 2 * step) {
        const int i2 = i + step; const bool h2 = i2 < n;
        float d = 0.f, dd = 0.f;
#pragma unroll
        for (int s = 0; s < NSL; ++s) { d += __uint_as_float((unsigned)PART[(size_t)s * MALL * 128 + i] << 16); if (h2) dd += __uint_as_float((unsigned)PART[(size_t)s * MALL * 128 + i2] << 16); }
        const int j = (i & ~127) + peer_slot_of_storage(i & 127), j2 = (i2 & ~127) + peer_slot_of_storage(i2 & 127);
        const int e = IDX[j]; const int e2 = h2 ? IDX[j2] : 0;
        const float a = gelu_erf(d * SU[e]) * GW[j] * SV[e];
        WT[j] = a;
        if (h2) WT[j2] = gelu_erf(dd * SU[e2]) * GW[j2] * SV[e2];
    }
}
template <int MODE>
__device__ __forceinline__ void peer_down_phase(Frame& F, int l, int nrows) {
    frame_refresh(F); asm volatile("" : "+s"(l));
    const int lane = F.lane, grp = lane >> 3, c8 = lane & 7;
    const bool b4 = (lane >> 4) & 1, b3 = (lane >> 3) & 1;
    const int xg = blockIdx.x & 7, wg = (blockIdx.x >> 3) * NWAVES + F.wave, nwg = (F.G >> 3) * NWAVES;
    const unsigned char* tbl = F.ws + WS_PV + (size_t)l * NEXP * DM;
    const unsigned* IDX = (const unsigned*)(F.ws + WS_IDX); const unsigned* WT = (const unsigned*)(F.ws + WS_WT); float* SSQ = (float*)(F.ws + WS_SSQ);
    bf16* XS = (bf16*)(F.ws + WS_XS);
    const float* modl = F.mod + (size_t)l * 5 * 12288 + 5 * DM; const float* bl = F.ada_b + (size_t)l * 12288 + 5 * DM;
    for (int sub = 0; sub < 2; ++sub) {
        const int slice = xg + 8 * sub; const unsigned loff = (unsigned)(slice * (NEXP * 128) + c8 * 16);
        int tok = wg; if (tok >= nrows) continue;
        unsigned e0[2], e1[2], e2[2], w0[2], w1[2], w2[2]; v4u bufA[8], bufB[8];
        PS_IDX2(e0, IDX, tok); PS_IDX2(w0, WT, tok);
        if (tok + nwg < nrows) { PS_IDX2(e1, IDX, tok + nwg); PS_IDX2(w1, WT, tok + nwg); } else { e1[0] = e0[0]; e1[1] = e0[1]; w1[0] = w0[0]; w1[1] = w0[1]; }
        PS_LOAD(bufA, e0, 0);
        for (; tok < nrows; tok += nwg) {
            const int t1 = tok + nwg, t2 = tok + 2 * nwg;
            if (t2 < nrows) { PS_IDX2(e2, IDX, t2); PS_IDX2(w2, WT, t2); }
            PS_LOAD(bufB, e0, 1);
            f32x2_t o2[8];
#pragma unroll
            for (int i = 0; i < 8; ++i) o2[i] = (f32x2_t){0.f, 0.f};
#define PS_DN1(buf, II, wv_) { const v4u vv = buf[II]; const float w = __uint_as_float((unsigned)PS_BC(wv_, II)); \
                if (MODE == 1) { o2[0].x += w * __uint_as_float((vv.x ^ vv.y) & 0x3fffffffu); o2[0].y += w * __uint_as_float((vv.z ^ vv.w) & 0x3fffffffu); } else { \
                _Pragma("unroll") for (int q = 0; q < 4; ++q) { const f32x2_t lo = __builtin_amdgcn_cvt_pk_f32_fp8((int)vv[q], false), hi = __builtin_amdgcn_cvt_pk_f32_fp8((int)vv[q], true); \
                    o2[q * 2] += lo * w; o2[q * 2 + 1] += hi * w; } } }
#define PS_DNCOMP(buf, C_) do { const unsigned wv_ = w0[C_]; PS_DN1(buf, 0, wv_) PS_DN1(buf, 1, wv_) PS_DN1(buf, 2, wv_) PS_DN1(buf, 3, wv_) PS_DN1(buf, 4, wv_) PS_DN1(buf, 5, wv_) PS_DN1(buf, 6, wv_) PS_DN1(buf, 7, wv_) } while (0)
            PS_DNCOMP(bufA, 0);
            if (t1 < nrows) PS_LOAD(bufA, e1, 0);
            PS_DNCOMP(bufB, 1);
            float o[16];
#pragma unroll
            for (int i = 0; i < 8; ++i) { o[2 * i] = o2[i].x; o[2 * i + 1] = o2[i].y; }
            float r1[8], r2[4], r3[2];
#pragma unroll
            for (int k = 0; k < 8; ++k) { auto rr = __builtin_amdgcn_permlane32_swap(__float_as_uint(o[k]), __float_as_uint(o[k + 8]), false, false); r1[k] = __uint_as_float(rr[0]) + __uint_as_float(rr[1]); }
#pragma unroll
            for (int k = 0; k < 4; ++k) { const float keep = b4 ? r1[k + 4] : r1[k], send = b4 ? r1[k] : r1[k + 4]; r2[k] = keep + __shfl_xor(send, 16); }
#pragma unroll
            for (int k = 0; k < 2; ++k) { const float keep = b3 ? r2[k + 2] : r2[k], send = b3 ? r2[k] : r2[k + 2]; r3[k] = keep + dppf<DPP_ROR8>(send); }
            const int mr = tok < NLAT ? tok / SEQ : 4; const int col = slice * 128 + c8 * 16 + grp * 2;
            GAS unsigned* xr = (GAS unsigned*)(XS + (size_t)tok * DM + col);
            const unsigned xw = *xr; const f32x2_t xv = {bflo(xw), bfhi(xw)}, gg = *(const f32x2_t*)(modl + mr * 12288 + col) + *(const f32x2_t*)(bl + col);
            const f32x2_t x2f = xv + gg * (f32x2_t){r3[0], r3[1]};
            const unsigned xo = pk2(x2f.x, x2f.y); const f32x2_t x2 = {bflo(xo), bfhi(xo)};
            if (MODE == 0) *xr = xo;
            const float ss = wave_sum(x2.x * x2.x + x2.y * x2.y);
            if (MODE == 0) { if (lane == 0) SSQ[(size_t)slice * MALL + tok] = ss; }
            else if (lane == 0) ((float*)(F.ws + WS_MODP))[(F.gw & 511) * 64] = ss;
            e0[0] = e1[0]; e0[1] = e1[1]; e1[0] = e2[0]; e1[1] = e2[1]; w0[0] = w1[0]; w0[1] = w1[1]; w1[0] = w2[0]; w1[1] = w2[1];
        }
    }
}
#undef PS_IDX2
#undef PS_BC
#undef PS_LD1
#undef PS_DN1
#undef PS_LOAD
#undef PS_UPCOMP
#undef PS_DNCOMP
__device__ __forceinline__ void post_norm_phase(Frame& F, int l, int nrows, bool last) {
    frame_refresh(F); asm volatile("" : "+s"(l));
    bf16* H = (bf16*)(F.ws + WS_H); const float* SSQ = (const float*)(F.ws + WS_SSQ); const bf16* XS = (const bf16*)(F.ws + WS_XS);
    const float* modn = F.mod + (size_t)(l + 1) * 5 * 12288; const float* bn = F.ada_b + (size_t)(l + 1) * 12288;
    const int lane = F.lane;
    const bool bad = last && __hip_atomic_load((unsigned*)(F.ws + WS_CTL) + 24, __ATOMIC_RELAXED, __HIP_MEMORY_SCOPE_AGENT) != 0u;
    const int r0 = (int)(((long)F.gw * nrows) / F.NGW), r1 = (int)(((long)(F.gw + 1) * nrows) / F.NGW);
    if (r0 >= r1) return;
    v4f cur[8], nxt[8], Av[8], Bv[8]; float scur, snxt = 0.f; int have = -1;
    load_row<true>(cur, nullptr, nullptr, XS, r0, lane); scur = (lane < NSL) ? SSQ[(size_t)lane * MALL + r0] : 0.f;
    for (int row = r0; row < r1; ++row) {
        if (row + 1 < r1) { load_row<true>(nxt, nullptr, nullptr, XS, row + 1, lane); snxt = (lane < NSL) ? SSQ[(size_t)lane * MALL + row + 1] : 0.f; }
        const int mr = row < NLAT ? row / SEQ : 4;
        if (mr != have) { have = mr;
#pragma unroll
            for (int j = 0; j < 8; ++j) { const int cidx = row_col<true>(j, lane);
                if (!last) { Av[j] = *(const v4f*)(F.norm1_g + (size_t)(l + 1) * DM + cidx) * (*(const v4f*)(modn + mr * 12288 + DM + cidx) + *(const v4f*)(bn + DM + cidx) + 1.f);
                    Bv[j] = *(const v4f*)(modn + mr * 12288 + cidx) + *(const v4f*)(bn + cidx); }
                else { Av[j] = *(const v4f*)(F.final_g + cidx); Bv[j] = (v4f){0.f, 0.f, 0.f, 0.f}; } } }
        const float rstd = rsqrtf(wave_sum(scur) * (1.f / DM) + EPS);
        v4f yv[8];
#pragma unroll
        for (int j = 0; j < 8; ++j) { const int cidx = row_col<true>(j, lane); yv[j] = (cur[j] * rstd) * Av[j] + Bv[j];
            if (last) *(GAS v4f*)(F.out + (size_t)row * DM + cidx) = bad ? (v4f){0.f, 0.f, 0.f, 0.f} : yv[j]; }
        if (!last) quant_row8<true>(yv, (unsigned char*)H + (size_t)row * DM, (float*)(F.ws + WS_HS) + row, lane);
#pragma unroll
        for (int j = 0; j < 8; ++j) cur[j] = nxt[j];
        scur = snxt;
    }
}
__device__ __forceinline__ bool mfma8_selftest(int lane) {
    typedef int v8i_t __attribute__((ext_vector_type(8)));
    const int idx = lane & 15, kb = lane >> 4;
    v8i_t X, Y;
#pragma unroll
    for (int w = 0; w < 8; ++w) { float xa[4], yb[4];
#pragma unroll
        for (int t = 0; t < 4; ++t) { const int k = 32 * kb + 4 * w + t; xa[t] = (float)(((idx * 3 + k * 5) % 7) - 3); yb[t] = (float)(((k * 2 + idx * 7) % 5) - 2); }
        int xw = 0, yw = 0; xw = __builtin_amdgcn_cvt_pk_fp8_f32(xa[0], xa[1], xw, false); xw = __builtin_amdgcn_cvt_pk_fp8_f32(xa[2], xa[3], xw, true);
        yw = __builtin_amdgcn_cvt_pk_fp8_f32(yb[0], yb[1], yw, false); yw = __builtin_amdgcn_cvt_pk_fp8_f32(yb[2], yb[3], yw, true); X[w] = xw; Y[w] = yw; }
    v4f d = {0.f, 0.f, 0.f, 0.f};
    d = __builtin_amdgcn_mfma_scale_f32_16x16x128_f8f6f4(X, Y, d, 0, 0, 0, 0x7F7F7F7F, 0, 0x7F7F7F7F);
    bool ok = true;
#pragma unroll
    for (int r = 0; r < 4; ++r) { const int i = 4 * kb + r, j = idx; int e = 0;
        for (int k = 0; k < 128; ++k) e += (((i * 3 + k * 5) % 7) - 3) * (((k * 2 + j * 7) % 5) - 2);
        ok = ok && (d[r] == (float)e); }
    return __all(ok);
}
struct Args { const float* in[22]; float* out; unsigned char* ws; int ph_lo, ph_hi, use_bar, pad; };
__global__ void __launch_bounds__(NWAVES * 64, 2) mk_fwd(Args args) {
    extern __shared__ __attribute__((aligned(16))) unsigned char lds[];
    Frame F;
    F.lds = (LAS unsigned char*)lds; F.ldsg = lds;
    F.tid = threadIdx.x; F.lane = F.tid & 63; F.wave = __builtin_amdgcn_readfirstlane(F.tid >> 6);
    F.G = gridDim.x; { const int bx = blockIdx.x; F.vcu = (F.G % 8 == 0) ? (bx % 8) * (F.G / 8) + bx / 8 : bx; }
    F.gw = F.vcu * NWAVES + F.wave; F.NGW = F.G * NWAVES;
    F.x = args.in[0]; F.c = args.in[1]; F.ctx = args.in[2]; F.c_ctx = args.in[3]; F.ada_w = args.in[4]; F.ada_b = args.in[5]; F.norm1_g = args.in[6]; F.norm2_g = args.in[7];
    F.w_in = args.in[8]; F.b_gate = args.in[9]; F.q_norm_g = args.in[10]; F.k_norm_g = args.in[11]; F.conv_w = args.in[12]; F.w_ao = args.in[13]; F.w_co = args.in[14]; F.w_o = args.in[15];
    F.peer_wq = args.in[16]; F.peer_k1 = args.in[17]; F.peer_k2 = args.in[18]; F.peer_u = args.in[19]; F.peer_v = args.in[20]; F.final_g = args.in[21];
    F.out = args.out; F.ws = args.ws; F.mod = (float*)(args.ws + WS_CTL + CTL_MOD);
    volatile LAS unsigned* MISC = (volatile LAS unsigned*)(F.lds + MISC_OFF);
    for (int u = F.tid; u < (LDS_BYTES - MISC_OFF) / 4; u += NWAVES * 64) MISC[u] = 0u;
    __syncthreads();
    XcdBarrier bar; bar.bar = (unsigned*)(args.ws + WS_CTL) + CW_BAR; bar.x = 0; bar.st = nullptr;
    if (args.use_bar) bar = xcd_barrier_post((unsigned*)(args.ws + WS_CTL) + CW_BAR, MISC + 8);
    const int lo = args.ph_lo, hi = args.ph_hi;
#ifndef PHASE_MASK
#define PHASE_MASK 0xFFFFFFFFu
#endif
#define PHK(k) ((k) < 3 ? (k) : 3 + ((k) - 3) % NPH_LAYER)
#define IN(k) (((PHASE_MASK >> PHK(k)) & 1u) && lo <= (k) && (k) < hi)
#define SEAM(k) do { if (IN(k) && IN((k) + 1)) xcd_barrier(bar); } while (0)
    bf16* H = (bf16*)(F.ws + WS_H); bf16* P = (bf16*)(F.ws + WS_P); bf16* A2 = (bf16*)(F.ws + WS_A2); bf16* XS = (bf16*)(F.ws + WS_XS);

#if PROBE_DUP & 0x200
    if (IN(0)) { p0_prologue(F); __syncthreads(); }
#endif
    if (IN(0) && blockIdx.x == 0 && F.wave == 0) { if (!mfma8_selftest(F.lane) && F.lane == 0) __hip_atomic_store((unsigned*)(args.ws + WS_CTL) + 24, 1u, __ATOMIC_RELAXED, __HIP_MEMORY_SCOPE_AGENT); }
    if (IN(0)) { p0_prologue(F); __syncthreads(); } SEAM(0);
    if (IN(1)) { mod_reduce_phase(F); } SEAM(1);
    if (IN(2)) { norm_phase<1, false>(F, F.x, F.ctx, MALL, 0, F.norm1_g, 0, 1); } SEAM(2);
    for (int l = 0; l < 2; ++l) {
        const int base = 3 + NPH_LAYER * l, Ml = (l == 0) ? MALL : NLAT;
        if (IN(base + 0)) {
            pg8::Gemm g{H, (const bf16*)(F.ws + WS_WIN + (size_t)l * INW * DM), Ml, INW, DM / 2}; pg8::OrderX S; S.init(Ml, INW, F.G, (int)blockIdx.x, l == 1 ? 16 : 0);
            pg8::EpiStore8 E{F.ws + WS_P, INW, (const float*)(F.ws + WS_HS), G8_SCALE / W8_SCALE};
            for (int rep = 0; rep < ((PROBE_DUP & 0x1) ? 2 : 1); ++rep) pg8::gemm_phase<pg8::EpiStore8, pg8::OrderX, true, true, true>(F.lds, g, S, E);
        } SEAM(base + 0);
#if PROBE_DUP & 0x2
        if (IN(base + 1)) { split_phase(F, l, Ml, MALL); }
#endif
        if (IN(base + 1)) { split_phase(F, l, Ml, MALL); } SEAM(base + 1);
#if PROBE_DUP & 0x4
        if (IN(base + 2)) { attn_phase(F, l == 0, true); }
#endif
        if (IN(base + 2)) { attn_phase(F, l == 0); } SEAM(base + 2);
        if (IN(base + 3)) {
            pg8::Gemm g{(const bf16*)(F.ws + WS_A2), (const bf16*)(F.ws + WS_W2 + (size_t)l * DM * 4096), Ml, DM, 2048}; pg8::OrderX S; S.init(Ml, DM, F.G, (int)blockIdx.x, 0);
            pg8::EpiGate<true> E{H, DM  , MG8_SCALE, CV8_SCALE / AT8_SCALE, 1.f / (CV8_SCALE * W8_SCALE), (const unsigned char*)P, INW, C_GA, C_GA + 2048, 1.f / G8_SCALE, F.b_gate + (size_t)l * 4096};
            for (int rep = 0; rep < ((PROBE_DUP & 0x8) ? 2 : 1); ++rep) pg8::gemm_phase<pg8::EpiGate<true>, pg8::OrderX, true, true, true>(F.lds, g, S, E);
        } SEAM(base + 3);
        if (IN(base + 4)) {
            pg8::Gemm g{H, (const bf16*)(F.ws + WS_WO + (size_t)l * DM * DM), Ml, DM, DM / 2}; pg8::OrderX S; S.init(Ml, DM, F.G, (int)blockIdx.x, 0);
            if (l == 0) { pg8::EpiResid<false> E{F.x, F.ctx, XS, F.mod + (size_t)l * 5 * 12288 + 2 * DM, F.ada_b + (size_t)l * 12288 + 2 * DM, 1.f / (MG8_SCALE * W8_SCALE)};
                pg8::gemm_phase<pg8::EpiResid<false>, pg8::OrderX, true, true, true>(F.lds, g, S, E); }
            else { pg8::EpiResid<true> E{nullptr, nullptr, XS, F.mod + (size_t)l * 5 * 12288 + 2 * DM, F.ada_b + (size_t)l * 12288 + 2 * DM, 1.f / (MG8_SCALE * W8_SCALE)};
                pg8::gemm_phase<pg8::EpiResid<true>, pg8::OrderX, true, true, true>(F.lds, g, S, E); }
        } SEAM(base + 4);
#if PROBE_DUP & 0x20
        if (IN(base + 5)) { norm_phase<0, true>(F, nullptr, nullptr, Ml, l, F.norm2_g + (size_t)l * DM, 3, 4); }
#endif
        if (IN(base + 5)) { norm_phase<0, true>(F, nullptr, nullptr, Ml, l, F.norm2_g + (size_t)l * DM, 3, 4); } SEAM(base + 5);
        if (IN(base + 6)) {
            pg8::Gemm g{H, (const bf16*)(F.ws + WS_WQ) + (size_t)l * DM * DM, Ml, DM, DM}; pg8::OrderX S; S.init(Ml, DM, F.G, (int)blockIdx.x, 0);
            pg8::EpiStore E{(bf16*)(F.ws + WS_PQ), DM};
            for (int rep = 0; rep < ((PROBE_DUP & 0x40) ? 2 : 1); ++rep) pg8::gemm_phase<pg8::EpiStore, pg8::OrderX, true, true>(F.lds, g, S, E);
        } SEAM(base + 6);
#if PROBE_DUP & 0x80
        if (IN(base + 7)) { topk_phase(F, l, Ml); }
#endif
        if (IN(base + 7)) { topk_phase(F, l, Ml); } SEAM(base + 7);
#if PROBE_DUP & 0x100
        if (IN(base + 8)) { peer_up_phase<PROBE_GMODE>(F, l, Ml); }
#endif
        if (IN(base + 8)) { peer_up_mfma(F, l, Ml); } SEAM(base + 8);
#if PROBE_DUP & 0x400
        if (IN(base + 9)) { peer_combine_phase(F, l, Ml); }
#endif
        if (IN(base + 9)) { peer_combine_phase(F, l, Ml); } SEAM(base + 9);
#if PROBE_DUP & 0x100
        if (IN(base + 10)) { peer_down_phase<PROBE_GMODE ? PROBE_GMODE : 3>(F, l, Ml); }
#endif
        if (IN(base + 10)) { peer_down_phase<0>(F, l, Ml); } SEAM(base + 10);
#if PROBE_DUP & 0x800
        if (IN(base + 11) && l == 0) { post_norm_phase(F, l, Ml, false); }
#endif
        if (IN(base + 11)) { post_norm_phase(F, l, Ml, l == 1); }
        if (l == 0) SEAM(base + 11);
    }
#undef IN
#undef SEAM
}

extern "C" void kernel_launch(void* const* d_in, const int* in_sizes, int n_in, void* d_out, int out_size, void* d_ws, size_t ws_size, hipStream_t stream) {
    static int grid = 0;
    if (grid == 0) {
        if (n_in != 22 || out_size != NLAT * DM || ws_size < WS_END) { fprintf(stderr, "kernel_launch: unexpected shapes: n_in %d out %d ws %zu (need %zu)\n", n_in, out_size, ws_size, (size_t)WS_END); grid = -1; return; }
        int dev = 0, cus = 0, per_cu = 0;
        if (hipGetDevice(&dev) != hipSuccess || hipDeviceGetAttribute(&cus, hipDeviceAttributeMultiprocessorCount, dev) != hipSuccess) { grid = -1; return; }
        if (hipFuncSetAttribute((const void*)mk_fwd, hipFuncAttributeMaxDynamicSharedMemorySize, LDS_BYTES) != hipSuccess) { fprintf(stderr, "kernel_launch: hipFuncSetAttribute failed\n"); grid = -1; return; }
        if (hipOccupancyMaxActiveBlocksPerMultiprocessor(&per_cu, (const void*)mk_fwd, NWAVES * 64, LDS_BYTES) != hipSuccess || per_cu < 1) fprintf(stderr, "kernel_launch: occupancy query reports %d\n", per_cu);
        (void)hipGetLastError();
        grid = cus;
    }
    if (grid < 0) return;
    if (hipMemsetAsync((char*)d_ws + WS_CTL, 0, CTL_ZERO_BYTES, stream) != hipSuccess) return;
    Args a{};
    for (int i = 0; i < 22; ++i) a.in[i] = (const float*)d_in[i];
    a.out = (float*)d_out; a.ws = (unsigned char*)d_ws; a.pad = 0;
#if MK_ONE_LAUNCH
    a.ph_lo = 0; a.ph_hi = NPH; a.use_bar = 1;
    hipLaunchKernelGGL(mk_fwd, dim3(grid), dim3(NWAVES * 64), LDS_BYTES, stream, a);
#else
    for (int p = 0; p < NPH; ++p) { a.ph_lo = p; a.ph_hi = p + 1; a.use_bar = 0;
        hipLaunchKernelGGL(mk_fwd, dim3(grid), dim3(NWAVES * 64), LDS_BYTES, stream, a); }
#endif
    const hipError_t le = hipPeekAtLastError();
    if (le != hipSuccess) fprintf(stderr, "kernel_launch: launch failed: %s\n", hipGetErrorName(le));
}
```

```cpp
#include <hip/hip_runtime.h>
#include <hip/hip_bf16.h>
#include <cstdio>
#include <cstdint>
namespace pg8 {
#define PG8_LAS __attribute__((address_space(3)))
typedef unsigned short bf16_t;
typedef short bf16x8 __attribute__((ext_vector_type(8)));
typedef float f32x4 __attribute__((ext_vector_type(4)));
typedef unsigned u32x4 __attribute__((ext_vector_type(4)));
constexpr int BM = 256, BK = 64, HALF = 128, HTB = HALF * BK * 2  , STAGE_BYTES = 8 * HTB, NXCD = 8, WGM = 4;

__host__ __device__ __forceinline__ int lds_byte(int r, int c) { const int st = (r >> 4) * 2 + (c >> 5), rr = r & 15, cc = c & 31, ob = rr * 64 + cc * 2; return st * 1024 + (ob ^ (((ob >> 9) & 1) << 5)); }
__host__ __device__ __forceinline__ void stage_rc(int b, int& R, int& C) { const int st = b / 1024, sb = b % 1024, swz = sb ^ (((sb >> 9) & 1) << 5); R = (st >> 1) * 16 + swz / 64; C = (st & 1) * 32 + (swz % 64) / 2; }
__host__ __device__ __forceinline__ int perm32(int rho) { const int n = rho >> 4, i = rho & 15; return 8 * (i >> 2) + 4 * n + (i & 3); }

struct Unit { int pm, pn; };
struct Gemm { const bf16_t* A; const bf16_t* Bt; int M, N, K; };

struct StaticOrder {
    int nM, nN, nwg, G, c;
    __host__ __device__ void init(int M, int N, int G_, int c_) { nM = M / BM; nN = N / BM; nwg = nM * nN; G = G_; c = c_; }
    __host__ __device__ bool next(int i, Unit& u) const {
        const long L = (long)i * G + c; if (L >= nwg) return false;
        int wgid = (int)L; { const int q = nwg / NXCD, r = nwg % NXCD, xcd = wgid % NXCD, off = wgid / NXCD; wgid = (xcd < r ? xcd * (q + 1) : r * (q + 1) + (xcd - r) * q) + off; }
        const int nig = WGM * nN, gid = wgid / nig, fm = gid * WGM, gsz = (nM - fm) < WGM ? (nM - fm) : WGM;
        u.pm = fm + ((wgid % nig) % gsz); u.pn = (wgid % nig) / gsz; return true;
    }
    __device__ __forceinline__ void a_ready(const Unit&) const {}
    __device__ __forceinline__ void done(const Unit&) const {}
};

__device__ __forceinline__ unsigned cvt_pk_bf16(float lo, float hi) { unsigned r; asm volatile("v_cvt_pk_bf16_f32 %0, %1, %2" : "=v"(r) : "v"(lo), "v"(hi)); return r; }
typedef float f32x2 __attribute__((ext_vector_type(2)));
__device__ __forceinline__ f32x2 gelu_pk(f32x2 v) {
    const f32x2 av = __builtin_elementwise_abs(v), d = av * 0.2316418882f + 1.0f;
    f32x2 t; t.x = __builtin_amdgcn_rcpf(d.x); t.y = __builtin_amdgcn_rcpf(d.y);
    f32x2 q = t * 0.5307027145f + (-0.7265760135f); q = q * t + 0.7107068705f; q = q * t + (-0.142248368f); q = q * t + 0.127414796f; q = q * t;
    const f32x2 s = (v * v) * (-0.72134752044f);
    f32x2 e; e.x = __builtin_amdgcn_exp2f(s.x); e.y = __builtin_amdgcn_exp2f(s.y);
    const f32x2 m = v * (q * e), r = v - m;
    f32x2 o; o.x = v.x < 0.f ? m.x : r.x; o.y = v.y < 0.f ? m.y : r.y; return o;
}


__device__ __forceinline__ float bf_lo(unsigned w) { return __uint_as_float(w << 16); }
__device__ __forceinline__ float bf_hi(unsigned w) { return __uint_as_float(w & 0xffff0000u); }
struct EpiStore {
    static constexpr bool PERM = true, AFTER_DRAIN = false, HAS_MID = false;
    bf16_t* O; int ldc;
    __device__ __forceinline__ void mid(f32x4 (&)[2][2][4][2], const Unit&, int, int, int, int) const {}
    __device__ __forceinline__ void operator()(const f32x4 (&acc)[2][2][4][2], const Unit& u, int wr, int wc, int fr, int fq) const {
        const int row0 = u.pm * BM + wr * 64 + fr, col0 = u.pn * BM + wc * 32 + 8 * fq;
#pragma unroll
        for (int ai = 0; ai < 2; ++ai)
#pragma unroll
            for (int m = 0; m < 4; ++m) { bf16_t* rowp = O + (size_t)(row0 + ai * HALF + m * 16) * ldc + col0;
#pragma unroll
                for (int bj = 0; bj < 2; ++bj) { const f32x4 v0 = acc[ai][bj][m][0], v1 = acc[ai][bj][m][1];
                    u32x4 w; w.x = cvt_pk_bf16(v0[0], v0[1]); w.y = cvt_pk_bf16(v0[2], v0[3]); w.z = cvt_pk_bf16(v1[0], v1[1]); w.w = cvt_pk_bf16(v1[2], v1[3]);
                    *(u32x4*)(rowp + bj * HALF) = w; } }
    }
};
struct EpiStore8 {
    static constexpr bool PERM = true, AFTER_DRAIN = false, HAS_MID = false;
    unsigned char* O; int ldc; const float* rs; float cs;
    __device__ __forceinline__ void mid(f32x4 (&)[2][2][4][2], const Unit&, int, int, int, int) const {}
    __device__ __forceinline__ void operator()(const f32x4 (&acc)[2][2][4][2], const Unit& u, int wr, int wc, int fr, int fq) const {
        int fr_ = fr, fq_ = fq; asm volatile("" : "+v"(fr_), "+v"(fq_));
        const int row0 = u.pm * BM + wr * 64 + fr_, col0 = u.pn * BM + wc * 32 + 8 * fq_;
        typedef unsigned u32x2 __attribute__((ext_vector_type(2)));
        float scv[8];
#pragma unroll
        for (int q = 0; q < 8; ++q) scv[q] = rs[row0 + (q >> 2) * HALF + (q & 3) * 16];
        __builtin_amdgcn_sched_group_barrier(0x020, 8, 0);
#pragma unroll
        for (int q = 0; q < 8; ++q) scv[q] *= cs;
#pragma unroll
        for (int ai = 0; ai < 2; ++ai)
#pragma unroll
            for (int m = 0; m < 4; ++m) { const int row = row0 + ai * HALF + m * 16; unsigned char* rowp = O + (size_t)row * ldc + col0; const float sc = scv[ai * 4 + m];
#pragma unroll
                for (int bj = 0; bj < 2; ++bj) { const f32x4 v0 = acc[ai][bj][m][0] * sc, v1 = acc[ai][bj][m][1] * sc;
                    float c8[8] = {v0[0], v0[1], v0[2], v0[3], v1[0], v1[1], v1[2], v1[3]};
#pragma unroll
                    for (int e = 0; e < 8; ++e) c8[e] = fminf(fmaxf(c8[e], -448.f), 448.f);
                    int w0 = 0, w1 = 0; w0 = __builtin_amdgcn_cvt_pk_fp8_f32(c8[0], c8[1], w0, false); w0 = __builtin_amdgcn_cvt_pk_fp8_f32(c8[2], c8[3], w0, true);
                    w1 = __builtin_amdgcn_cvt_pk_fp8_f32(c8[4], c8[5], w1, false); w1 = __builtin_amdgcn_cvt_pk_fp8_f32(c8[6], c8[7], w1, true);
                    u32x2 w; w.x = (unsigned)w0; w.y = (unsigned)w1;
                    *(u32x2*)(rowp + bj * HALF) = w; } }
    }
};
template <bool OUT8>
struct EpiGate {
    static constexpr bool PERM = true, AFTER_DRAIN = false, HAS_MID = true;
    bf16_t* O; int ldc; float oscale; float midf, endf; const unsigned char* G; int ldg; int ga_off, gc_off; float ginv; const float* bgate;
    __device__ __forceinline__ void mid(f32x4 (&acc)[2][2][4][2], const Unit& u, int wr, int wc, int fr, int fq) const {
        int rowv = u.pm * BM + wr * 64 + fr; asm volatile("" : "+v"(rowv));
        const int col0 = u.pn * BM + wc * 32 + 8 * fq;
        const unsigned char* pbase = G + (size_t)rowv * ldg + col0;
        typedef unsigned u32x2 __attribute__((ext_vector_type(2))); typedef float f32x2 __attribute__((ext_vector_type(2)));
#pragma unroll
        for (int bj = 0; bj < 2; ++bj) {
            const f32x4 ba0 = *(const f32x4*)(bgate + col0 + bj * HALF), ba1 = *(const f32x4*)(bgate + col0 + bj * HALF + 4), bc0 = *(const f32x4*)(bgate + 2048 + col0 + bj * HALF), bc1 = *(const f32x4*)(bgate + 2048 + col0 + bj * HALF + 4);
#pragma unroll
            for (int ai = 0; ai < 2; ++ai) { u32x2 gav[4], gcv[4];
                const unsigned char* pq = pbase + (size_t)(ai * HALF) * ldg + bj * HALF; asm volatile("" : "+v"(pq) :: "memory");
#pragma unroll
                for (int m = 0; m < 4; ++m) { const unsigned char* pr = pq + (size_t)(m * 16) * ldg; gav[m] = *(const u32x2*)(pr + ga_off); gcv[m] = *(const u32x2*)(pr + gc_off); }
#pragma unroll
                for (int m = 0; m < 4; ++m) { const u32x2 ga = gav[m], gc = gcv[m];
                    const f32x2 a0 = __builtin_amdgcn_cvt_pk_f32_fp8((int)ga.x, false), a1 = __builtin_amdgcn_cvt_pk_f32_fp8((int)ga.x, true), a2 = __builtin_amdgcn_cvt_pk_f32_fp8((int)ga.y, false), a3 = __builtin_amdgcn_cvt_pk_f32_fp8((int)ga.y, true);
                    const f32x2 c0 = __builtin_amdgcn_cvt_pk_f32_fp8((int)gc.x, false), c1 = __builtin_amdgcn_cvt_pk_f32_fp8((int)gc.x, true), c2 = __builtin_amdgcn_cvt_pk_f32_fp8((int)gc.y, false), c3 = __builtin_amdgcn_cvt_pk_f32_fp8((int)gc.y, true);
                    float a[8] = {a0.x * ginv, a0.y * ginv, a1.x * ginv, a1.y * ginv, a2.x * ginv, a2.y * ginv, a3.x * ginv, a3.y * ginv};
                    float c[8] = {c0.x * ginv, c0.y * ginv, c1.x * ginv, c1.y * ginv, c2.x * ginv, c2.y * ginv, c3.x * ginv, c3.y * ginv};
#pragma unroll
                    for (int e = 0; e < 8; ++e) { const float av = a[e] + (e < 4 ? ba0[e & 3] : ba1[e & 3]), cv = c[e] + (e < 4 ? bc0[e & 3] : bc1[e & 3]);
                        const float ratio = midf * (1.f + __expf(-cv)) * __builtin_amdgcn_rcpf(1.f + __expf(-av));
                        acc[ai][bj][m][e >> 2][e & 3] *= ratio; } } } }
    }
    __device__ __forceinline__ void operator()(const f32x4 (&acc)[2][2][4][2], const Unit& u, int wr, int wc, int fr, int fq) const {
        int rowv = u.pm * BM + wr * 64 + fr; asm volatile("" : "+v"(rowv));
        const int col0 = u.pn * BM + wc * 32 + 8 * fq;
        const unsigned char* pbase = G + (size_t)rowv * ldg + col0 + gc_off; typedef unsigned u32x2g __attribute__((ext_vector_type(2))); typedef float f32x2 __attribute__((ext_vector_type(2))); bf16_t* obase = OUT8 ? (bf16_t*)((unsigned char*)O + (size_t)rowv * ldc + col0) : O + (size_t)rowv * ldc + col0;
        u32x2g gall[2][2][4];
#pragma unroll
        for (int bj = 0; bj < 2; ++bj)
#pragma unroll
            for (int ai = 0; ai < 2; ++ai) { const unsigned char* pq = pbase + (size_t)(ai * HALF) * ldg + bj * HALF;
#pragma unroll
                for (int m = 0; m < 4; ++m) gall[bj][ai][m] = *(const u32x2g*)(pq + (size_t)(m * 16) * ldg); }
        f32x4 bcv[2][2];
#pragma unroll
        for (int bj = 0; bj < 2; ++bj) { bcv[bj][0] = *(const f32x4*)(bgate + 2048 + col0 + bj * HALF); bcv[bj][1] = *(const f32x4*)(bgate + 2048 + col0 + bj * HALF + 4); }
#pragma unroll
        for (int bj = 0; bj < 2; ++bj) {
            const f32x4 bc0 = bcv[bj][0], bc1 = bcv[bj][1];
#pragma unroll
            for (int ai = 0; ai < 2; ++ai) {
                unsigned char* oq = (unsigned char*)obase + ((size_t)(ai * HALF) * ldc + bj * HALF) * (OUT8 ? 1 : 2);
                asm volatile("" : "+v"(oq) :: "memory");
#pragma unroll
                for (int m = 0; m < 4; ++m) { const u32x2g gc = gall[bj][ai][m]; unsigned char* orow = oq + (size_t)(m * 16) * ldc * (OUT8 ? 1 : 2);
                    const f32x2 c0 = __builtin_amdgcn_cvt_pk_f32_fp8((int)gc.x, false), c1 = __builtin_amdgcn_cvt_pk_f32_fp8((int)gc.x, true), c2 = __builtin_amdgcn_cvt_pk_f32_fp8((int)gc.y, false), c3 = __builtin_amdgcn_cvt_pk_f32_fp8((int)gc.y, true);
                    float c[8] = {c0.x * ginv, c0.y * ginv, c1.x * ginv, c1.y * ginv, c2.x * ginv, c2.y * ginv, c3.x * ginv, c3.y * ginv};
                    float o[8];
#pragma unroll
                    for (int e = 0; e < 8; ++e) { const float cv = c[e] + (e < 4 ? bc0[e & 3] : bc1[e & 3]); o[e] = acc[ai][bj][m][e >> 2][e & 3] * endf * __builtin_amdgcn_rcpf(1.f + __expf(-cv)); }
                    if constexpr (OUT8) { float c8[8];
#pragma unroll
                        for (int e = 0; e < 8; ++e) c8[e] = fminf(fmaxf(o[e] * oscale, -448.f), 448.f);
                        int w0 = 0, w1 = 0; w0 = __builtin_amdgcn_cvt_pk_fp8_f32(c8[0], c8[1], w0, false); w0 = __builtin_amdgcn_cvt_pk_fp8_f32(c8[2], c8[3], w0, true);
                        w1 = __builtin_amdgcn_cvt_pk_fp8_f32(c8[4], c8[5], w1, false); w1 = __builtin_amdgcn_cvt_pk_fp8_f32(c8[6], c8[7], w1, true);
                        typedef unsigned u32x2 __attribute__((ext_vector_type(2))); u32x2 w; w.x = (unsigned)w0; w.y = (unsigned)w1; *(u32x2*)orow = w;
                    } else { u32x4 w; w.x = cvt_pk_bf16(o[0], o[1]); w.y = cvt_pk_bf16(o[2], o[3]); w.z = cvt_pk_bf16(o[4], o[5]); w.w = cvt_pk_bf16(o[6], o[7]);
                    *(u32x4*)orow = w; } } } }
    }
};
template <bool IN16>
struct EpiResid {
    static constexpr bool PERM = false, AFTER_DRAIN = false, HAS_MID = false;
    const float* xin_lat; const float* xin_ctx; bf16_t* xs; const float* mod; const float* bias; float ascale;
    __device__ __forceinline__ void mid(f32x4 (&)[2][2][4][2], const Unit&, int, int, int, int) const {}
    __device__ __forceinline__ void operator()(const f32x4 (&acc)[2][2][4][2], const Unit& u, int wr, int wc, int fr, int fq) const {
        int fr_ = fr, fq_ = fq; asm volatile("" : "+v"(fr_), "+v"(fq_));
        const int modrow = u.pm < 64 ? (u.pm >> 4) : 4; const bool lat = u.pm < 64;
        const float* xi = lat ? xin_lat + (size_t)(u.pm * BM) * 2048 : xin_ctx + (size_t)((u.pm - 64) * BM) * 2048;
        bf16_t* xo = xs + (size_t)(u.pm * BM) * 2048;
        const float* md = mod + modrow * 12288;
        const int col0 = u.pn * BM + wc * 32 + 4 * fq_;
        typedef unsigned u32x2 __attribute__((ext_vector_type(2)));
#pragma unroll
        for (int bj = 0; bj < 2; ++bj)
#pragma unroll
            for (int n = 0; n < 2; ++n) { const int col = col0 + bj * HALF + n * 16; const f32x4 g = (*(const f32x4*)(md + col) + *(const f32x4*)(bias + col)) * ascale;
                constexpr int NB = IN16 ? 8 : 4;
#pragma unroll
                for (int q0 = 0; q0 < 8; q0 += NB) {
                    u32x2 xw[NB]; f32x4 xf[NB];
#pragma unroll
                    for (int q = 0; q < NB; ++q) { const int qq = q0 + q; const size_t off = (size_t)((qq >> 2) * HALF + wr * 64 + (qq & 3) * 16 + fr_) * 2048 + col;
                        if constexpr (IN16) xw[q] = *(const u32x2*)(xo + off); else xf[q] = *(const f32x4*)(xi + off); }
#pragma unroll
                    for (int q = 0; q < NB; ++q) { const int qq = q0 + q, ai = qq >> 2, m = qq & 3; const size_t off = (size_t)(ai * HALF + wr * 64 + m * 16 + fr_) * 2048 + col;
                        f32x4 xv; if constexpr (IN16) xv = (f32x4){bf_lo(xw[q].x), bf_hi(xw[q].x), bf_lo(xw[q].y), bf_hi(xw[q].y)}; else xv = xf[q];
                        const f32x4 o = xv + g * acc[ai][bj][m][n];
                        u32x2 w; w.x = cvt_pk_bf16(o[0], o[1]); w.y = cvt_pk_bf16(o[2], o[3]); *(u32x2*)(xo + off) = w; } } }
    }
};
struct OrderX {
    StaticOrder b; int nextra;
    __device__ __forceinline__ void init(int M, int N, int G, int c, int nextra_) { b.init(M, N, G, c); nextra = nextra_; }
    __device__ __forceinline__ bool next(int i, Unit& u) const {
        const long L = (long)i * b.G + b.c; if (L < b.nwg) return b.next(i, u);
        const int e = (int)(L - b.nwg); if (e >= nextra) return false; u.pm = 64 + (e >> 2); u.pn = 8 + (e & 3); return true; }
    __device__ __forceinline__ void a_ready(const Unit&) const {}
    __device__ __forceinline__ void done(const Unit&) const {}
};
typedef int pg8_v4i __attribute__((ext_vector_type(4))); typedef int pg8_v8i __attribute__((ext_vector_type(8)));
__device__ __forceinline__ pg8_v8i pg8_cat(bf16x8 lo, bf16x8 hi) { return __builtin_shufflevector(__builtin_bit_cast(pg8_v4i, lo), __builtin_bit_cast(pg8_v4i, hi), 0, 1, 2, 3, 4, 5, 6, 7); }
template <class Epi, class Sched, bool ALIGN_EPI = false, bool SP2 = false, bool FP8 = false>
__device__ __forceinline__ void gemm_phase(PG8_LAS unsigned char* lds, const Gemm g, const Sched& S, const Epi& E) {
    int tid = threadIdx.x; asm volatile("" : "+v"(tid));
    const int wid = __builtin_amdgcn_readfirstlane(tid >> 6), lane = tid & 63, wr = wid >> 2, wc = wid & 3, fr = lane & 15, fq = lane >> 4;
    const int K = g.K, nt = K / BK;
    unsigned voffA[2], voffB[2];
#pragma unroll
    for (int i = 0; i < 2; ++i) { int R, C; stage_rc(tid * 16 + i * 8192, R, C); const int Rb = Epi::PERM ? ((R & ~31) + perm32(R & 31)) : R;
        voffA[i] = (unsigned)(R * K + C) * 2u; voffB[i] = (unsigned)(Rb * K + C) * 2u; }
    const size_t kstep = (size_t)(BK * 2);
    const size_t hstep = (size_t)HALF * K * 2;
    const size_t tstep = 2 * hstep;
    const unsigned ldsw = (unsigned)wid * 1024u;
    const int aoff = lds_byte(wr * 64 + fr, fq * 8), boff = lds_byte(wc * 32 + fr, fq * 8);
    constexpr int KSTEP = 1024;
    int sc8 = 0x7F7F7F7F; asm volatile("" : "+v"(sc8));
    unsigned abase8 = (unsigned)(size_t)lds + (unsigned)aoff, bbase8 = (unsigned)(size_t)lds + (unsigned)boff + 4u * HTB; asm volatile("" : "+v"(abase8), "+v"(bbase8));
#define PG8_SA(b, h) (((b) * 2 + (h)) * HTB)
#define PG8_SB(b, h) ((4 + (b) * 2 + (h)) * HTB)
#define PG8_STAGE(bufoff, gbase, voff) do { _Pragma("unroll") for (int _i = 0; _i < 2; ++_i) \
        __builtin_amdgcn_global_load_lds((const unsigned*)((const char*)(gbase) + (voff)[_i]), (PG8_LAS unsigned*)(lds + (bufoff) + ldsw + _i * 8192), 16, 0, 0); } while (0)
#define PG8_LDA(dst, b, h) do { _Pragma("unroll") for (int m = 0; m < 4; ++m) _Pragma("unroll") for (int k = 0; k < 2; ++k) { if constexpr (FP8) { if (k == 0) dst##8[m].lo = *(const PG8_LAS pg8_v4i*)(size_t)(abase8 + (PG8_SA(b, h) + m * 2048)); else dst##8[m].hi = *(const PG8_LAS pg8_v4i*)(size_t)(abase8 + (PG8_SA(b, h) + m * 2048 + 1024)); } else dst[m][k] = *(const PG8_LAS bf16x8*)(lds + PG8_SA(b, h) + aoff + m * 2048 + k * KSTEP); } } while (0)
#define PG8_LDB(dst, b, h) do { _Pragma("unroll") for (int n = 0; n < 2; ++n) _Pragma("unroll") for (int k = 0; k < 2; ++k) { if constexpr (FP8) { if (k == 0) dst##8[n].lo = *(const PG8_LAS pg8_v4i*)(size_t)(bbase8 + (PG8_SB(b, h) - 4 * HTB + n * 2048)); else dst##8[n].hi = *(const PG8_LAS pg8_v4i*)(size_t)(bbase8 + (PG8_SB(b, h) - 4 * HTB + n * 2048 + 1024)); } else dst[n][k] = *(const PG8_LAS bf16x8*)(lds + PG8_SB(b, h) + boff + n * 2048 + k * KSTEP); } } while (0)
#define PG8_MMA(ai, bj, At, Bt) do { __builtin_amdgcn_s_setprio(1); if constexpr (FP8) { _Pragma("unroll") for (int m = 0; m < 4; ++m) _Pragma("unroll") for (int n = 0; n < 2; ++n) \
        asm volatile("v_mfma_scale_f32_16x16x128_f8f6f4 %0, %1, %2, %0, %3, %3 op_sel_hi:[0,0,0]" : "+v"(acc[ai][bj][m][n]) : "v"(Bt##8[n]), "v"(At##8[m]), "v"(sc8)); } else { \
        _Pragma("unroll") for (int m = 0; m < 4; ++m) _Pragma("unroll") for (int n = 0; n < 2; ++n) _Pragma("unroll") for (int k = 0; k < 2; ++k) \
        acc[ai][bj][m][n] = __builtin_amdgcn_mfma_f32_16x16x32_bf16(Bt[n][k], At[m][k], acc[ai][bj][m][n], 0, 0, 0); } __builtin_amdgcn_s_setprio(0); } while (0)
#define PG8_WAIT_V(n) asm volatile("s_waitcnt vmcnt(" #n ")" ::: "memory")
#define PG8_WAIT_L(n) asm volatile("s_waitcnt lgkmcnt(" #n ")" ::: "memory")
#define PG8_BAR __builtin_amdgcn_s_barrier()
#define PG8_SCHED __builtin_amdgcn_sched_barrier(0)
    Unit cur, nxt; int ui = 0;
    if (!S.next(0, cur)) return;
    f32x4 acc[2][2][4][2];
#pragma unroll
    for (int a = 0; a < 2; ++a)
#pragma unroll
        for (int b = 0; b < 2; ++b)
#pragma unroll
            for (int m = 0; m < 4; ++m)
#pragma unroll
                for (int n = 0; n < 2; ++n) acc[a][b][m][n] = (f32x4){0.f, 0.f, 0.f, 0.f};
    bf16x8 At[4][2], B0[2][2], B1[2][2]; pg8_v8i At8[4], B08[2], B18[2];
    const char* cA = (const char*)g.A + (size_t)cur.pm * tstep; const char* cB = (const char*)g.Bt + (size_t)cur.pn * tstep;
    S.a_ready(cur);
    if constexpr (SP2) {
        PG8_STAGE(PG8_SB(0, 0), cB, voffB); PG8_STAGE(PG8_SB(0, 1), cB + hstep, voffB); PG8_STAGE(PG8_SA(0, 0), cA, voffA); PG8_STAGE(PG8_SA(0, 1), cA + hstep, voffA);
        if (wr == 1) PG8_BAR;
        PG8_WAIT_V(2); PG8_BAR;
        PG8_STAGE(PG8_SB(1, 0), cB + kstep, voffB); PG8_STAGE(PG8_SA(1, 0), cA + kstep, voffA); PG8_STAGE(PG8_SB(1, 1), cB + hstep + kstep, voffB);
        PG8_WAIT_V(6); PG8_BAR;
    } else {
        PG8_STAGE(PG8_SB(0, 0), cB, voffB); PG8_STAGE(PG8_SA(0, 0), cA, voffA); PG8_STAGE(PG8_SB(0, 1), cB + hstep, voffB); PG8_STAGE(PG8_SA(0, 1), cA + hstep, voffA);
        if (wr == 1) PG8_BAR;
        PG8_WAIT_V(4); PG8_BAR;
        PG8_STAGE(PG8_SB(1, 0), cB + kstep, voffB); PG8_STAGE(PG8_SA(1, 0), cA + kstep, voffA); PG8_STAGE(PG8_SB(1, 1), cB + hstep + kstep, voffB);
        PG8_WAIT_V(6); PG8_BAR;
    }
    for (;;) {
        const bool has_next = S.next(ui + 1, nxt);
        const char* nA = has_next ? (const char*)g.A + (size_t)nxt.pm * tstep : cA; const char* nB = has_next ? (const char*)g.Bt + (size_t)nxt.pn * tstep : cB;
        constexpr int NPART = Epi::HAS_MID ? 2 : 1; const int tpp = nt / NPART;
        for (int part = 0; part < NPART; ++part) {
        if constexpr (Epi::HAS_MID) { if (part == 1) { if constexpr (FP8) asm volatile("s_nop 15\n\ts_nop 15\n\ts_nop 15\n\ts_nop 15" ::: "memory"); E.mid(acc, cur, wr, wc, fr, fq); } }
        for (int t = part * tpp; t < (part + 1) * tpp; t += 2) {
            const bool last = (t == nt - 2);
            const char* a1 = cA + (size_t)(t + 1) * kstep;
            const char* a2 = last ? nA : cA + (size_t)(t + 2) * kstep; const char* b2 = last ? nB : cB + (size_t)(t + 2) * kstep;
            const char* a3 = a2 + kstep; const char* b3 = b2 + kstep;
            if (last && has_next) S.a_ready(nxt);
            if constexpr (SP2) {
            PG8_LDB(B0, 0, 0); PG8_LDB(B1, 0, 1); PG8_SCHED; PG8_LDA(At, 0, 0); PG8_STAGE(PG8_SA(1, 1), a1 + hstep, voffA);
            PG8_WAIT_V(8); PG8_WAIT_L(0); PG8_BAR; PG8_MMA(0, 0, At, B0); PG8_MMA(0, 1, At, B1); PG8_BAR; PG8_SCHED;
            PG8_LDA(At, 0, 1); PG8_STAGE(PG8_SB(0, 0), b2, voffB); PG8_STAGE(PG8_SB(0, 1), b2 + hstep, voffB); PG8_STAGE(PG8_SA(0, 0), a2, voffA);
            PG8_WAIT_V(8); PG8_WAIT_L(0); PG8_BAR; PG8_MMA(1, 0, At, B0); PG8_MMA(1, 1, At, B1); PG8_BAR; PG8_SCHED;
            PG8_LDB(B0, 1, 0); PG8_LDB(B1, 1, 1); PG8_SCHED; PG8_LDA(At, 1, 0); PG8_STAGE(PG8_SA(0, 1), a2 + hstep, voffA);
            PG8_WAIT_V(8); PG8_WAIT_L(0); PG8_BAR; PG8_MMA(0, 0, At, B0); PG8_MMA(0, 1, At, B1); PG8_BAR; PG8_SCHED;
            PG8_LDA(At, 1, 1); PG8_STAGE(PG8_SB(1, 0), b3, voffB); PG8_STAGE(PG8_SB(1, 1), b3 + hstep, voffB); PG8_STAGE(PG8_SA(1, 0), a3, voffA);
            PG8_WAIT_V(8); PG8_WAIT_L(0); PG8_BAR; PG8_MMA(1, 0, At, B0); PG8_MMA(1, 1, At, B1); PG8_BAR; PG8_SCHED;
            } else {
            PG8_LDB(B0, 0, 0); PG8_SCHED; PG8_LDA(At, 0, 0); PG8_STAGE(PG8_SA(1, 1), a1 + hstep, voffA);
            PG8_WAIT_L(8); PG8_BAR; PG8_WAIT_L(0); PG8_MMA(0, 0, At, B0); PG8_BAR; PG8_SCHED;
            PG8_LDB(B1, 0, 1); PG8_STAGE(PG8_SB(0, 0), b2, voffB);
            PG8_BAR; PG8_WAIT_L(0); PG8_MMA(0, 1, At, B1); PG8_BAR;
            PG8_LDA(At, 0, 1); PG8_STAGE(PG8_SA(0, 0), a2, voffA);
            PG8_BAR; PG8_WAIT_L(0); PG8_MMA(1, 0, At, B0); PG8_BAR; PG8_SCHED;
            PG8_STAGE(PG8_SB(0, 1), b2 + hstep, voffB);
            PG8_WAIT_V(6); PG8_BAR; PG8_MMA(1, 1, At, B1); PG8_BAR;
            PG8_LDB(B0, 1, 0); PG8_SCHED; PG8_LDA(At, 1, 0); PG8_STAGE(PG8_SA(0, 1), a2 + hstep, voffA);
            PG8_WAIT_L(8); PG8_BAR; PG8_WAIT_L(0); PG8_MMA(0, 0, At, B0); PG8_BAR; PG8_SCHED;
            PG8_LDB(B1, 1, 1); PG8_STAGE(PG8_SB(1, 0), b3, voffB);
            PG8_BAR; PG8_WAIT_L(0); PG8_MMA(0, 1, At, B1); PG8_BAR;
            PG8_LDA(At, 1, 1); PG8_STAGE(PG8_SA(1, 0), a3, voffA);
            PG8_BAR; PG8_WAIT_L(0); PG8_MMA(1, 0, At, B0); PG8_BAR; PG8_SCHED;
            PG8_STAGE(PG8_SB(1, 1), b3 + hstep, voffB);
            PG8_WAIT_V(6); PG8_BAR; PG8_MMA(1, 1, At, B1); PG8_BAR;
            }
        }
        }
        if constexpr (FP8) asm volatile("s_nop 15\n\ts_nop 15\n\ts_nop 15\n\ts_nop 15" ::: "memory");
        if constexpr (ALIGN_EPI) { if (wr == 0) PG8_BAR; }
        if constexpr (!Epi::AFTER_DRAIN) { E(acc, cur, wr, wc, fr, fq); S.done(cur); }
        if (!has_next) break;
#pragma unroll
        for (int a = 0; a < 2; ++a)
#pragma unroll
            for (int b = 0; b < 2; ++b)
#pragma unroll
                for (int m = 0; m < 4; ++m)
#pragma unroll
                    for (int n = 0; n < 2; ++n) acc[a][b][m][n] = (f32x4){0.f, 0.f, 0.f, 0.f};
        cur = nxt; cA = nA; cB = nB; ++ui;
        if constexpr (ALIGN_EPI) { if (wr == 1) PG8_BAR; }
    }
    PG8_WAIT_V(0);
    if constexpr (!ALIGN_EPI) { if (wr == 0) PG8_BAR; }
    PG8_BAR;
    if constexpr (Epi::AFTER_DRAIN) { E.fused(acc, cur, wr, wc, fr, fq, lds, wid, lane); S.done(cur); }
#undef PG8_SA
#undef PG8_SB
#undef PG8_STAGE
#undef PG8_LDA
#undef PG8_LDB
#undef PG8_MMA
#undef PG8_WAIT_V
#undef PG8_WAIT_L
#undef PG8_BAR
#undef PG8_SCHED
}
}
namespace att {
using bf16 = __hip_bfloat16;
constexpr int   D = 128, NW = 8, QBLK = 32, KVBLK = 64;
constexpr float QK8 = 0.35709534f;
constexpr float THR2 = 4.3f;
constexpr float V8 = 32.f;
constexpr int VTS = 4 * 8192;
constexpr int SDEPTH = 2;
constexpr int LDQ = 2048, LDK = 512;
constexpr size_t SHM_V = KVBLK * D, SHM_K = KVBLK * D, NBUF = 6, SHM_ATTN = NBUF * SHM_V + NBUF * SHM_K + NW * 64 * 4;
typedef int v4i_t __attribute__((ext_vector_type(4))); typedef int v8i_t __attribute__((ext_vector_type(8)));
using bf16x8 = __attribute__((ext_vector_type(8))) short;
using s16x4  = __attribute__((ext_vector_type(4))) short;
using f32x16 = __attribute__((ext_vector_type(16))) float;
using f32x8  = __attribute__((ext_vector_type(8))) float;
using u32x4  = __attribute__((ext_vector_type(4))) unsigned;
#define KSWZ(row, colB) ((row) * 256 + ((colB) ^ (((row) & 7) << 4)))
#define SBAR() __builtin_amdgcn_sched_barrier(0)
__device__ __forceinline__ int crow(int r, int hi) { return (r & 3) + 8 * (r >> 2) + 4 * hi; }
__device__ __forceinline__ unsigned cvtpk(float lo, float hi) {
  unsigned r; asm volatile("v_cvt_pk_bf16_f32 %0, %1, %2" : "=v"(r) : "v"(lo), "v"(hi)); return r;
}
template <typename TIn> struct Stage;
template <> struct Stage<bf16>  { using T = bf16x8;
  __device__ static __forceinline__ T ld8(const bf16* p) { return *reinterpret_cast<const bf16x8*>(p); }
  __device__ static __forceinline__ bf16x8 tobf(T x) { return x; } };
template <> struct Stage<float> { using T = f32x8;
  __device__ static __forceinline__ T ld8(const float* p) { return *reinterpret_cast<const f32x8*>(p); }
  __device__ static __forceinline__ bf16x8 tobf(T x) {
    u32x4 w = {cvtpk(x[0], x[1]), cvtpk(x[2], x[3]), cvtpk(x[4], x[5]), cvtpk(x[6], x[7])}; return *reinterpret_cast<bf16x8*>(&w); } };

__device__ __forceinline__ void partialSM(f32x16& p0, f32x16& p1, f32x16& negm, float& alpha, bool first) {
  float pmax = p0[0]; for (int r = 1; r < 16; ++r) pmax = fmaxf(pmax, p0[r]); for (int r = 0; r < 16; ++r) pmax = fmaxf(pmax, p1[r]);
  { auto rr = __builtin_amdgcn_permlane32_swap(__float_as_uint(pmax), __float_as_uint(pmax), false, false);
    pmax = fmaxf(__uint_as_float(rr[0]), __uint_as_float(rr[1])); }
  if (__builtin_expect(!first && __all(pmax <= THR2 + 4.f), 1)) alpha = 1.f;
  else { const float delta = first ? pmax - 4.f : fmaxf(pmax - 4.f, 0.f);
    alpha = __builtin_amdgcn_exp2f(-delta);
    for (int r = 0; r < 16; ++r) { p0[r] -= delta; p1[r] -= delta; negm[r] -= delta; } }
  for (int r = 0; r < 16; ++r) p0[r] = __builtin_amdgcn_exp2f(p0[r]);
}
__device__ __forceinline__ void finishSM(f32x16& p0, f32x16& p1, float alpha, float& l_reg, v8i_t& pa) {
  for (int r = 0; r < 16; ++r) p1[r] = __builtin_amdgcn_exp2f(p1[r]);
  float ps = 0; for (int r = 0; r < 16; ++r) ps += p0[r]; for (int r = 0; r < 16; ++r) ps += p1[r];
  { auto rr = __builtin_amdgcn_permlane32_swap(__float_as_uint(ps), __float_as_uint(ps), false, false);
    ps = __uint_as_float(rr[0]) + __uint_as_float(rr[1]); }
  l_reg = l_reg * alpha + ps;
#pragma unroll
  for (int i = 0; i < 4; ++i) { int w = 0; w = __builtin_amdgcn_cvt_pk_fp8_f32(p0[4 * i], p0[4 * i + 1], w, false); w = __builtin_amdgcn_cvt_pk_fp8_f32(p0[4 * i + 2], p0[4 * i + 3], w, true); pa[i] = w;
    int x = 0; x = __builtin_amdgcn_cvt_pk_fp8_f32(p1[4 * i], p1[4 * i + 1], x, false); x = __builtin_amdgcn_cvt_pk_fp8_f32(p1[4 * i + 2], p1[4 * i + 3], x, true); pa[4 + i] = x; }
}
__device__ __forceinline__ void qkt(f32x16& p0, f32x16& p1, const char* Ks, const v8i_t* qr, const f32x16& negm, int r32, int hi) {
  const int sw = r32 & 7;
  const char* k0 = Ks + r32 * 128; const char* k1 = Ks + (32 + r32) * 128;
  { v8i_t a0, a1;
    a0.lo = *reinterpret_cast<const v4i_t*>(k0 + (((2 * hi) ^ sw) << 4)); a0.hi = *reinterpret_cast<const v4i_t*>(k0 + (((2 * hi + 1) ^ sw) << 4));
    a1.lo = *reinterpret_cast<const v4i_t*>(k1 + (((2 * hi) ^ sw) << 4)); a1.hi = *reinterpret_cast<const v4i_t*>(k1 + (((2 * hi + 1) ^ sw) << 4));
    p0 = __builtin_amdgcn_mfma_scale_f32_32x32x64_f8f6f4(a0, qr[0], negm, 0, 0, 0, 0x7F7F7F7F, 0, 0x7F7F7F7F);
    p1 = __builtin_amdgcn_mfma_scale_f32_32x32x64_f8f6f4(a1, qr[0], negm, 0, 0, 0, 0x7F7F7F7F, 0, 0x7F7F7F7F); }
  SBAR();
  { v8i_t b0, b1;
    b0.lo = *reinterpret_cast<const v4i_t*>(k0 + (((4 + 2 * hi) ^ sw) << 4)); b0.hi = *reinterpret_cast<const v4i_t*>(k0 + (((5 + 2 * hi) ^ sw) << 4));
    b1.lo = *reinterpret_cast<const v4i_t*>(k1 + (((4 + 2 * hi) ^ sw) << 4)); b1.hi = *reinterpret_cast<const v4i_t*>(k1 + (((5 + 2 * hi) ^ sw) << 4));
    p0 = __builtin_amdgcn_mfma_scale_f32_32x32x64_f8f6f4(b0, qr[1], p0, 0, 0, 0, 0x7F7F7F7F, 0, 0x7F7F7F7F);
    p1 = __builtin_amdgcn_mfma_scale_f32_32x32x64_f8f6f4(b1, qr[1], p1, 0, 0, 0, 0x7F7F7F7F, 0, 0x7F7F7F7F); }
}
__device__ __forceinline__ void pv_d0(f32x16* o, const char* Vs, const v8i_t& pa, int r32, int hi) {
  const int sw = (r32 >> 2) & 3;
#pragma unroll
  for (int db = 0; db < 4; ++db) { const char* row = Vs + (db * 32 + r32) * 64; v8i_t b;
    b.lo = *reinterpret_cast<const v4i_t*>(row + (((2 * hi) ^ sw) << 4)); b.hi = *reinterpret_cast<const v4i_t*>(row + (((2 * hi + 1) ^ sw) << 4));
    o[db] = __builtin_amdgcn_mfma_scale_f32_32x32x64_f8f6f4(pa, b, o[db], 0, 0, 0, 0x7F7F7F7F, 0, 0x7F7F7F7F); }
}

__device__ __forceinline__ int undef_i() { int w; asm volatile("" : "=v"(w)); return w; }
#define ATT_MFMA(a_, b_, c_) __builtin_amdgcn_mfma_scale_f32_32x32x64_f8f6f4(a_, b_, c_, 0, 0, 0, 0x7F7F7F7F, 0, 0x7F7F7F7F)
#ifndef ATT_PLIM
#define ATT_PLIM 448.f
#endif
template <bool HASN>
__device__ __forceinline__ void att_redo(f32x16& pO0, f32x16& pO1, f32x16& pN0, f32x16& pN1, f32x16* o, f32x16& negm, float& l_reg, float& ps_lane, float* al_l, int r32, int hi) {
  float pmax = pO0[0];
#pragma unroll
  for (int r = 1; r < 16; ++r) pmax = fmaxf(pmax, pO0[r]);
#pragma unroll
  for (int r = 0; r < 16; ++r) pmax = fmaxf(pmax, pO1[r]);
  { auto rr = __builtin_amdgcn_permlane32_swap(__float_as_uint(pmax), __float_as_uint(pmax), false, false); pmax = fmaxf(__uint_as_float(rr[0]), __uint_as_float(rr[1])); }
  const float delta = fmaxf(__builtin_amdgcn_logf(pmax) - 4.f, 0.f), alpha = __builtin_amdgcn_exp2f(-delta);
#pragma unroll
  for (int r = 0; r < 16; ++r) { pO0[r] *= alpha; pO1[r] *= alpha; negm[r] -= delta; }
  if constexpr (HASN) {
#pragma unroll
    for (int r = 0; r < 16; ++r) { pN0[r] -= delta; pN1[r] -= delta; } }
  ps_lane *= alpha; l_reg *= alpha;
  if (hi == 0) al_l[r32] = alpha; asm volatile("s_waitcnt lgkmcnt(0)" ::: "memory");
#pragma unroll
  for (int d = 0; d < 4; ++d)
#pragma unroll
    for (int r = 0; r < 16; ++r) o[d][r] *= al_l[crow(r, hi)];
}
__device__ __forceinline__ void att_pack(const f32x16& p0, const f32x16& p1, v8i_t& pa) {
#pragma unroll
  for (int i = 0; i < 4; ++i) { int w = undef_i(); w = __builtin_amdgcn_cvt_pk_fp8_f32(p0[4 * i], p0[4 * i + 1], w, false); w = __builtin_amdgcn_cvt_pk_fp8_f32(p0[4 * i + 2], p0[4 * i + 3], w, true); pa[i] = w;
    int x = undef_i(); x = __builtin_amdgcn_cvt_pk_fp8_f32(p1[4 * i], p1[4 * i + 1], x, false); x = __builtin_amdgcn_cvt_pk_fp8_f32(p1[4 * i + 2], p1[4 * i + 3], x, true); pa[4 + i] = x; }
}
__device__ __forceinline__ void att_step(f32x16& pN0, f32x16& pN1, f32x16& pO0, f32x16& pO1, f32x16* o, const v8i_t* qr, f32x16& negm, float& l_reg,
                                         const char* Ks, const char* KsO, const char* Vs, float* al_l, int r32, int hi) {
  v8i_t a0, a1, b0, b1, pa;
  { const int sw = r32 & 7; const char* k0 = Ks + r32 * 128; const char* k1 = Ks + (32 + r32) * 128;
    a0.lo = *reinterpret_cast<const v4i_t*>(k0 + (((2 * hi) ^ sw) << 4)); a0.hi = *reinterpret_cast<const v4i_t*>(k0 + (((2 * hi + 1) ^ sw) << 4));
    a1.lo = *reinterpret_cast<const v4i_t*>(k1 + (((2 * hi) ^ sw) << 4)); a1.hi = *reinterpret_cast<const v4i_t*>(k1 + (((2 * hi + 1) ^ sw) << 4));
    b0.lo = *reinterpret_cast<const v4i_t*>(k0 + (((4 + 2 * hi) ^ sw) << 4)); b0.hi = *reinterpret_cast<const v4i_t*>(k0 + (((5 + 2 * hi) ^ sw) << 4));
    b1.lo = *reinterpret_cast<const v4i_t*>(k1 + (((4 + 2 * hi) ^ sw) << 4)); b1.hi = *reinterpret_cast<const v4i_t*>(k1 + (((5 + 2 * hi) ^ sw) << 4)); }
  SBAR();
#pragma unroll
  for (int r = 0; r < 16; ++r) pO1[r] = __builtin_amdgcn_exp2f(pO1[r]);
  SBAR();
  pN0 = ATT_MFMA(a0, qr[0], negm); SBAR();
  typedef float f2_t __attribute__((ext_vector_type(2)));
#define PR2(v_, k_) __builtin_shufflevector(v_, v_, 2 * (k_), 2 * (k_) + 1)
  f2_t sa = PR2(pO0, 0), sb = PR2(pO0, 1);
  sa += PR2(pO0, 2); sb += PR2(pO0, 3); sa += PR2(pO0, 4); sb += PR2(pO0, 5); sa += PR2(pO0, 6); sb += PR2(pO0, 7);
  SBAR();
  pN1 = ATT_MFMA(a1, qr[0], negm); SBAR();
  sa += PR2(pO1, 0); sb += PR2(pO1, 1); sa += PR2(pO1, 2); sb += PR2(pO1, 3); sa += PR2(pO1, 4); sb += PR2(pO1, 5);
  SBAR();
  pN0 = ATT_MFMA(b0, qr[1], pN0); SBAR();
  sa += PR2(pO1, 6); sb += PR2(pO1, 7); sa += sb;
  float ps_lane = sa.x + sa.y;
  if (__builtin_expect(__any(!(ps_lane <= ATT_PLIM)), 0)) att_redo<true>(pO0, pO1, pN0, pN1, o, negm, l_reg, ps_lane, al_l, r32, hi);
  { auto rr = __builtin_amdgcn_permlane32_swap(__float_as_uint(ps_lane), __float_as_uint(ps_lane), false, false);
    l_reg += __uint_as_float(rr[0]) + __uint_as_float(rr[1]); }
#pragma unroll
  for (int i = 0; i < 4; ++i) { int w = undef_i(); w = __builtin_amdgcn_cvt_pk_fp8_f32(pO0[4 * i], pO0[4 * i + 1], w, false); w = __builtin_amdgcn_cvt_pk_fp8_f32(pO0[4 * i + 2], pO0[4 * i + 3], w, true); pa[i] = w; }
  SBAR();
  pN1 = ATT_MFMA(b1, qr[1], pN1); SBAR();
#pragma unroll
  for (int i = 0; i < 4; ++i) { int x = undef_i(); x = __builtin_amdgcn_cvt_pk_fp8_f32(pO1[4 * i], pO1[4 * i + 1], x, false); x = __builtin_amdgcn_cvt_pk_fp8_f32(pO1[4 * i + 2], pO1[4 * i + 3], x, true); pa[4 + i] = x; }
  asm volatile("" : "+v"(pa));
  v8i_t vb[4];
  { const int sw = (r32 >> 2) & 3;
#pragma unroll
    for (int db = 0; db < 4; ++db) { const char* row = Vs + (db * 32 + r32) * 64;
      vb[db].lo = *reinterpret_cast<const v4i_t*>(row + (((2 * hi) ^ sw) << 4)); vb[db].hi = *reinterpret_cast<const v4i_t*>(row + (((2 * hi + 1) ^ sw) << 4)); } }
  SBAR();
#pragma unroll
  for (int db = 0; db < 4; ++db) {
    o[db] = ATT_MFMA(pa, vb[db], o[db]); SBAR();
#pragma unroll
    for (int r = 0; r < 4; ++r) pN0[4 * db + r] = __builtin_amdgcn_exp2f(pN0[4 * db + r]);
    asm volatile("" : "+v"(pN0));
    SBAR(); }
}
__device__ __forceinline__ void att_last(f32x16& pO0, f32x16& pO1, f32x16* o, const v8i_t* qr, f32x16& negm, float& l_reg, const char* KsO, const char* Vs, float* al_l, int r32, int hi) {
  float ps_lane = 0.f; v8i_t pa;
#pragma unroll
  for (int r = 0; r < 16; ++r) { pO1[r] = __builtin_amdgcn_exp2f(pO1[r]); ps_lane += pO0[r] + pO1[r]; }
  if (__builtin_expect(__any(!(ps_lane <= ATT_PLIM)), 0)) att_redo<false>(pO0, pO1, pO0, pO1, o, negm, l_reg, ps_lane, al_l, r32, hi);
  { auto rr = __builtin_amdgcn_permlane32_swap(__float_as_uint(ps_lane), __float_as_uint(ps_lane), false, false);
    l_reg += __uint_as_float(rr[0]) + __uint_as_float(rr[1]); }
  att_pack(pO0, pO1, pa); SBAR();
  pv_d0(o, Vs, pa, r32, hi);
}

__device__ __forceinline__ void attn_dense_body(const unsigned char* __restrict__ Qb, const unsigned char* __restrict__ Kh, const unsigned char* __restrict__ Vh, unsigned char* Ob, int ldo, float oscale, int seq, char* lds) {
  int tid = threadIdx.x; asm volatile("" : "+v"(tid));
  const int wid = tid >> 6, lane = tid & 63, r32 = lane & 31, hi = lane >> 5;
  char* V_lds = lds; char* K_lds = lds + NBUF * SHM_V;
  float* ws = (float*)(lds + NBUF * SHM_V + NBUF * SHM_K) + wid * 64; float* li_l = ws; float* al_l = ws + 32;
  float l_reg = 0; f32x16 o[4] = {}; v8i_t qr[2]; f32x16 negm;
#pragma unroll
  for (int r = 0; r < 16; ++r) negm[r] = 4.f;
  const unsigned char* Qw = Qb + (long)(wid * QBLK + r32) * LDQ + hi * 32;
#pragma unroll
  for (int sq = 0; sq < 2; ++sq) { qr[sq].lo = *reinterpret_cast<const v4i_t*>(Qw + sq * 64); qr[sq].hi = *reinterpret_cast<const v4i_t*>(Qw + sq * 64 + 16); }
  const int kkey = tid >> 3, ksrc = (long)kkey * LDK + (((tid & 7) ^ (kkey & 7)) << 4);
  typedef __attribute__((address_space(3))) unsigned lds_u32;
  const unsigned ldsK = (unsigned)(uintptr_t)K_lds + (unsigned)wid * 1024u, ldsV = (unsigned)(uintptr_t)V_lds + (unsigned)wid * 1024u;
#define DMA_TILE(t_, slot_) do { \
    __builtin_amdgcn_global_load_lds((const unsigned*)(Kh + (long)(t_) * KVBLK * LDK + ksrc), (lds_u32*)(uintptr_t)(unsigned)__builtin_amdgcn_readfirstlane((int)(ldsK + (unsigned)(slot_))), 16, 0, 0); \
    __builtin_amdgcn_global_load_lds((const unsigned*)(Vh + (long)(t_) * VTS + tid * 16), (lds_u32*)(uintptr_t)(unsigned)__builtin_amdgcn_readfirstlane((int)(ldsV + (unsigned)(slot_))), 16, 0, 0); } while (0)
#define RESC(a) do { if (__any((a) < 1.f)) { if (hi == 0) al_l[r32] = (a); asm volatile("s_waitcnt lgkmcnt(0)" ::: "memory"); \
    for (int d = 0; d < 4; ++d) for (int r = 0; r < 16; ++r) o[d][r] *= al_l[crow(r, hi)]; } } while (0)
  f32x16 pA0, pA1, pB0, pB1; float alA, alB; v8i_t pa; const int NT = seq / KVBLK;
  int c6 = 1;
#define SL6(d_) ((unsigned)((c6 + (d_) >= 6 ? c6 + (d_) - 6 : c6 + (d_)) << 13))
  DMA_TILE(0, 0); DMA_TILE(1, SHM_K); DMA_TILE(2, 2 * SHM_K); asm volatile("s_waitcnt vmcnt(0)" ::: "memory"); __syncthreads();
  qkt(pA0, pA1, K_lds, qr, negm, r32, hi); partialSM(pA0, pA1, negm, alA, true);
  for (int j = 1; j + 1 < NT; j += 2) {
    DMA_TILE(j + 2, SL6(2)); if (j + 3 < NT) DMA_TILE(j + 3, SL6(3));
    att_step(pB0, pB1, pA0, pA1, o, qr, negm, l_reg, K_lds + SL6(0), K_lds + SL6(5), V_lds + SL6(5), al_l, r32, hi);
    att_step(pA0, pA1, pB0, pB1, o, qr, negm, l_reg, K_lds + SL6(1), K_lds + SL6(0), V_lds + SL6(0), al_l, r32, hi);
    asm volatile("s_waitcnt vmcnt(0)" ::: "memory"); __syncthreads();
    c6 = c6 + 2 >= 6 ? c6 + 2 - 6 : c6 + 2;
  }
  att_step(pB0, pB1, pA0, pA1, o, qr, negm, l_reg, K_lds + SL6(0), K_lds + SL6(5), V_lds + SL6(5), al_l, r32, hi);
  att_last(pB0, pB1, o, qr, negm, l_reg, K_lds + SL6(0), V_lds + SL6(0), al_l, r32, hi);
#undef SL6
  if (hi == 0) li_l[r32] = l_reg; asm volatile("s_waitcnt lgkmcnt(0)" ::: "memory");
  float rli[16];
#pragma unroll
  for (int r = 0; r < 16; ++r) rli[r] = __builtin_amdgcn_rcpf(li_l[crow(r, hi)]) * (1.f / V8);
  __syncthreads();
  { unsigned char* stg = (unsigned char*)(lds + wid * 4096);
#pragma unroll
    for (int r = 0; r < 16; ++r) { const int orow = crow(r, hi);
#pragma unroll
      for (int d0 = 0; d0 < 4; ++d0) { const float v = fminf(fmaxf(o[d0][r] * rli[r] * oscale, -448.f), 448.f); stg[orow * 128 + d0 * 32 + r32] = (unsigned char)__builtin_amdgcn_cvt_pk_fp8_f32(v, v, 0, false); } }
    asm volatile("s_waitcnt lgkmcnt(0)" ::: "memory");
    int rb = (lane >> 3) * 128 + (lane & 7) * 16; asm volatile("" : "+v"(rb));
    const unsigned char* rp = stg + rb;
    unsigned char* op = (unsigned char*)Ob + (long)(wid * QBLK + (rb >> 7)) * ldo + ((rb >> 4) & 7) * 16;
#pragma unroll
    for (int i = 0; i < 4; ++i) { const u32x4 v = *(const u32x4*)(rp + i * 1024); *(u32x4*)op = v; op += 8 * ldo; } }
  __syncthreads();
#undef DMA_TILE
#undef RESC
}
#undef KSWZ
#undef SBAR
}
constexpr int NWAVES = 8;
constexpr int DM = 2048, BATCH = 4, SEQ = 4096, CTXL = 256, NLAT = BATCH * SEQ, NCTX = BATCH * CTXL, MALL = NLAT + NCTX;
constexpr int INW = 13312, KVW = 512, SKV = SEQ + CTXL;
constexpr int C_Q = 0, C_K = 2048, C_V = 2560, C_U = 3072, C_GB = 5120, C_GC = 7168, C_GA = 9216, C_GV = 11264;
constexpr int NEXP = 16384;
constexpr float EPS = 1e-6f;
#ifndef PROBE_GMODE
#define PROBE_GMODE 0
#endif
#ifndef PROBE_DUP
#define PROBE_DUP 0
#endif
#ifndef MK_ONE_LAUNCH
#define MK_ONE_LAUNCH 1
#endif
constexpr int NPH_LAYER = 12, NPH = 3 + 2 * NPH_LAYER;

constexpr size_t MiB = 1u << 20;
constexpr size_t WS_CTL = 0, CTL_ZERO_BYTES = 1 * MiB;
constexpr size_t CTL_MOD = 65536;
constexpr size_t WS_K1B = 1 * MiB, WS_K2B = WS_K1B + 524288;
constexpr size_t WS_WIN = 2 * MiB  , WS_W2 = 106 * MiB, WS_WO = 138 * MiB, WS_WQ = 154 * MiB;
constexpr size_t WS_PU = 170 * MiB, WS_PV = 234 * MiB;
constexpr size_t WS_Q = 300 * MiB;
constexpr float G8_SCALE = 16.f;
constexpr float AT8_SCALE = 32.f, CV8_SCALE = 8.f;
constexpr size_t WS_HS = 299 * MiB;
constexpr float W8_SCALE = 1024.f, MG8_SCALE = 64.f;
constexpr float W8_SCALE_UNUSED = 0.f;
constexpr size_t WS_SU = 298 * MiB, WS_SV = WS_SU + 131072;
constexpr size_t WS_XS = 336 * MiB;
constexpr size_t WS_H = 434 * MiB;
constexpr size_t WS_KB = 502 * MiB, WS_VB = 519 * MiB;
constexpr size_t WS_A2 = 536 * MiB;
constexpr size_t WS_P = 672 * MiB;
constexpr size_t WS_PQ = WS_P, WS_IDX = WS_P + 68 * MiB, WS_GW = WS_P + 80 * MiB;
constexpr size_t WS_MODP = 1114 * MiB;
constexpr size_t WS_END = 1122 * MiB;
constexpr int CW_BAR = 4096;

constexpr int PHASE_LDS = 149504, MISC_OFF = PHASE_LDS, LDS_BYTES = PHASE_LDS + 1024;

#define GAS __attribute__((address_space(1)))
#define LAS __attribute__((address_space(3)))
typedef unsigned short bf16;
typedef unsigned v4u __attribute__((ext_vector_type(4)));
typedef unsigned v2u __attribute__((ext_vector_type(2)));
typedef float v4f __attribute__((ext_vector_type(4)));
typedef __bf16 bf16x2_t __attribute__((ext_vector_type(2)));
#define LDS_WAIT() asm volatile("s_waitcnt lgkmcnt(0)" ::: "memory")
#define VM_WAIT() asm volatile("s_waitcnt vmcnt(0)" ::: "memory")
__device__ __forceinline__ unsigned f2bf(float f) { unsigned u = __builtin_bit_cast(unsigned, f); return (u + 0x7fffu + ((u >> 16) & 1u)) >> 16; }
__device__ __forceinline__ unsigned pk2(float lo, float hi) { return f2bf(lo) | (f2bf(hi) << 16); }
__device__ __forceinline__ float bflo(unsigned w) { return __uint_as_float(w << 16); }
__device__ __forceinline__ float bfhi(unsigned w) { return __uint_as_float(w & 0xffff0000u); }
__device__ __forceinline__ float dot2bf(unsigned a, unsigned b, float c) { return __builtin_amdgcn_fdot2_f32_bf16(__builtin_bit_cast(bf16x2_t, a), __builtin_bit_cast(bf16x2_t, b), c, false); }
template <int CTRL> __device__ __forceinline__ float dppf(float v) { return __builtin_bit_cast(float, __builtin_amdgcn_update_dpp(0, __builtin_bit_cast(int, v), CTRL, 0xF, 0xF, true)); }
template <int CTRL> __device__ __forceinline__ unsigned dppu(unsigned v) { return (unsigned)__builtin_amdgcn_update_dpp(0, (int)v, CTRL, 0xF, 0xF, true); }
constexpr int DPP_X1 = 0xB1, DPP_X2 = 0x4E, DPP_HMIR = 0x141, DPP_MIR = 0x140, DPP_ROR8 = 0x128;
__device__ __forceinline__ float wave_sum(float v) {
#pragma unroll
    for (int o = 1; o < 64; o <<= 1) v += __shfl_xor(v, o);
    return v;
}
__device__ __forceinline__ float sum16(float v) {
    v += dppf<DPP_X1>(v); v += dppf<DPP_X2>(v); v += dppf<DPP_HMIR>(v); v += dppf<DPP_MIR>(v); return v;
}
__device__ __forceinline__ float wave_sum_dpp(float v) {
    v = sum16(v);
    { auto rr = __builtin_amdgcn_permlane16_swap(__float_as_uint(v), __float_as_uint(v), false, false); v = __uint_as_float(rr[0]) + __uint_as_float(rr[1]); }
    { auto rr = __builtin_amdgcn_permlane32_swap(__float_as_uint(v), __float_as_uint(v), false, false); v = __uint_as_float(rr[0]) + __uint_as_float(rr[1]); }
    return v;
}
__device__ __forceinline__ unsigned max32u(unsigned v) {
    v = max(v, dppu<DPP_X1>(v)); v = max(v, dppu<DPP_X2>(v)); v = max(v, dppu<DPP_HMIR>(v)); v = max(v, dppu<DPP_MIR>(v));
    v = max(v, (unsigned)__shfl_xor((int)v, 16)); return v;
}
__device__ __forceinline__ float gelu_erf(float v) {
    const float av = fabsf(v), t = __builtin_amdgcn_rcpf(av * 0.2316418882f + 1.0f);
    float q = t * 0.5307027145f + (-0.7265760135f); q = q * t + 0.7107068705f; q = q * t + (-0.142248368f); q = q * t + 0.127414796f; q = q * t;
    const float e = __builtin_amdgcn_exp2f((v * v) * (-0.72134752044f));
    const float m = v * (q * e); return v < 0.f ? m : v - m;
}
#define XB_TMO      128
#define XB_XCNT(j)  (256  + 64 * (j))
#define XB_XSUB(j)  (1280 + 64 * (j))
#define XB_XGEN(j)  (2304 + 64 * (j))
#define XB_TOP      3328
#define XB_TOPGEN   3392
#define XCD_BAR_WORDS 3456
#define XB_SPIN_CAP (1u << 18)

__device__ __forceinline__ unsigned xb_ld(unsigned* p)              { return __hip_atomic_load(p, __ATOMIC_RELAXED, __HIP_MEMORY_SCOPE_AGENT); }
__device__ __forceinline__ unsigned xb_add(unsigned* p, unsigned v) { return __hip_atomic_fetch_add(p, v, __ATOMIC_RELAXED, __HIP_MEMORY_SCOPE_AGENT); }
__device__ __forceinline__ unsigned xb_xcc_id() { return (unsigned)__builtin_amdgcn_s_getreg((3 << 11) | 20) & 0xFu; }
#define XB_SPIN(cond, bar) do { unsigned _sp = 0; while (cond) { __builtin_amdgcn_s_sleep(1); \
    if ((++_sp & 255u) == 0u) { if (xb_ld(&(bar)[XB_TMO])) break; if (_sp > XB_SPIN_CAP) { atomicAdd(&(bar)[XB_TMO], 1u); break; } } } } while (0)

struct XcdBarrier {
    unsigned* bar; unsigned x;
    volatile LAS unsigned* st;
};

__device__ __forceinline__ XcdBarrier xcd_barrier_post(unsigned* bar, volatile LAS unsigned* st) {
    XcdBarrier b; b.bar = bar; b.x = xb_xcc_id(); b.st = st;
    if (threadIdx.x == 0) (void)xb_add(&bar[XB_XCNT(b.x)], 1u);
    return b;
}
__device__ __forceinline__ void xcd_barrier_complete(unsigned* bar, unsigned x, unsigned& nloc, unsigned& nx) {
    const unsigned G = gridDim.x * gridDim.y * gridDim.z;
    unsigned sum, cnt, mine, sp = 0u;
    for (;;) {
        sum = 0u; cnt = 0u; mine = 0u;
#pragma unroll
        for (unsigned j = 0; j < 16; ++j) { const unsigned c = xb_ld(&bar[XB_XCNT(j)]); sum += c; cnt += (c > 0u) ? 1u : 0u; mine = (j == x) ? c : mine; }
        if (sum == G) break;
        __builtin_amdgcn_s_sleep(1);
        if ((++sp & 255u) == 0u) { if (xb_ld(&bar[XB_TMO])) break; if (sp > XB_SPIN_CAP) { atomicAdd(&bar[XB_TMO], 1u); break; } }
    }
    nloc = mine > 0u ? mine : 1u; nx = cnt > 0u ? cnt : 1u;
}

__device__ __forceinline__ void xcd_barrier(const XcdBarrier& b) {
    asm volatile("s_waitcnt vmcnt(0)" ::: "memory");
    __syncthreads();
    if (threadIdx.x == 0) {
        unsigned* bar = b.bar;
        __builtin_amdgcn_s_waitcnt(0);
        unsigned nloc = b.st[0], nx = b.st[1];
        if (nloc == 0u) { xcd_barrier_complete(bar, b.x, nloc, nx); b.st[0] = nloc; b.st[1] = nx; }
        const unsigned old = xb_add(&bar[XB_XSUB(b.x)], 1u);
        const unsigned gen = old / nloc;
        if (old + 1u == (gen + 1u) * nloc) {
            __builtin_amdgcn_fence(__ATOMIC_RELEASE, "agent");
            asm volatile("s_waitcnt vmcnt(0)" ::: "memory");
            const unsigned og = xb_add(&bar[XB_TOP], 1u);
            const unsigned tg = og / nx;
            if (og + 1u == (tg + 1u) * nx) xb_add(&bar[XB_TOPGEN], 1u);
            else XB_SPIN(xb_ld(&bar[XB_TOPGEN]) == tg, bar);
            __builtin_amdgcn_fence(__ATOMIC_ACQUIRE, "agent");
            xb_add(&bar[XB_XGEN(b.x)], 1u);
            asm volatile("s_waitcnt vmcnt(0)" ::: "memory");
        } else {
            XB_SPIN(xb_ld(&bar[XB_XGEN(b.x)]) == gen, bar);
            __builtin_amdgcn_fence(__ATOMIC_ACQUIRE, "agent");
            asm volatile("s_waitcnt vmcnt(0)" ::: "memory");
        }
    }
    __syncthreads();
}
struct Frame {
    LAS unsigned char* lds; unsigned char* ldsg;
    int tid, lane, wave, vcu, G, gw, NGW;
    const float *x, *c, *ctx, *c_ctx, *ada_w, *ada_b, *norm1_g, *norm2_g, *w_in, *b_gate, *q_norm_g, *k_norm_g, *conv_w, *w_ao, *w_co, *w_o, *peer_wq, *peer_k1, *peer_k2, *peer_u, *peer_v, *final_g;
    float* out; unsigned char* ws;
    float* mod;
};

__device__ __forceinline__ void frame_refresh(Frame& F) {
    int tid = threadIdx.x; asm volatile("" : "+v"(tid));
    F.tid = tid; F.lane = tid & 63; F.wave = __builtin_amdgcn_readfirstlane(tid >> 6);
    int bx = blockIdx.x; asm volatile("" : "+s"(bx));
    F.vcu = (F.G % 8 == 0) ? (bx % 8) * (F.G / 8) + bx / 8 : bx;
    F.gw = F.vcu * NWAVES + F.wave; F.NGW = F.G * NWAVES;
}
__device__ __forceinline__ void p0_transpose_item(const float* W, int N, bf16* WT, int ldk, int koff, LAS float* scr, int item, int lane) {
    const int nblk = N / 32, kb = item / nblk, nb = item % nblk, k0 = 64 * kb, n0 = 32 * nb;
#pragma unroll 32
    for (int i = 0; i < 32; ++i) { const int kk = 2 * i + (lane >> 5); scr[kk * 33 + (lane & 31)] = __builtin_nontemporal_load(&W[(size_t)(k0 + kk) * N + n0 + (lane & 31)]); }
    LDS_WAIT(); asm volatile("" ::: "memory");
    const int c = lane & 7;
#pragma unroll
    for (int j = 0; j < 4; ++j) { const int n = (lane >> 3) + 8 * j; const LAS float* s = scr + (8 * c) * 33 + n;
        v4u o; o.x = pk2(s[0 * 33], s[1 * 33]); o.y = pk2(s[2 * 33], s[3 * 33]); o.z = pk2(s[4 * 33], s[5 * 33]); o.w = pk2(s[6 * 33], s[7 * 33]);
        *(GAS v4u*)(WT + (size_t)(n0 + n) * ldk + koff + k0 + 8 * c) = o; }
    LDS_WAIT(); asm volatile("" ::: "memory");
}
__device__ __forceinline__ void p0_transpose_item8(const float* W, int N, unsigned char* WT, int ldk, LAS float* scr, int item, int lane) {
    const int nblk = N / 32, kb = item / nblk, nb = item % nblk, k0 = 64 * kb, n0 = 32 * nb;
#pragma unroll 32
    for (int i = 0; i < 32; ++i) { const int kk = 2 * i + (lane >> 5); scr[kk * 33 + (lane & 31)] = __builtin_nontemporal_load(&W[(size_t)(k0 + kk) * N + n0 + (lane & 31)]); }
    LDS_WAIT(); asm volatile("" ::: "memory");
    const int c = lane & 7;
#pragma unroll
    for (int j = 0; j < 4; ++j) { const int n = (lane >> 3) + 8 * j; const LAS float* s = scr + (8 * c) * 33 + n; float f[8];
#pragma unroll
        for (int i = 0; i < 8; ++i) f[i] = fminf(fmaxf(s[i * 33] * W8_SCALE, -448.f), 448.f);
        int w0 = 0, w1 = 0; w0 = __builtin_amdgcn_cvt_pk_fp8_f32(f[0], f[1], w0, false); w0 = __builtin_amdgcn_cvt_pk_fp8_f32(f[2], f[3], w0, true);
        w1 = __builtin_amdgcn_cvt_pk_fp8_f32(f[4], f[5], w1, false); w1 = __builtin_amdgcn_cvt_pk_fp8_f32(f[6], f[7], w1, true);
        v2u o; o.x = (unsigned)w0; o.y = (unsigned)w1; *(GAS v2u*)(WT + (size_t)(n0 + n) * ldk + k0 + 8 * c) = o; }
    LDS_WAIT(); asm volatile("" ::: "memory");
}
__device__ __forceinline__ void p0_cvt_item(const float* src, bf16* dst, size_t item, int lane) {
    const float* s = src + item * 4096 + lane * 8; bf16* d = dst + item * 4096 + lane * 8;
#pragma unroll
    for (int j = 0; j < 8; ++j) { const v4f a = *(const GAS v4f*)(s + j * 512), b = *(const GAS v4f*)(s + j * 512 + 4);
        v4u o; o.x = pk2(a.x, a.y); o.y = pk2(a.z, a.w); o.z = pk2(b.x, b.y); o.w = pk2(b.z, b.w); *(GAS v4u*)(d + j * 512) = o; }
}
__device__ __forceinline__ void p0_fp8_row(const float* src, unsigned char* dst, float* scale, int lane) {
    const GAS v4f* xr = (const GAS v4f*)src + lane; v4f v[8]; float am = 0.f;
#pragma unroll
    for (int j = 0; j < 8; ++j) { v[j] = __builtin_nontemporal_load(&xr[64 * j]); am = fmaxf(am, fmaxf(fmaxf(fabsf(v[j].x), fabsf(v[j].y)), fmaxf(fabsf(v[j].z), fabsf(v[j].w)))); }
#pragma unroll
    for (int o = 1; o < 64; o <<= 1) am = fmaxf(am, __shfl_xor(am, o));
    const float inv = am > 0.f ? 448.f / am : 0.f;
    if (lane == 0) *scale = am * (1.f / 448.f);
#pragma unroll
    for (int j = 0; j < 8; ++j) { int w = 0; w = __builtin_amdgcn_cvt_pk_fp8_f32(v[j].x * inv, v[j].y * inv, w, false); w = __builtin_amdgcn_cvt_pk_fp8_f32(v[j].z * inv, v[j].w * inv, w, true);
        *(GAS int*)(dst + (size_t)(2 * j + (lane >> 5)) * ((size_t)16384 * 128) + 4 * (lane & 31)) = w; }
}
__device__ __forceinline__ void p0_ada_item(Frame& F, const LAS float* sl, int item) {
    const int kc = item & 15, nb = (item >> 4) % 48, l = item / (16 * 48);
    const float* W = F.ada_w + ((size_t)l * DM + kc * 128) * 12288 + nb * 256 + F.lane * 4;
    v4f acc[5];
#pragma unroll
    for (int r = 0; r < 5; ++r) acc[r] = (v4f){0.f, 0.f, 0.f, 0.f};
#pragma unroll 16
    for (int k = 0; k < 128; ++k) { const v4f w = __builtin_nontemporal_load((const GAS v4f*)(W + (size_t)k * 12288));
#pragma unroll
        for (int r = 0; r < 5; ++r) acc[r] += w * sl[r * DM + kc * 128 + k]; }
    float* m = (float*)(F.ws + WS_MODP) + ((size_t)kc * 2 + l) * 5 * 12288 + nb * 256 + F.lane * 4;
#pragma unroll
    for (int r = 0; r < 5; ++r) *(GAS v4f*)(m + r * 12288) = acc[r];
}
__device__ __forceinline__ void mod_reduce_phase(Frame& F) {
    frame_refresh(F);
    const float* mp = (const float*)(F.ws + WS_MODP);
    for (int i = F.gw * 64 + F.lane; i < 2 * 5 * 12288 / 4; i += F.NGW * 64) { v4f s = (v4f){0.f, 0.f, 0.f, 0.f};
#pragma unroll
        for (int kc = 0; kc < 16; ++kc) s += *(const GAS v4f*)(mp + (size_t)kc * 2 * 5 * 12288 + (size_t)i * 4);
        *(GAS v4f*)(F.mod + (size_t)i * 4) = s; }
}
__device__ __forceinline__ void p0_prologue(Frame& F) {
    frame_refresh(F);
    LAS float* scr = (LAS float*)(F.lds + F.wave * 9216);
    LAS float* sl = (LAS float*)(F.lds + 8 * 9216);
    for (int i = F.tid; i < 5 * DM; i += NWAVES * 64) { const float v = (i < 4 * DM) ? F.c[i] : F.c_ctx[i - 4 * DM]; sl[i] = v / (1.f + __expf(-v)); }
    __syncthreads();
    constexpr int I_ADA = 2 * 48 * 16;
    constexpr int I_WIN = 2 * 32 * (INW / 32);
    constexpr int I_SQ = 2 * 32 * 64;
    constexpr int I_UV = 2 * NEXP;
    constexpr int I_KEY = 2 * 8 * 128 * 128 / 4096;
    constexpr int NITEMS = I_ADA + I_WIN + 4 * I_SQ + 2 * I_UV + 2 * I_KEY;
    for (int it = F.gw; it < NITEMS; it += F.NGW) {
        int r = it;
        if (r < I_ADA) { p0_ada_item(F, sl, r); continue; } r -= I_ADA;
        if (r < I_WIN) { const int l = r / (I_WIN / 2), q = r % (I_WIN / 2); p0_transpose_item8(F.w_in + (size_t)l * DM * INW, INW, F.ws + WS_WIN + (size_t)l * INW * DM, DM, scr, q, F.lane); continue; } r -= I_WIN;
        if (r < 4 * I_SQ) { const int mtx = r / I_SQ, rr = r % I_SQ, l = rr / (I_SQ / 2), q = rr % (I_SQ / 2);
            const size_t mo = (size_t)l * DM * DM;
            if (mtx == 0) p0_transpose_item8(F.w_ao + mo, DM, F.ws + WS_W2 + (size_t)l * DM * 4096, 4096, scr, q, F.lane);
            else if (mtx == 1) p0_transpose_item8(F.w_co + mo, DM, F.ws + WS_W2 + (size_t)l * DM * 4096 + DM, 4096, scr, q, F.lane);
            else if (mtx == 2) p0_transpose_item8(F.w_o + mo, DM, F.ws + WS_WO + mo, DM, scr, q, F.lane);
            else p0_transpose_item(F.peer_wq + mo, DM, (bf16*)(F.ws + WS_WQ) + mo, DM, 0, scr, q, F.lane);
            continue; } r -= 4 * I_SQ;
        if (r < 2 * I_UV) { const int tb = r / I_UV, row = r % I_UV; p0_fp8_row((tb ? F.peer_v : F.peer_u) + (size_t)row * DM, F.ws + (tb ? WS_PV : WS_PU) + (size_t)(row / NEXP) * NEXP * DM + (size_t)(row % NEXP) * 128, (float*)(F.ws + (tb ? WS_SV : WS_SU)) + row, F.lane); continue; } r -= 2 * I_UV;
        { const int tb = r / I_KEY; p0_cvt_item(tb ? F.peer_k2 : F.peer_k1, (bf16*)(F.ws + (tb ? WS_K2B : WS_K1B)), (size_t)(r % I_KEY), F.lane); }
    }
}

__device__ __forceinline__ const float* xrow_ptr(const float* xlat, const float* xctx, int row) { return row < NLAT ? xlat + (size_t)row * DM : xctx + (size_t)(row - NLAT) * DM; }
template <bool IN16> __device__ __forceinline__ int row_col(int j, int lane) { return IN16 ? 8 * lane + 512 * (j >> 1) + 4 * (j & 1) : 4 * lane + 256 * j; }
template <bool IN16>
__device__ __forceinline__ void quant_row8(const v4f (&y)[8], unsigned char* orow8, float* hs, int lane) {
    float am = 0.f;
#pragma unroll
    for (int j = 0; j < 8; ++j) am = fmaxf(am, fmaxf(fmaxf(fabsf(y[j].x), fabsf(y[j].y)), fmaxf(fabsf(y[j].z), fabsf(y[j].w))));
#pragma unroll
    for (int o = 1; o < 64; o <<= 1) am = fmaxf(am, __shfl_xor(am, o));
    const float inv = am > 0.f ? 448.f / am : 0.f;
    if (lane == 0) *hs = am * (1.f / 448.f);
#pragma unroll
    for (int j = 0; j < 8; ++j) { int w = 0; w = __builtin_amdgcn_cvt_pk_fp8_f32(y[j].x * inv, y[j].y * inv, w, false); w = __builtin_amdgcn_cvt_pk_fp8_f32(y[j].z * inv, y[j].w * inv, w, true);
        *(GAS int*)(orow8 + row_col<IN16>(j, lane)) = w; }
}
template <bool IN16> __device__ __forceinline__ void load_row(v4f (&d)[8], const float* xlat, const float* xctx, const bf16* xs, int row, int lane) {
    if constexpr (IN16) { const GAS v4u* p = (const GAS v4u*)(xs + (size_t)row * DM) + lane;
#pragma unroll
        for (int j = 0; j < 4; ++j) { const v4u w = p[64 * j]; d[2 * j] = (v4f){bflo(w.x), bfhi(w.x), bflo(w.y), bfhi(w.y)}; d[2 * j + 1] = (v4f){bflo(w.z), bfhi(w.z), bflo(w.w), bfhi(w.w)}; }
    } else { const GAS v4f* xr = (const GAS v4f*)(row < NLAT ? xlat + (size_t)row * DM : xctx + (size_t)(row - NLAT) * DM) + lane;
#pragma unroll
        for (int j = 0; j < 8; ++j) d[j] = xr[64 * j]; }
}
template <int F8, bool IN16>
__device__ __forceinline__ void norm_phase(Frame& F, const float* xlat, const float* xctx, int nrows, int l, const float* g, int csh, int csc) {
    frame_refresh(F); asm volatile("" : "+s"(l));
    bf16* H = (bf16*)(F.ws + WS_H); const bf16* XS = (const bf16*)(F.ws + WS_XS);
    const float* modl = F.mod + (size_t)l * 5 * 12288; const float* bl = F.ada_b + (size_t)l * 12288;
    const int lane = F.lane;
    const int r0 = (int)(((long)F.gw * nrows) / F.NGW), r1 = (int)(((long)(F.gw + 1) * nrows) / F.NGW);
    if (r0 >= r1) return;
    if constexpr (IN16) {
    v4u rawA[4], rawB[4]; v4f Av[8], Bv[8]; int have = -1;
#define NP_LD(raw_, row_) do { const GAS v4u* p_ = (const GAS v4u*)(XS + (size_t)(row_) * DM) + lane; _Pragma("unroll") for (int j = 0; j < 4; ++j) raw_[j] = p_[64 * j]; } while (0)
#define NP_MOD(row_) do { const int mr = (row_) < NLAT ? (row_) / SEQ : 4; \
        if (mr != have) { have = mr; \
            const float* msh = modl + mr * 12288 + csh * DM; const float* msc = modl + mr * 12288 + csc * DM; const float* bsh = bl + csh * DM; const float* bsc = bl + csc * DM; \
            _Pragma("unroll") for (int j = 0; j < 8; ++j) { const int cidx = row_col<IN16>(j, lane); \
                Av[j] = *(const v4f*)(g + cidx) * (*(const v4f*)(msc + cidx) + *(const v4f*)(bsc + cidx) + 1.f); Bv[j] = *(const v4f*)(msh + cidx) + *(const v4f*)(bsh + cidx); } } } while (0)
#define NP_ROW(raw_, row_) do { v4f cur[8]; \
        _Pragma("unroll") for (int j = 0; j < 4; ++j) { const v4u w = raw_[j]; cur[2 * j] = (v4f){bflo(w.x), bfhi(w.x), bflo(w.y), bfhi(w.y)}; cur[2 * j + 1] = (v4f){bflo(w.z), bfhi(w.z), bflo(w.w), bfhi(w.w)}; } \
        float s_ = 0.f; \
        _Pragma("unroll") for (int j = 0; j < 8; ++j) s_ += (cur[j].x * cur[j].x + cur[j].y * cur[j].y) + (cur[j].z * cur[j].z + cur[j].w * cur[j].w); \
        const float rstd = rsqrtf(wave_sum(s_) * (1.f / DM) + EPS); \
        bf16* orow = H + (size_t)(row_) * DM; v4f yv[8]; \
        _Pragma("unroll") for (int j = 0; j < 8; ++j) { const int cidx = row_col<IN16>(j, lane); \
            const v4f y = (cur[j] * rstd) * Av[j] + Bv[j]; yv[j] = y; \
            if (!F8) { v2u o; o.x = pk2(y.x, y.y); o.y = pk2(y.z, y.w); *(GAS v2u*)(orow + cidx) = o; } } \
        if (F8) quant_row8<IN16>(yv, (unsigned char*)H + (size_t)(row_) * DM, (float*)(F.ws + WS_HS) + (row_), lane); } while (0)
    NP_LD(rawA, r0);
    for (int row = r0; row < r1; row += 2) {
        NP_MOD(row);
        NP_LD(rawB, min(row + 1, r1 - 1));
        NP_ROW(rawA, row);
        if (row + 1 < r1) {
            NP_MOD(row + 1);
            NP_LD(rawA, min(row + 2, r1 - 1));
            NP_ROW(rawB, row + 1); }
    }
#undef NP_LD
#undef NP_MOD
#undef NP_ROW
    } else {
    v4f cur[8], nxt[8], Av[8], Bv[8]; int have = -1;
    load_row<IN16>(cur, xlat, xctx, XS, r0, lane);
    for (int row = r0; row < r1; ++row) {
        const int mr = row < NLAT ? row / SEQ : 4;
        if (mr != have) { have = mr;
            const float* msh = modl + mr * 12288 + csh * DM; const float* msc = modl + mr * 12288 + csc * DM; const float* bsh = bl + csh * DM; const float* bsc = bl + csc * DM;
#pragma unroll
            for (int j = 0; j < 8; ++j) { const int cidx = row_col<IN16>(j, lane);
                Av[j] = *(const v4f*)(g + cidx) * (*(const v4f*)(msc + cidx) + *(const v4f*)(bsc + cidx) + 1.f); Bv[j] = *(const v4f*)(msh + cidx) + *(const v4f*)(bsh + cidx); } }
        load_row<IN16>(nxt, xlat, xctx, XS, min(row + 1, r1 - 1), lane);
        float s = 0.f;
#pragma unroll
        for (int j = 0; j < 8; ++j) s += (cur[j].x * cur[j].x + cur[j].y * cur[j].y) + (cur[j].z * cur[j].z + cur[j].w * cur[j].w);
        const float rstd = rsqrtf(wave_sum(s) * (1.f / DM) + EPS);
        bf16* orow = H + (size_t)row * DM; v4f yv[8];
#pragma unroll
        for (int j = 0; j < 8; ++j) { const int cidx = row_col<IN16>(j, lane);
            const v4f y = (cur[j] * rstd) * Av[j] + Bv[j]; yv[j] = y;
            if (!F8) { v2u o; o.x = pk2(y.x, y.y); o.y = pk2(y.z, y.w); *(GAS v2u*)(orow + cidx) = o; } }
        if (F8) quant_row8<IN16>(yv, (unsigned char*)H + (size_t)row * DM, (float*)(F.ws + WS_HS) + row, lane);
#pragma unroll
        for (int j = 0; j < 8; ++j) cur[j] = nxt[j];
    }
    }
}
__device__ __forceinline__ void unpack8(const v2u w, float (&f)[8]) {
    typedef float f2_t __attribute__((ext_vector_type(2))); const float k = 1.f / G8_SCALE;
    const f2_t a = __builtin_amdgcn_cvt_pk_f32_fp8((int)w.x, false), b = __builtin_amdgcn_cvt_pk_f32_fp8((int)w.x, true), c = __builtin_amdgcn_cvt_pk_f32_fp8((int)w.y, false), d = __builtin_amdgcn_cvt_pk_f32_fp8((int)w.y, true);
    f[0] = a.x * k; f[1] = a.y * k; f[2] = b.x * k; f[3] = b.y * k; f[4] = c.x * k; f[5] = c.y * k; f[6] = d.x * k; f[7] = d.y * k; }
__device__ __forceinline__ void unpack8(const v4u w, float (&f)[8]) { f[0] = bflo(w.x); f[1] = bfhi(w.x); f[2] = bflo(w.y); f[3] = bfhi(w.y); f[4] = bflo(w.z); f[5] = bfhi(w.z); f[6] = bflo(w.w); f[7] = bfhi(w.w); }
__device__ __forceinline__ v4u pack8(const float (&f)[8]) { v4u o; o.x = pk2(f[0], f[1]); o.y = pk2(f[2], f[3]); o.z = pk2(f[4], f[5]); o.w = pk2(f[6], f[7]); return o; }
__device__ __forceinline__ v2u pack8_fp8(const float (&f)[8], float scale) { float c[8];
#pragma unroll
    for (int i = 0; i < 8; ++i) c[i] = fminf(fmaxf(f[i] * scale, -448.f), 448.f);
    int w0 = 0, w1 = 0; w0 = __builtin_amdgcn_cvt_pk_fp8_f32(c[0], c[1], w0, false); w0 = __builtin_amdgcn_cvt_pk_fp8_f32(c[2], c[3], w0, true);
    w1 = __builtin_amdgcn_cvt_pk_fp8_f32(c[4], c[5], w1, false); w1 = __builtin_amdgcn_cvt_pk_fp8_f32(c[6], c[7], w1, true);
    v2u o; o.x = (unsigned)w0; o.y = (unsigned)w1; return o; }
template <class W>
__device__ __forceinline__ v2u head_norm_rope(const W in, const float (&g)[8], bool rope, const float (&cs)[8], const float (&sn)[8], bool second) {
    float f[8]; unpack8(in, f); float ss = 0.f;
#pragma unroll
    for (int i = 0; i < 8; ++i) ss += f[i] * f[i];
    ss = sum16(ss);
    const float rstd = rsqrtf(ss * (1.f / 128.f) + EPS);
#pragma unroll
    for (int i = 0; i < 8; ++i) f[i] = f[i] * rstd * g[i];
    if (rope) {
        float o[8];
#pragma unroll
        for (int i = 0; i < 8; ++i) { const float pv = __shfl_xor(f[i], 4); o[i] = second ? f[i] * cs[i] + pv * sn[i] : f[i] * cs[i] - pv * sn[i]; }
        return pack8_fp8(o, att::QK8);
    }
    return pack8_fp8(f, att::QK8);
}
template <int VARX = 0>
__device__ __forceinline__ void split_phase(Frame& F, int l, int nfull, int nrows) {
    frame_refresh(F); asm volatile("" : "+s"(l));
    const unsigned char* P = F.ws + WS_P;     unsigned char* A2 = F.ws + WS_A2; unsigned char* QB = F.ws + WS_Q; unsigned char* KB = F.ws + WS_KB; unsigned char* VT = F.ws + WS_VB;
    const int lane = F.lane, l16 = lane & 15;
    float qg[8], kg[8];
#pragma unroll
    for (int i = 0; i < 8; ++i) { qg[i] = F.q_norm_g[l * 128 + l16 * 8 + i]; kg[i] = F.k_norm_g[l * 128 + l16 * 8 + i]; }
    const bool second = (lane >> 2) & 1; const int blk = (lane >> 3) & 1;
    float inv[8];
#pragma unroll
    for (int i = 0; i < 8; ++i) inv[i] = __builtin_amdgcn_exp2f(-(float)((lane & 3) * 8 + i) * (13.287712379549449f / 32.f));
    const float* cw = F.conv_w + (size_t)l * 3 * DM;
    { int row = F.gw;
      if (row < nrows) {
        v2u cq[4], ck, nq[4], nk;
#define QK_LD(q_, k_, r_) do { const unsigned char* pr_ = P + (size_t)(r_) * INW + lane * 8; k_ = __builtin_nontemporal_load((const GAS v2u*)(pr_ + C_K)); \
        { _Pragma("unroll") for (int p = 0; p < 4; ++p) q_[p] = __builtin_nontemporal_load((const GAS v2u*)(pr_ + C_Q + p * 512)); } } while (0)
        QK_LD(cq, ck, row);
        for (; row < nrows; row += F.NGW) {
            { const int nr = min(row + F.NGW, nrows - 1); QK_LD(nq, nk, nr); }
            const bool lat = row < NLAT; const int b = lat ? row / SEQ : (row - NLAT) / CTXL, t = lat ? row % SEQ : (row - NLAT) % CTXL;
            const size_t kvrow = (size_t)b * SKV + (lat ? t : SEQ + t);
            float cs[8], sn[8];
            if (lat) { const float pos = (float)(blk ? (t & 63) : (t >> 6));
#pragma unroll
                for (int i = 0; i < 8; ++i) { const float a = pos * inv[i]; cs[i] = __cosf(a); sn[i] = __sinf(a); } }
            else {
#pragma unroll
                for (int i = 0; i < 8; ++i) { cs[i] = 1.f; sn[i] = 0.f; } }
            *(GAS v2u*)(KB + kvrow * KVW + lane * 8) = head_norm_rope(ck, kg, lat, cs, sn, second);
            if (row < nfull) {
#pragma unroll
                for (int p = 0; p < 4; ++p) *(GAS v2u*)(QB + (size_t)row * DM + p * 512 + lane * 8) = head_norm_rope(cq[p], qg, lat, cs, sn, second); }
#pragma unroll
            for (int p = 0; p < 4; ++p) cq[p] = nq[p];
            ck = nk;
        }
#undef QK_LD
      }
    }
    {
        const float* cw = F.conv_w + (size_t)l * 3 * DM;
        const int r0 = (int)(((long)F.gw * nfull) / F.NGW), r1 = (int)(((long)(F.gw + 1) * nfull) / F.NGW);
        auto seqid = [](int r) { return r < NLAT ? r / SEQ : 4 + (r - NLAT) / CTXL; };
        if (r0 < r1)
        for (int pp = 0; pp < 2; ++pp) {
            float w0[2][8], w1[2][8], w2[2][8];
#pragma unroll
            for (int h = 0; h < 2; ++h)
#pragma unroll
                for (int i = 0; i < 8; ++i) { const int cc = (2 * pp + h) * 512 + lane * 8 + i; w0[h][i] = cw[cc]; w1[h][i] = cw[DM + cc]; w2[h][i] = cw[2 * DM + cc]; }
            const unsigned char* pc = P + (2 * pp) * 512 + lane * 8;
#define CV_LD(U_, G_, B_, r_) do { const unsigned char* q_ = pc + (size_t)(r_) * INW; _Pragma("unroll") for (int h = 0; h < 2; ++h) { U_[h] = __builtin_nontemporal_load((const GAS v2u*)(q_ + h * 512 + C_U)); G_[h] = __builtin_nontemporal_load((const GAS v2u*)(q_ + h * 512 + C_GC)); B_[h] = __builtin_nontemporal_load((const GAS v2u*)(q_ + h * 512 + C_GB)); } } while (0)
            float mp[2][8], mc[2][8], f0[8], f1[8];
            v2u un[2], gn[2], bn_[2], u2[2], g2[2], b2[2], bc[2];
            const bool hp0 = r0 > 0 && seqid(r0 - 1) == seqid(r0);
            { v2u a[2], g[2], bb[2]; CV_LD(a, g, bb, hp0 ? r0 - 1 : r0);
#pragma unroll
              for (int h = 0; h < 2; ++h) { unpack8(a[h], f0); unpack8(g[h], f1);
#pragma unroll
                for (int i = 0; i < 8; ++i) mp[h][i] = hp0 ? f0[i] * f1[i] : 0.f; } }
            { v2u a[2], g[2]; CV_LD(a, g, bc, r0);
#pragma unroll
              for (int h = 0; h < 2; ++h) { unpack8(a[h], f0); unpack8(g[h], f1);
#pragma unroll
                for (int i = 0; i < 8; ++i) mc[h][i] = f0[i] * f1[i]; } }
            const int rlast = nfull - 1;
            CV_LD(un, gn, bn_, min(r0 + 1, rlast));
            for (int row = r0; row < r1; ++row) {
                CV_LD(u2, g2, b2, min(row + 2, rlast));
                const int sid = seqid(row); const bool hp = row > 0 && seqid(row - 1) == sid, hn = row + 1 < nfull && seqid(row + 1) == sid;
#pragma unroll
                for (int h = 0; h < 2; ++h) { float mn[8], gb[8], o[8]; unpack8(un[h], f0); unpack8(gn[h], f1); unpack8(bc[h], gb);
#pragma unroll
                    for (int i = 0; i < 8; ++i) mn[i] = f0[i] * f1[i];
#pragma unroll
                    for (int i = 0; i < 8; ++i) o[i] = gb[i] * (w0[h][i] * (hp ? mp[h][i] : 0.f) + w1[h][i] * mc[h][i] + w2[h][i] * (hn ? mn[i] : 0.f));
                    *(GAS v2u*)(A2 + (size_t)row * 4096 + 2048 + (2 * pp + h) * 512 + lane * 8) = pack8_fp8(o, CV8_SCALE);
#pragma unroll
                    for (int i = 0; i < 8; ++i) { mp[h][i] = mc[h][i]; mc[h][i] = mn[i]; }
                    bc[h] = bn_[h]; un[h] = u2[h]; gn[h] = g2[h]; bn_[h] = b2[h]; }
            }
#undef CV_LD
        }
    }
    { LAS unsigned char* Vt = F.lds; const int tid = F.tid, wave = F.wave;
      for (int T = F.vcu; T < BATCH * (SKV / 64); T += F.G) {
        const int b = T / (SKV / 64), tile = T % (SKV / 64);
#pragma unroll
        for (int j = 0; j < 8; ++j) { const int i = wave * 8 + j, kk = tile * 64 + i; const size_t row = kk < SEQ ? (size_t)b * SEQ + kk : (size_t)NLAT + b * CTXL + (kk - SEQ);
            float f[8]; unpack8(__builtin_nontemporal_load((const GAS v2u*)(P + row * INW + C_V + lane * 8)), f);
            *(LAS v2u*)(Vt + i * 512 + lane * 8) = pack8_fp8(f, att::V8); }
        LDS_WAIT(); __syncthreads();
#pragma unroll
        for (int n = 0; n < 4; ++n) { const int c = tid + 512 * n, d = c & 127, rest = c >> 7, jj = rest & 1, hh = (rest >> 1) & 1, kvh = rest >> 2;
            v4u w;
#pragma unroll
            for (int q = 0; q < 4; ++q) { unsigned x = 0u;
#pragma unroll
                for (int e = 0; e < 4; ++e) { const int i = 4 * q + e, key = jj * 32 + (i & 3) + 8 * (i >> 2) + 4 * hh; x |= (unsigned)Vt[key * 512 + kvh * 128 + d] << (8 * e); }
                w[q] = x; }
            *(GAS v4u*)(VT + ((size_t)(b * (SKV / 64) + tile) * 4 + kvh) * 8192 + d * 64 + ((((hh * 2 + jj) ^ ((d >> 2) & 3))) << 4)) = w; }
        __syncthreads();
      }
    }
}
__device__ __forceinline__ void attn_phase(Frame& F, bool with_ctx, bool dry = false) {
    frame_refresh(F);
    unsigned char* A2 = F.ws + WS_A2; const unsigned char* Q = F.ws + WS_Q; const unsigned char* KB = F.ws + WS_KB; const unsigned char* VT = F.ws + WS_VB;
    const int nunits = 1024 + (with_ctx ? 64 : 0);
    for (int u = F.vcu; u < nunits; u += F.G) {
        size_t row0, ko, vo; int seq, h;
        if (u < 1024) { const int b = u >> 8, kvh = (u >> 6) & 3, g = (u >> 4) & 3, qb = u & 15; h = kvh * 4 + g;
            row0 = (size_t)b * SEQ + qb * 256; ko = (size_t)b * SKV * KVW + kvh * 128; vo = ((size_t)b * (SKV / 64) * 4 + kvh) * 8192; seq = SKV;
        } else { const int v = u - 1024, b = v >> 4; h = v & 15; const int kvh = h >> 2;
            row0 = (size_t)NLAT + b * CTXL; ko = ((size_t)b * SKV + SEQ) * KVW + kvh * 128; vo = ((size_t)(b * (SKV / 64) + SEQ / 64) * 4 + kvh) * 8192; seq = CTXL; }
        unsigned char* od = dry ? F.ws + 404 * MiB + row0 * 2048 + h * 128 : A2 + row0 * 4096 + h * 128;
        att::attn_dense_body(Q + row0 * DM + h * 128, KB + ko, VT + vo, od, dry ? 2048 : 4096, AT8_SCALE, seq, (char*)F.ldsg);
    }
}
__device__ __forceinline__ unsigned f2ord(float f) { const unsigned u = __float_as_uint(f); return u ^ ((u >> 31) ? 0xFFFFFFFFu : 0x80000000u); }
__device__ __forceinline__ float ord2f(unsigned o) { return __uint_as_float(o ^ ((o >> 31) ? 0x80000000u : 0xFFFFFFFFu)); }
typedef short s16x8 __attribute__((ext_vector_type(8)));
typedef float f32x16 __attribute__((ext_vector_type(16)));
__device__ __forceinline__ int crow16(int r, int hi) { return (r & 3) + 8 * (r >> 2) + 4 * hi; }
__device__ __forceinline__ unsigned max16u(unsigned v) {
    v = max(v, dppu<DPP_X1>(v)); v = max(v, dppu<DPP_X2>(v)); v = max(v, dppu<DPP_HMIR>(v)); v = max(v, dppu<DPP_MIR>(v)); return v;
}
#define CSWAP(a_, b_) do { const unsigned hi_ = max(a_, b_), lo_ = min(a_, b_); a_ = hi_; b_ = lo_; } while (0)
__device__ __forceinline__ void topk_phase(Frame& F, int l, int nrows) {
    frame_refresh(F); asm volatile("" : "+s"(l));
    const bf16* PQ = (const bf16*)(F.ws + WS_PQ);
    const bf16* K1 = (const bf16*)(F.ws + WS_K1B) + (size_t)l * 8 * 128 * 128; const bf16* K2 = (const bf16*)(F.ws + WS_K2B) + (size_t)l * 8 * 128 * 128;
    int* IDX = (int*)(F.ws + WS_IDX); float* GW = (float*)(F.ws + WS_GW);
    LAS float* S = (LAS float*)(F.lds + F.wave * 18688);
    LAS unsigned* T1 = (LAS unsigned*)(F.lds + F.wave * 18688 + 16384);
    LAS unsigned* T2 = T1 + 512;
    const int lane = F.lane, r32 = lane & 31, hi = lane >> 5, l16 = lane & 15, qd = lane >> 4;
    int ct[4] = {0xFF, 0xFF, 0xFF, 0xFF};
    { int cnt = 0;
      for (int i = 0; i < 16; ++i) for (int j = 0; j < 16; ++j) if ((i + 1) * (j + 1) <= 16) {
#pragma unroll
          for (int s = 0; s < 4; ++s) if (cnt == l16 * 4 + s) ct[s] = (i << 4) | j;
          ++cnt; } }
    const int nitems = (nrows / 32) * 8;
    const long npass = (long)nitems * 8; const int pbeg = (int)(((long)F.gw * npass) / F.NGW), pend = (int)(((long)(F.gw + 1) * npass) / F.NGW);
    for (int pp = pbeg; pp < pend; ) {
        const int it = pp >> 3, ps_lo = pp & 7, ps_hi = min(8, ps_lo + (pend - pp)); pp += ps_hi - ps_lo;
        const int h = it & 7, tok0 = (it >> 3) * 32;
        for (int half = 0; half < 2; ++half) {
            f32x16 acc[4];
#pragma unroll
            for (int nb = 0; nb < 4; ++nb) acc[nb] = (f32x16){};
            const bf16* qp = PQ + (size_t)(tok0 + r32) * DM + h * 256 + half * 128 + hi * 8;
            const bf16* kp = (half ? K2 : K1) + ((size_t)h * 128 + r32) * 128 + hi * 8;
#pragma unroll
            for (int d0 = 0; d0 < 8; ++d0) { const s16x8 a = __builtin_nontemporal_load((const GAS s16x8*)(qp + d0 * 16));
#pragma unroll
                for (int nb = 0; nb < 4; ++nb) { const s16x8 bb = *(const GAS s16x8*)(kp + (size_t)nb * 32 * 128 + d0 * 16); acc[nb] = __builtin_amdgcn_mfma_f32_32x32x16_bf16(a, bb, acc[nb], 0, 0, 0); } }
#pragma unroll
            for (int nb = 0; nb < 4; ++nb)
#pragma unroll
                for (int r = 0; r < 16; ++r) S[crow16(r, hi) * 128 + nb * 32 + r32] = acc[nb][r];
            LDS_WAIT();
            for (int ps = ps_lo; ps < ps_hi; ++ps) {
                const int tok = ps * 4 + qd;
                unsigned k[8];
#pragma unroll
                for (int j = 0; j < 8; ++j) k[j] = (f2ord(S[tok * 128 + j * 16 + l16]) & ~127u) | (unsigned)(127 - (j * 16 + l16));
                CSWAP(k[0], k[1]); CSWAP(k[2], k[3]); CSWAP(k[4], k[5]); CSWAP(k[6], k[7]);
                CSWAP(k[0], k[2]); CSWAP(k[1], k[3]); CSWAP(k[4], k[6]); CSWAP(k[5], k[7]);
                CSWAP(k[1], k[2]); CSWAP(k[5], k[6]); CSWAP(k[0], k[4]); CSWAP(k[3], k[7]);
                CSWAP(k[1], k[5]); CSWAP(k[2], k[6]);
                CSWAP(k[1], k[4]); CSWAP(k[3], k[6]);
                CSWAP(k[2], k[4]); CSWAP(k[3], k[5]);
                CSWAP(k[3], k[4]);
                unsigned mine = 0u;
                for (int rnd = 0; rnd < 16; ++rnd) {
                    const unsigned m = max16u(k[0]);
                    if (l16 == rnd) mine = m;
                    const bool pop = (k[0] == m);
#pragma unroll
                    for (int j = 0; j < 7; ++j) k[j] = pop ? k[j + 1] : k[j];
                    k[7] = pop ? 0u : k[7];
                }
                if (half == 0) T1[tok * 16 + l16] = mine;
                else {
                    T2[qd * 16 + l16] = mine;
                    LDS_WAIT();
                    unsigned ck[4];
#pragma unroll
                    for (int s = 0; s < 4; ++s) { const int i = (ct[s] >> 4) & 15, j = ct[s] & 15;
                        const float c = ord2f(T1[tok * 16 + i] & ~127u) + ord2f(T2[qd * 16 + j] & ~127u);
                        ck[s] = (ct[s] == 0xFF) ? 0u : ((f2ord(c) & ~255u) | (unsigned)(255 - ct[s])); }
                    CSWAP(ck[0], ck[1]); CSWAP(ck[2], ck[3]); CSWAP(ck[0], ck[2]); CSWAP(ck[1], ck[3]); CSWAP(ck[1], ck[2]);
                    unsigned win = 0u, m0 = 0u;
                    for (int rnd = 0; rnd < 16; ++rnd) {
                        const unsigned m = max16u(ck[0]);
                        if (rnd == 0) m0 = m;
                        if (l16 == rnd) win = m;
                        const bool pop = (ck[0] == m);
                        ck[0] = pop ? ck[1] : ck[0]; ck[1] = pop ? ck[2] : ck[1]; ck[2] = pop ? ck[3] : ck[2]; ck[3] = pop ? 0u : ck[3];
                    }
                    const float sv = ord2f(win & ~255u), smax = ord2f(m0 & ~255u);
                    const int ij = 255 - (int)(win & 255u), ci = (ij >> 4) & 15, cj = ij & 15;
                    const int e = (127 - (int)(T1[tok * 16 + ci] & 127u)) * 128 + (127 - (int)(T2[qd * 16 + cj] & 127u));
                    const float p = __expf(sv - smax);
                    const float den = sum16(p);
                    { const size_t o = (size_t)(tok0 + tok) * 128 + h * 16 + l16; IDX[o] = e; GW[o] = p / den; }
                    LDS_WAIT();
                }
            }
        }
    }
}
#undef CSWAP

typedef float f32x2_t __attribute__((ext_vector_type(2)));
constexpr int NSL = 16;
constexpr size_t WS_W8 = WS_P + 252 * MiB, WS_TS = WS_P + 255 * MiB;
constexpr size_t WS_PART = WS_P + 96 * MiB, WS_WT = WS_P + 240 * MiB, WS_SSQ = WS_P + 250 * MiB;
#define PS_IDX2(dst, src, tok_) do { const GAS unsigned* p_ = (const GAS unsigned*)((src) + (size_t)(tok_) * 128 + grp * 16 + c8); dst[0] = p_[0]; dst[1] = p_[8]; } while (0)
#define PS_BC(v, II) __builtin_amdgcn_ds_swizzle((int)(v), ((II) << 5) | 0x18)
#define PS_LD1(buf, II, ev_) { const unsigned e_ = (unsigned)PS_BC(ev_, II); buf[II] = *(const GAS v4u*)(tbl + ((MODE == 2 ? (e_ & 63u) : e_) * 128u + loff)); }
#define PS_LOAD(buf, ev, C_) do { const unsigned ev_ = ev[C_]; PS_LD1(buf, 0, ev_) PS_LD1(buf, 1, ev_) PS_LD1(buf, 2, ev_) PS_LD1(buf, 3, ev_) PS_LD1(buf, 4, ev_) PS_LD1(buf, 5, ev_) PS_LD1(buf, 6, ev_) PS_LD1(buf, 7, ev_) } while (0)
template <int MODE>
__device__ __forceinline__ void peer_up_phase(Frame& F, int l, int nrows) {
    frame_refresh(F); asm volatile("" : "+s"(l));
    const int lane = F.lane, grp = lane >> 3, c8 = lane & 7;
    const int xg = blockIdx.x & 7, wg = (blockIdx.x >> 3) * NWAVES + F.wave, nwg = (F.G >> 3) * NWAVES;
    const unsigned char* tbl = F.ws + WS_PU + (size_t)l * NEXP * DM;
    const unsigned* IDX = (const unsigned*)(F.ws + WS_IDX); const bf16* H = (const bf16*)(F.ws + WS_H); bf16* PART = (bf16*)(F.ws + WS_PART);
    for (int sub = 0; sub < 2; ++sub) {
        const int slice = xg + 8 * sub; const unsigned loff = (unsigned)(slice * (NEXP * 128) + c8 * 16);
        int tok = wg; if (tok >= nrows) continue;
        unsigned e0[2], e1[2], e2[2], h0, h1 = 0u; v4u bufA[8], bufB[8];
        const GAS unsigned* H32 = (const GAS unsigned*)H + slice * 64 + lane;
        PS_IDX2(e0, IDX, tok); h0 = H32[(size_t)tok * (DM / 2)];
        if (tok + nwg < nrows) PS_IDX2(e1, IDX, tok + nwg); else { e1[0] = e0[0]; e1[1] = e0[1]; }
        PS_LOAD(bufA, e0, 0);
        for (; tok < nrows; tok += nwg) {
            const int t1 = tok + nwg, t2 = tok + 2 * nwg;
            if (t2 < nrows) PS_IDX2(e2, IDX, t2);
            if (t1 < nrows) h1 = H32[(size_t)t1 * (DM / 2)];
            PS_LOAD(bufB, e0, 1);
            f32x2_t hf[8];
#pragma unroll
            for (int k = 0; k < 8; ++k) { const unsigned w = (unsigned)__builtin_amdgcn_ds_bpermute((c8 * 8 + k) * 4, (int)h0); hf[k] = (f32x2_t){bflo(w), bfhi(w)}; }
            float keep[2] = {0.f, 0.f};
#define PS_UPCOMP(buf, C_) do { _Pragma("unroll") for (int ii = 0; ii < 8; ++ii) { const v4u uv = buf[ii]; f32x2_t s0 = {0.f, 0.f}, s1 = {0.f, 0.f}; \
                if (MODE == 1) { s0.x = __uint_as_float((uv.x ^ uv.y) & 0x3fffffffu); s1.x = __uint_as_float((uv.z ^ uv.w) & 0x3fffffffu); } else { \
                _Pragma("unroll") for (int q = 0; q < 4; ++q) { const f32x2_t lo = __builtin_amdgcn_cvt_pk_f32_fp8((int)uv[q], false), hi = __builtin_amdgcn_cvt_pk_f32_fp8((int)uv[q], true); \
                    s0 += lo * hf[q * 2]; s1 += hi * hf[q * 2 + 1]; } } \
                s0 += s1; float d = s0.x + s0.y; d += dppf<DPP_X1>(d); d += dppf<DPP_X2>(d); d += dppf<DPP_HMIR>(d); \
                if (c8 == ii) keep[C_] = d; } } while (0)
            PS_UPCOMP(bufA, 0);
            if (t1 < nrows) PS_LOAD(bufA, e1, 0);
            PS_UPCOMP(bufB, 1);
            bf16* pp = PART + ((size_t)slice * MALL + tok) * 128 + grp * 16 + c8;
            pp[0] = (bf16)f2bf(keep[0]); pp[8] = (bf16)f2bf(keep[1]);
            e0[0] = e1[0]; e0[1] = e1[1]; e1[0] = e2[0]; e1[1] = e2[1]; h0 = h1;
        }
    }
}
__device__ __forceinline__ int peer_slot_of_storage(int st) { return ((st >> 5) + 4 * ((st >> 3) & 1)) * 16 + 2 * (st & 7) + ((st >> 4) & 1); }
__device__ __forceinline__ void peer_up_mfma(Frame& F, int l, int nrows) {
    frame_refresh(F); asm volatile("" : "+s"(l));
    typedef int v8i_t __attribute__((ext_vector_type(8))); typedef int v4i_t __attribute__((ext_vector_type(4)));
    const int lane = F.lane, i16 = lane & 15, kq = lane >> 4, ch = 4 * (kq & 1) + (i16 & 3), xsl = (i16 >> 2) + 4 * (kq >> 1);
    const bool hnz = (kq >> 1) == ((i16 >> 2) & 1), hsel = (i16 >> 3) & 1; const int rsel = lane & 3;
    const int xg = blockIdx.x & 7, wg = (blockIdx.x >> 3) * NWAVES + F.wave, nwg = (F.G >> 3) * NWAVES;
    const unsigned* IDX = (const unsigned*)(F.ws + WS_IDX); const unsigned char* Hb = F.ws + WS_H; bf16* PART = (bf16*)(F.ws + WS_PART);
    for (int sub = 0; sub < 2; ++sub) {
        const int slice = xg + 8 * sub;
        const unsigned char* tbl = F.ws + WS_PU + (size_t)l * NEXP * DM + (size_t)slice * (NEXP * 128);
        const unsigned loff = (unsigned)(ch * 16);
        int tok = wg; if (tok >= nrows) continue;
#define UM_LDE(e_, t_) do { e_ = *(const GAS v2u*)((const GAS unsigned*)IDX + (size_t)(t_) * 128 + 2 * lane); } while (0)
#define UM_LDH(h_, t_) do { h_ = *(const GAS unsigned*)(Hb + (size_t)(t_) * (DM * 2) + slice * 256 + 4 * lane); } while (0)
#define UM_LDA(A_, e_) do { _Pragma("unroll") for (int g = 0; g < 8; ++g) { const int src_ = (xsl * 8 + g) * 4; \
            const unsigned ea_ = (unsigned)__builtin_amdgcn_ds_bpermute(src_, (int)e_.x), eb_ = (unsigned)__builtin_amdgcn_ds_bpermute(src_, (int)e_.y); \
            A_[g].lo = *(const GAS v4i_t*)(tbl + (ea_ * 128u + loff)); A_[g].hi = *(const GAS v4i_t*)(tbl + (eb_ * 128u + loff)); } } while (0)
#define UM_COMP(A_, h_, t_, ok_) do { int hq[4]; \
            _Pragma("unroll") for (int q = 0; q < 4; ++q) { const unsigned wa = (unsigned)__builtin_amdgcn_ds_bpermute((ch * 8 + 2 * q) * 4, (int)h_), wb = (unsigned)__builtin_amdgcn_ds_bpermute((ch * 8 + 2 * q + 1) * 4, (int)h_); \
                int x0 = 0; x0 = __builtin_amdgcn_cvt_pk_fp8_f32(bflo(wa), bfhi(wa), x0, false); x0 = __builtin_amdgcn_cvt_pk_fp8_f32(bflo(wb), bfhi(wb), x0, true); hq[q] = hnz ? x0 : 0; } \
            v8i_t hb; _Pragma("unroll") for (int q = 0; q < 4; ++q) { hb[q] = hsel ? 0 : hq[q]; hb[4 + q] = hsel ? hq[q] : 0; } \
            float keep[8]; \
            _Pragma("unroll") for (int g = 0; g < 8; ++g) { v4f d = {0.f, 0.f, 0.f, 0.f}; d = __builtin_amdgcn_mfma_scale_f32_16x16x128_f8f6f4(A_[g], hb, d, 0, 0, 0, 0x7F7F7F7F, 0, 0x7F7F7F7F); \
                float qv_ = rsel == 0 ? d.x : rsel == 1 ? d.y : rsel == 2 ? d.z : d.w; qv_ += dppf<DPP_X1>(qv_); qv_ += dppf<DPP_X2>(qv_); keep[g] = qv_; }     \
            if (rsel == 0 && (ok_)) { v4u o; o.x = pg8::cvt_pk_bf16(keep[0], keep[1]); o.y = pg8::cvt_pk_bf16(keep[2], keep[3]); o.z = pg8::cvt_pk_bf16(keep[4], keep[5]); o.w = pg8::cvt_pk_bf16(keep[6], keep[7]); \
                *(GAS v4u*)(PART + ((size_t)slice * MALL + (t_)) * 128 + (lane >> 2) * 8) = o; } } while (0)
        v2u e1, e2; unsigned h0, h1, h2, h3; v8i_t bufA[8], bufB[8]; const int tl = nrows - 1;
        UM_LDE(e2, tok); UM_LDH(h0, tok); UM_LDE(e1, min(tok + nwg, tl)); UM_LDH(h1, min(tok + nwg, tl)); __builtin_amdgcn_sched_barrier(0);
        UM_LDA(bufA, e2);
        for (; tok < nrows; tok += 2 * nwg) {
            const int t1 = tok + nwg, t2 = min(tok + 2 * nwg, tl), t3 = min(tok + 3 * nwg, tl);
            UM_LDE(e2, t2); UM_LDH(h2, t2); __builtin_amdgcn_sched_barrier(0);
            UM_LDA(bufB, e1); __builtin_amdgcn_sched_barrier(0);
            UM_COMP(bufA, h0, tok, true);
            UM_LDE(e1, t3); UM_LDH(h3, t3); __builtin_amdgcn_sched_barrier(0);
            UM_LDA(bufA, e2); __builtin_amdgcn_sched_barrier(0);
            UM_COMP(bufB, h1, min(t1, tl), t1 < nrows);
            h0 = h2; h1 = h3;
        }
#undef UM_LDE
#undef UM_LDH
#undef UM_LDA
#undef UM_COMP
    }
}
__device__ __forceinline__ void peer_combine_phase(Frame& F, int l, int nrows, bool want_wt) {
    frame_refresh(F); asm volatile("" : "+s"(l));
    const bf16* PART = (const bf16*)(F.ws + WS_PART); const int* IDX = (const int*)(F.ws + WS_IDX); const float* GW = (const float*)(F.ws + WS_GW); float* WT = (float*)(F.ws + WS_WT);
    const float* SU = (const float*)(F.ws + WS_SU) + (size_t)l * NEXP; const float* SV = (const float*)(F.ws + WS_SV) + (size_t)l * NEXP;
    const int nv = nrows * 16;
    for (int v = F.gw * 64 + F.lane; v < nv; v += F.NGW * 64) {
        const int i = v * 8; float d[8];
#pragma unroll
        for (int k = 0; k < 8; ++k) d[k] = 0.f;
#pragma unroll
        for (int s = 0; s < NSL; ++s) { const v4u w = __builtin_nontemporal_load((const GAS v4u*)(PART + (size_t)s * MALL * 128 + i));
            d[0] += bflo(w.x); d[1] += bfhi(w.x); d[2] += bflo(w.y); d[3] += bfhi(w.y); d[4] += bflo(w.z); d[5] += bfhi(w.z); d[6] += bflo(w.w); d[7] += bfhi(w.w); }
        const int tb = i & ~127, st0 = i & 127; int j[8], e[8]; float gwv[8];
#pragma unroll
        for (int k = 0; k < 8; ++k) { j[k] = tb + peer_slot_of_storage(st0 + k); e[k] = IDX[j[k]]; gwv[k] = GW[j[k]]; }
        float su[8], sv[8];
#pragma unroll
        for (int k = 0; k < 8; ++k) { su[k] = SU[e[k]]; sv[k] = SV[e[k]]; }
        float a[8], am = 0.f;
#pragma unroll
        for (int k = 0; k < 8; ++k) { a[k] = gelu_erf(d[k] * su[k]) * gwv[k] * sv[k]; am = fmaxf(am, fabsf(a[k])); }
        if (want_wt) {
#pragma unroll
            for (int k = 0; k < 8; ++k) WT[j[k]] = a[k]; }
        am = fmaxf(am, dppf<DPP_X1>(am)); am = fmaxf(am, dppf<DPP_X2>(am)); am = fmaxf(am, dppf<DPP_HMIR>(am)); am = fmaxf(am, dppf<DPP_MIR>(am));
        const float inv = am > 0.f ? 448.f / am : 0.f; unsigned char* W8 = F.ws + WS_W8;
#pragma unroll
        for (int k = 0; k < 8; ++k) { const float q = fminf(fmaxf(a[k] * inv, -448.f), 448.f); W8[j[k]] = (unsigned char)__builtin_amdgcn_cvt_pk_fp8_f32(q, q, 0, false); }
        if ((F.lane & 15) == 0) ((float*)(F.ws + WS_TS))[i >> 7] = am > 0.f ? am * (1.f / 448.f) : 1.f;
    }
}
template <int MODE>
__device__ __forceinline__ void peer_down_phase(Frame& F, int l, int nrows) {
    frame_refresh(F); asm volatile("" : "+s"(l));
    const int lane = F.lane, grp = lane >> 3, c8 = lane & 7;
    const bool b4 = (lane >> 4) & 1, b3 = (lane >> 3) & 1;
    const int xg = blockIdx.x & 7, wg = (blockIdx.x >> 3) * NWAVES + F.wave, nwg = (F.G >> 3) * NWAVES;
    const unsigned char* tbl = F.ws + WS_PV + (size_t)l * NEXP * DM;
    const unsigned* IDX = (const unsigned*)(F.ws + WS_IDX); const unsigned* WT = (const unsigned*)(F.ws + WS_WT); float* SSQ = (float*)(F.ws + WS_SSQ);
    bf16* XS = (bf16*)(F.ws + WS_XS);
    const float* modl = F.mod + (size_t)l * 5 * 12288 + 5 * DM; const float* bl = F.ada_b + (size_t)l * 12288 + 5 * DM;
    for (int sub = 0; sub < 2; ++sub) {
        const int slice = xg + 8 * sub; const unsigned loff = (unsigned)(slice * (NEXP * 128) + c8 * 16);
        int tok = wg; if (tok >= nrows) continue;
        unsigned e0[2], e1[2], e2[2], w0[2], w1[2], w2[2]; v4u bufA[8], bufB[8];
        PS_IDX2(e0, IDX, tok); PS_IDX2(w0, WT, tok);
        const int tl = nrows - 1;
        PS_IDX2(e1, IDX, min(tok + nwg, tl)); PS_IDX2(w1, WT, min(tok + nwg, tl)); __builtin_amdgcn_sched_barrier(0);
        PS_LOAD(bufA, e0, 0);
        for (; tok < nrows; tok += nwg) {
            const int t2 = min(tok + 2 * nwg, tl);
            PS_IDX2(e2, IDX, t2); PS_IDX2(w2, WT, t2);
            const int mr = tok < NLAT ? tok / SEQ : 4; const int col = slice * 128 + c8 * 16 + grp * 2;
            GAS unsigned* xr = (GAS unsigned*)(XS + (size_t)tok * DM + col);
            const unsigned xw = *xr; const f32x2_t gga = *(const GAS f32x2_t*)(modl + mr * 12288 + col), ggb = *(const GAS f32x2_t*)(bl + col);
            __builtin_amdgcn_sched_barrier(0);
            PS_LOAD(bufB, e0, 1); __builtin_amdgcn_sched_barrier(0);
            f32x2_t o2[8];
#pragma unroll
            for (int i = 0; i < 8; ++i) o2[i] = (f32x2_t){0.f, 0.f};
#define PS_DN1(buf, II, wv_) { const v4u vv = buf[II]; const float w = __uint_as_float((unsigned)PS_BC(wv_, II)); \
                if (MODE == 1) { o2[0].x += w * __uint_as_float((vv.x ^ vv.y) & 0x3fffffffu); o2[0].y += w * __uint_as_float((vv.z ^ vv.w) & 0x3fffffffu); } else { \
                _Pragma("unroll") for (int q = 0; q < 4; ++q) { const f32x2_t lo = __builtin_amdgcn_cvt_pk_f32_fp8((int)vv[q], false), hi = __builtin_amdgcn_cvt_pk_f32_fp8((int)vv[q], true); \
                    o2[q * 2] += lo * w; o2[q * 2 + 1] += hi * w; } } }
#define PS_DNCOMP(buf, C_) do { const unsigned wv_ = w0[C_]; PS_DN1(buf, 0, wv_) PS_DN1(buf, 1, wv_) PS_DN1(buf, 2, wv_) PS_DN1(buf, 3, wv_) PS_DN1(buf, 4, wv_) PS_DN1(buf, 5, wv_) PS_DN1(buf, 6, wv_) PS_DN1(buf, 7, wv_) } while (0)
            PS_DNCOMP(bufA, 0);
            PS_LOAD(bufA, e1, 0); __builtin_amdgcn_sched_barrier(0);
            PS_DNCOMP(bufB, 1);
            float o[16];
#pragma unroll
            for (int i = 0; i < 8; ++i) { o[2 * i] = o2[i].x; o[2 * i + 1] = o2[i].y; }
            float r1[8], r2[4], r3[2];
#pragma unroll
            for (int k = 0; k < 8; ++k) { auto rr = __builtin_amdgcn_permlane32_swap(__float_as_uint(o[k]), __float_as_uint(o[k + 8]), false, false); r1[k] = __uint_as_float(rr[0]) + __uint_as_float(rr[1]); }
#pragma unroll
            for (int k = 0; k < 4; ++k) { const float keep = b4 ? r1[k + 4] : r1[k], send = b4 ? r1[k] : r1[k + 4]; r2[k] = keep + __shfl_xor(send, 16); }
#pragma unroll
            for (int k = 0; k < 2; ++k) { const float keep = b3 ? r2[k + 2] : r2[k], send = b3 ? r2[k] : r2[k + 2]; r3[k] = keep + dppf<DPP_ROR8>(send); }
            const f32x2_t xv = {bflo(xw), bfhi(xw)}, gg = gga + ggb;
            const f32x2_t x2f = xv + gg * (f32x2_t){r3[0], r3[1]};
            const unsigned xo = pk2(x2f.x, x2f.y); const f32x2_t x2 = {bflo(xo), bfhi(xo)};
            if (MODE == 0) *xr = xo;
            const float ss = wave_sum(x2.x * x2.x + x2.y * x2.y);
            if (MODE == 0) { if (lane == 0) SSQ[(size_t)slice * MALL + tok] = ss; }
            else if (lane == 0) ((float*)(F.ws + WS_MODP))[(F.gw & 511) * 64] = ss;
            e0[0] = e1[0]; e0[1] = e1[1]; e1[0] = e2[0]; e1[1] = e2[1]; w0[0] = w1[0]; w0[1] = w1[1]; w1[0] = w2[0]; w1[1] = w2[1];
        }
    }
}
#undef PS_IDX2
#undef PS_BC
#undef PS_LD1
#undef PS_DN1
#undef PS_LOAD
#undef PS_UPCOMP
#undef PS_DNCOMP
__device__ __forceinline__ void peer_down_mfma(Frame& F, int l, int nrows) {
    frame_refresh(F); asm volatile("" : "+s"(l));
    typedef int v8i_t __attribute__((ext_vector_type(8))); typedef int v4i_t __attribute__((ext_vector_type(4)));
    const int lane = F.lane, i16 = lane & 15, kq = lane >> 4, tsel = i16 >> 3, ch = i16 & 7;
    const unsigned bm = 0xffu << (8 * (ch & 3)), m0 = ch < 4 ? bm : 0u, m1 = ch < 4 ? 0u : bm;
    const bool dvalid = tsel == (kq >> 1);
    const int xg = blockIdx.x & 7, wg = (blockIdx.x >> 3) * NWAVES + F.wave, nwg = (F.G >> 3) * NWAVES;
    const unsigned* IDX = (const unsigned*)(F.ws + WS_IDX); const unsigned char* W8 = F.ws + WS_W8; const float* TS = (const float*)(F.ws + WS_TS); float* SSQ = (float*)(F.ws + WS_SSQ);
    bf16* XS = (bf16*)(F.ws + WS_XS);
    const float* modl = F.mod + (size_t)l * 5 * 12288 + 5 * DM; const float* bl = F.ada_b + (size_t)l * 12288 + 5 * DM;
    LAS float* tr = (LAS float*)(F.lds + F.wave * 2048);
    const int srcl = (tsel * 32 + kq * 8) * 4;
    const int wa0 = dvalid ? tsel * 128 + (4 * (kq & 1)) * 16 + ch : 256 + lane; const int wstep = dvalid ? 16 : 0, whalf = dvalid ? 8 : 0;
    const int np = nrows / (2 * nwg);
    for (int sub = 0; sub < 2; ++sub) {
        const int slice = xg + 8 * sub, col = slice * 128 + 2 * lane;
        const unsigned char* tbl = F.ws + WS_PV + (size_t)l * NEXP * DM + (size_t)slice * (NEXP * 128);
        const unsigned loff = (unsigned)(ch * 16);
        const f32x2_t ggb = *(const GAS f32x2_t*)(bl + col);
#define DM_LDL(e_, w_, p_) do { const int t_ = wg + (2 * (p_) + (lane >> 5)) * nwg; e_ = *(const GAS v4u*)(IDX + (size_t)t_ * 128 + 4 * (lane & 31)); w_ = *(const GAS unsigned*)(W8 + (size_t)t_ * 128 + 4 * (lane & 31)); } while (0)
#define DM_LDA(A_, e_, b_) do { _Pragma("unroll") for (int a8 = 0; a8 < 8; ++a8) { const int a_ = 8 * (b_) + a8, sl_ = srcl + 4 * (a_ >> 1); \
            const unsigned el_ = (unsigned)__builtin_amdgcn_ds_bpermute(sl_, (int)((a_ & 1) ? e_.z : e_.x)), eh_ = (unsigned)__builtin_amdgcn_ds_bpermute(sl_, (int)((a_ & 1) ? e_.w : e_.y)); \
            A_[a8].lo = *(const GAS v4i_t*)(tbl + (el_ * 128u + loff)); A_[a8].hi = *(const GAS v4i_t*)(tbl + (eh_ * 128u + loff)); } } while (0)
#define DM_COMP(A_, w_, b_) do { unsigned wd_ = 0u; _Pragma("unroll") for (int a8 = 0; a8 < 8; ++a8) { const int a_ = 8 * (b_) + a8; \
            if ((a_ & 1) == 0) wd_ = (unsigned)__builtin_amdgcn_ds_bpermute(srcl + 4 * (a_ >> 1), (int)w_); \
            const unsigned wl_ = __builtin_amdgcn_perm(wd_, wd_, (a_ & 1) ? 0x02020202u : 0x00000000u), wh_ = __builtin_amdgcn_perm(wd_, wd_, (a_ & 1) ? 0x03030303u : 0x01010101u); \
            v8i_t& p1_ = (a8 & 1) ? B1o : B1e; v8i_t& p2_ = (a8 & 1) ? B2o : B2e;        \
            p1_[0] = (int)(wl_ & m0); p1_[1] = (int)(wl_ & m1); p1_[4] = (int)(wh_ & m0); p1_[5] = (int)(wh_ & m1); p2_[2] = (int)(wl_ & m0); p2_[3] = (int)(wl_ & m1); p2_[6] = (int)(wh_ & m0); p2_[7] = (int)(wh_ & m1); \
            D1 = __builtin_amdgcn_mfma_scale_f32_16x16x128_f8f6f4(A_[a8], p1_, D1, 0, 0, 0, 0x7F7F7F7F, 0, 0x7F7F7F7F); \
            D2 = __builtin_amdgcn_mfma_scale_f32_16x16x128_f8f6f4(A_[a8], p2_, D2, 0, 0, 0, 0x7F7F7F7F, 0, 0x7F7F7F7F); } } while (0)
        v4u eL, eN; unsigned wL, wN; v8i_t bufA[8], bufB[8];
        v8i_t B1e = {0, 0, 0, 0, 0, 0, 0, 0}, B1o = B1e, B2e = B1e, B2o = B1e;
        DM_LDL(eL, wL, 0); __builtin_amdgcn_sched_barrier(0);
        DM_LDA(bufA, eL, 0);
        for (int p = 0; p < np; ++p) {
            const int pn = min(p + 1, np - 1), t0 = wg + (2 * p) * nwg, t1 = t0 + nwg;
            DM_LDL(eN, wN, pn);
            const int mr0 = t0 < NLAT ? t0 / SEQ : 4, mr1 = t1 < NLAT ? t1 / SEQ : 4;
            GAS unsigned* xr0 = (GAS unsigned*)(XS + (size_t)t0 * DM + col); GAS unsigned* xr1 = (GAS unsigned*)(XS + (size_t)t1 * DM + col);
            const unsigned xw0 = *xr0, xw1 = *xr1; const f32x2_t gga0 = *(const GAS f32x2_t*)(modl + mr0 * 12288 + col), gga1 = *(const GAS f32x2_t*)(modl + mr1 * 12288 + col);
            const float ts0 = TS[t0], ts1 = TS[t1];
            __builtin_amdgcn_sched_barrier(0);
            DM_LDA(bufB, eL, 1); __builtin_amdgcn_sched_barrier(0);
            v4f D1 = {0.f, 0.f, 0.f, 0.f}, D2 = {0.f, 0.f, 0.f, 0.f};
            DM_COMP(bufA, wL, 0);
            DM_LDA(bufA, eN, 0); __builtin_amdgcn_sched_barrier(0);
            DM_COMP(bufB, wL, 1);
#pragma unroll
            for (int r = 0; r < 4; ++r) { tr[wa0 + r * wstep] = D1[r]; tr[wa0 + r * wstep + whalf] = D2[r]; }
            LDS_WAIT();
            const f32x2_t y0 = *(const LAS f32x2_t*)(tr + 2 * lane), y1 = *(const LAS f32x2_t*)(tr + 128 + 2 * lane);
            LDS_WAIT();
            { const f32x2_t xv = {bflo(xw0), bfhi(xw0)}, gg = gga0 + ggb; const f32x2_t x2f = xv + gg * (y0 * ts0);
              const unsigned xo = pk2(x2f.x, x2f.y); const f32x2_t x2 = {bflo(xo), bfhi(xo)}; *xr0 = xo;
              const float ss = wave_sum_dpp(x2.x * x2.x + x2.y * x2.y); if (lane == 0) SSQ[(size_t)slice * MALL + t0] = ss; }
            { const f32x2_t xv = {bflo(xw1), bfhi(xw1)}, gg = gga1 + ggb; const f32x2_t x2f = xv + gg * (y1 * ts1);
              const unsigned xo = pk2(x2f.x, x2f.y); const f32x2_t x2 = {bflo(xo), bfhi(xo)}; *xr1 = xo;
              const float ss = wave_sum_dpp(x2.x * x2.x + x2.y * x2.y); if (lane == 0) SSQ[(size_t)slice * MALL + t1] = ss; }
            eL = eN; wL = wN;
        }
#undef DM_LDL
#undef DM_LDA
#undef DM_COMP
    }
}
__device__ __forceinline__ void post_norm_phase(Frame& F, int l, int nrows, bool last) {
    frame_refresh(F); asm volatile("" : "+s"(l));
    bf16* H = (bf16*)(F.ws + WS_H); const float* SSQ = (const float*)(F.ws + WS_SSQ); const bf16* XS = (const bf16*)(F.ws + WS_XS);
    const float* modn = F.mod + (size_t)(l + 1) * 5 * 12288; const float* bn = F.ada_b + (size_t)(l + 1) * 12288;
    const int lane = F.lane;
    const bool bad = last && __hip_atomic_load((unsigned*)(F.ws + WS_CTL) + 24, __ATOMIC_RELAXED, __HIP_MEMORY_SCOPE_AGENT) != 0u;
    const int r0 = (int)(((long)F.gw * nrows) / F.NGW), r1 = (int)(((long)(F.gw + 1) * nrows) / F.NGW);
    if (r0 >= r1) return;
    v4f cur[8], nxt[8], Av[8], Bv[8]; float scur, snxt = 0.f; int have = -1;
    load_row<true>(cur, nullptr, nullptr, XS, r0, lane); scur = (lane < NSL) ? SSQ[(size_t)lane * MALL + r0] : 0.f;
    for (int row = r0; row < r1; ++row) {
        const int mr = row < NLAT ? row / SEQ : 4;
        if (mr != have) { have = mr;
#pragma unroll
            for (int j = 0; j < 8; ++j) { const int cidx = row_col<true>(j, lane);
                if (!last) { Av[j] = *(const v4f*)(F.norm1_g + (size_t)(l + 1) * DM + cidx) * (*(const v4f*)(modn + mr * 12288 + DM + cidx) + *(const v4f*)(bn + DM + cidx) + 1.f);
                    Bv[j] = *(const v4f*)(modn + mr * 12288 + cidx) + *(const v4f*)(bn + cidx); }
                else { Av[j] = *(const v4f*)(F.final_g + cidx); Bv[j] = (v4f){0.f, 0.f, 0.f, 0.f}; } } }
        { const int rn = min(row + 1, r1 - 1); load_row<true>(nxt, nullptr, nullptr, XS, rn, lane); snxt = SSQ[(size_t)(lane & (NSL - 1)) * MALL + rn]; if (lane >= NSL) snxt = 0.f; }
        const float rstd = rsqrtf(wave_sum(scur) * (1.f / DM) + EPS);
        v4f yv[8];
#pragma unroll
        for (int j = 0; j < 8; ++j) { const int cidx = row_col<true>(j, lane); yv[j] = (cur[j] * rstd) * Av[j] + Bv[j];
            if (last) *(GAS v4f*)(F.out + (size_t)row * DM + cidx) = bad ? (v4f){0.f, 0.f, 0.f, 0.f} : yv[j]; }
        if (!last) quant_row8<true>(yv, (unsigned char*)H + (size_t)row * DM, (float*)(F.ws + WS_HS) + row, lane);
#pragma unroll
        for (int j = 0; j < 8; ++j) cur[j] = nxt[j];
        scur = snxt;
    }
}
__device__ __forceinline__ bool mfma8_selftest(int lane) {
    typedef int v8i_t __attribute__((ext_vector_type(8)));
    const int idx = lane & 15, kb = lane >> 4;
    v8i_t X, Y;
#pragma unroll
    for (int w = 0; w < 8; ++w) { float xa[4], yb[4];
#pragma unroll
        for (int t = 0; t < 4; ++t) { const int k = 32 * kb + 4 * w + t; xa[t] = (float)(((idx * 3 + k * 5) % 7) - 3); yb[t] = (float)(((k * 2 + idx * 7) % 5) - 2); }
        int xw = 0, yw = 0; xw = __builtin_amdgcn_cvt_pk_fp8_f32(xa[0], xa[1], xw, false); xw = __builtin_amdgcn_cvt_pk_fp8_f32(xa[2], xa[3], xw, true);
        yw = __builtin_amdgcn_cvt_pk_fp8_f32(yb[0], yb[1], yw, false); yw = __builtin_amdgcn_cvt_pk_fp8_f32(yb[2], yb[3], yw, true); X[w] = xw; Y[w] = yw; }
    v4f d = {0.f, 0.f, 0.f, 0.f};
    d = __builtin_amdgcn_mfma_scale_f32_16x16x128_f8f6f4(X, Y, d, 0, 0, 0, 0x7F7F7F7F, 0, 0x7F7F7F7F);
    bool ok = true;
#pragma unroll
    for (int r = 0; r < 4; ++r) { const int i = 4 * kb + r, j = idx; int e = 0;
        for (int k = 0; k < 128; ++k) e += (((i * 3 + k * 5) % 7) - 3) * (((k * 2 + j * 7) % 5) - 2);
        ok = ok && (d[r] == (float)e); }
    return __all(ok);
}
struct Args { const float* in[22]; float* out; unsigned char* ws; int ph_lo, ph_hi, use_bar, pad; };
__global__ void __launch_bounds__(NWAVES * 64, 2) mk_fwd(Args args) {
    extern __shared__ __attribute__((aligned(16))) unsigned char lds[];
    Frame F;
    F.lds = (LAS unsigned char*)lds; F.ldsg = lds;
    F.tid = threadIdx.x; F.lane = F.tid & 63; F.wave = __builtin_amdgcn_readfirstlane(F.tid >> 6);
    F.G = gridDim.x; { const int bx = blockIdx.x; F.vcu = (F.G % 8 == 0) ? (bx % 8) * (F.G / 8) + bx / 8 : bx; }
    F.gw = F.vcu * NWAVES + F.wave; F.NGW = F.G * NWAVES;
    F.x = args.in[0]; F.c = args.in[1]; F.ctx = args.in[2]; F.c_ctx = args.in[3]; F.ada_w = args.in[4]; F.ada_b = args.in[5]; F.norm1_g = args.in[6]; F.norm2_g = args.in[7];
    F.w_in = args.in[8]; F.b_gate = args.in[9]; F.q_norm_g = args.in[10]; F.k_norm_g = args.in[11]; F.conv_w = args.in[12]; F.w_ao = args.in[13]; F.w_co = args.in[14]; F.w_o = args.in[15];
    F.peer_wq = args.in[16]; F.peer_k1 = args.in[17]; F.peer_k2 = args.in[18]; F.peer_u = args.in[19]; F.peer_v = args.in[20]; F.final_g = args.in[21];
    F.out = args.out; F.ws = args.ws; F.mod = (float*)(args.ws + WS_CTL + CTL_MOD);
    volatile LAS unsigned* MISC = (volatile LAS unsigned*)(F.lds + MISC_OFF);
    for (int u = F.tid; u < (LDS_BYTES - MISC_OFF) / 4; u += NWAVES * 64) MISC[u] = 0u;
    __syncthreads();
    XcdBarrier bar; bar.bar = (unsigned*)(args.ws + WS_CTL) + CW_BAR; bar.x = 0; bar.st = nullptr;
    if (args.use_bar) bar = xcd_barrier_post((unsigned*)(args.ws + WS_CTL) + CW_BAR, MISC + 8);
    const int lo = args.ph_lo, hi = args.ph_hi;
#ifndef PHASE_MASK
#define PHASE_MASK 0xFFFFFFFFu
#endif
#define PHK(k) ((k) < 3 ? (k) : 3 + ((k) - 3) % NPH_LAYER)
#define IN(k) (((PHASE_MASK >> PHK(k)) & 1u) && lo <= (k) && (k) < hi)
#define SEAM(k) do { if (IN(k) && IN((k) + 1)) xcd_barrier(bar); } while (0)
    bf16* H = (bf16*)(F.ws + WS_H); bf16* P = (bf16*)(F.ws + WS_P); bf16* A2 = (bf16*)(F.ws + WS_A2); bf16* XS = (bf16*)(F.ws + WS_XS);

#if PROBE_DUP & 0x200
    if (IN(0)) { p0_prologue(F); __syncthreads(); }
#endif
    if (IN(0) && blockIdx.x == 0 && F.wave == 0) { if (!mfma8_selftest(F.lane) && F.lane == 0) __hip_atomic_store((unsigned*)(args.ws + WS_CTL) + 24, 1u, __ATOMIC_RELAXED, __HIP_MEMORY_SCOPE_AGENT); }
    if (IN(0)) { p0_prologue(F); __syncthreads(); } SEAM(0);
    if (IN(1)) { mod_reduce_phase(F); } SEAM(1);
    if (IN(2)) { norm_phase<1, false>(F, F.x, F.ctx, MALL, 0, F.norm1_g, 0, 1); } SEAM(2);
    for (int l = 0; l < 2; ++l) {
        const int base = 3 + NPH_LAYER * l, Ml = (l == 0) ? MALL : NLAT;
        if (IN(base + 0)) {
            pg8::Gemm g{H, (const bf16*)(F.ws + WS_WIN + (size_t)l * INW * DM), Ml, INW, DM / 2}; pg8::OrderX S; S.init(Ml, INW, F.G, (int)blockIdx.x, l == 1 ? 16 : 0);
            pg8::EpiStore8 E{F.ws + WS_P, INW, (const float*)(F.ws + WS_HS), G8_SCALE / W8_SCALE};
            for (int rep = 0; rep < ((PROBE_DUP & 0x1) ? 2 : 1); ++rep) pg8::gemm_phase<pg8::EpiStore8, pg8::OrderX, true, true, true>(F.lds, g, S, E);
        } SEAM(base + 0);
#if PROBE_DUP & 0x2
        if (IN(base + 1)) { split_phase(F, l, Ml, MALL); }
#endif
        if (IN(base + 1)) { split_phase(F, l, Ml, MALL); } SEAM(base + 1);
#if PROBE_DUP & 0x4
        if (IN(base + 2)) { attn_phase(F, l == 0, true); }
#endif
        if (IN(base + 2)) { attn_phase(F, l == 0); } SEAM(base + 2);
        if (IN(base + 3)) {
            pg8::Gemm g{(const bf16*)(F.ws + WS_A2), (const bf16*)(F.ws + WS_W2 + (size_t)l * DM * 4096), Ml, DM, 2048}; pg8::OrderX S; S.init(Ml, DM, F.G, (int)blockIdx.x, 0);
            pg8::EpiGate<true> E{H, DM  , MG8_SCALE, CV8_SCALE / AT8_SCALE, 1.f / (CV8_SCALE * W8_SCALE), (const unsigned char*)P, INW, C_GA, C_GA + 2048, 1.f / G8_SCALE, F.b_gate + (size_t)l * 4096};
            for (int rep = 0; rep < ((PROBE_DUP & 0x8) ? 2 : 1); ++rep) pg8::gemm_phase<pg8::EpiGate<true>, pg8::OrderX, true, true, true>(F.lds, g, S, E);
        } SEAM(base + 3);
        if (IN(base + 4)) {
            pg8::Gemm g{H, (const bf16*)(F.ws + WS_WO + (size_t)l * DM * DM), Ml, DM, DM / 2}; pg8::OrderX S; S.init(Ml, DM, F.G, (int)blockIdx.x, 0);
            if (l == 0) { pg8::EpiResid<false> E{F.x, F.ctx, XS, F.mod + (size_t)l * 5 * 12288 + 2 * DM, F.ada_b + (size_t)l * 12288 + 2 * DM, 1.f / (MG8_SCALE * W8_SCALE)};
                pg8::gemm_phase<pg8::EpiResid<false>, pg8::OrderX, true, true, true>(F.lds, g, S, E); }
            else { pg8::EpiResid<true> E{nullptr, nullptr, XS, F.mod + (size_t)l * 5 * 12288 + 2 * DM, F.ada_b + (size_t)l * 12288 + 2 * DM, 1.f / (MG8_SCALE * W8_SCALE)};
                pg8::gemm_phase<pg8::EpiResid<true>, pg8::OrderX, true, true, true>(F.lds, g, S, E); }
        } SEAM(base + 4);
#if PROBE_DUP & 0x20
        if (IN(base + 5)) { norm_phase<0, true>(F, nullptr, nullptr, Ml, l, F.norm2_g + (size_t)l * DM, 3, 4); }
#endif
        if (IN(base + 5)) { norm_phase<0, true>(F, nullptr, nullptr, Ml, l, F.norm2_g + (size_t)l * DM, 3, 4); } SEAM(base + 5);
        if (IN(base + 6)) {
            pg8::Gemm g{H, (const bf16*)(F.ws + WS_WQ) + (size_t)l * DM * DM, Ml, DM, DM}; pg8::OrderX S; S.init(Ml, DM, F.G, (int)blockIdx.x, 0);
            pg8::EpiStore E{(bf16*)(F.ws + WS_PQ), DM};
            for (int rep = 0; rep < ((PROBE_DUP & 0x40) ? 2 : 1); ++rep) pg8::gemm_phase<pg8::EpiStore, pg8::OrderX, true, true>(F.lds, g, S, E);
        } SEAM(base + 6);
#if PROBE_DUP & 0x80
        if (IN(base + 7)) { topk_phase(F, l, Ml); }
#endif
        if (IN(base + 7)) { topk_phase(F, l, Ml); } SEAM(base + 7);
#if PROBE_DUP & 0x100
        if (IN(base + 8)) { peer_up_phase<PROBE_GMODE>(F, l, Ml); }
#endif
        if (IN(base + 8)) { peer_up_mfma(F, l, Ml); } SEAM(base + 8);
#if PROBE_DUP & 0x400
        if (IN(base + 9)) { peer_combine_phase(F, l, Ml, Ml % (2 * (F.G >> 3) * NWAVES) != 0); }
#endif
        if (IN(base + 9)) { peer_combine_phase(F, l, Ml, Ml % (2 * (F.G >> 3) * NWAVES) != 0); } SEAM(base + 9);
#if PROBE_DUP & 0x100
        if (IN(base + 10)) { peer_down_phase<PROBE_GMODE ? PROBE_GMODE : 3>(F, l, Ml); }
#endif
        if (IN(base + 10)) { if (Ml % (2 * (F.G >> 3) * NWAVES) == 0) peer_down_mfma(F, l, Ml); else peer_down_phase<0>(F, l, Ml); } SEAM(base + 10);
#if PROBE_DUP & 0x800
        if (IN(base + 11) && l == 0) { post_norm_phase(F, l, Ml, false); }
#endif
        if (IN(base + 11)) { post_norm_phase(F, l, Ml, l == 1); }
        if (l == 0) SEAM(base + 11);
    }
#undef IN
#undef SEAM
}

extern "C" void kernel_launch(void* const* d_in, const int* in_sizes, int n_in, void* d_out, int out_size, void* d_ws, size_t ws_size, hipStream_t stream) {
    static int grid = 0;
    if (grid == 0) {
        if (n_in != 22 || out_size != NLAT * DM || ws_size < WS_END) { fprintf(stderr, "kernel_launch: unexpected shapes: n_in %d out %d ws %zu (need %zu)\n", n_in, out_size, ws_size, (size_t)WS_END); grid = -1; return; }
        int dev = 0, cus = 0, per_cu = 0;
        if (hipGetDevice(&dev) != hipSuccess || hipDeviceGetAttribute(&cus, hipDeviceAttributeMultiprocessorCount, dev) != hipSuccess) { grid = -1; return; }
        if (hipFuncSetAttribute((const void*)mk_fwd, hipFuncAttributeMaxDynamicSharedMemorySize, LDS_BYTES) != hipSuccess) { fprintf(stderr, "kernel_launch: hipFuncSetAttribute failed\n"); grid = -1; return; }
        if (hipOccupancyMaxActiveBlocksPerMultiprocessor(&per_cu, (const void*)mk_fwd, NWAVES * 64, LDS_BYTES) != hipSuccess || per_cu < 1) fprintf(stderr, "kernel_launch: occupancy query reports %d\n", per_cu);
        (void)hipGetLastError();
        grid = cus;
    }
    if (grid < 0) return;
    if (hipMemsetAsync((char*)d_ws + WS_CTL, 0, CTL_ZERO_BYTES, stream) != hipSuccess) return;
    Args a{};
    for (int i = 0; i < 22; ++i) a.in[i] = (const float*)d_in[i];
    a.out = (float*)d_out; a.ws = (unsigned char*)d_ws; a.pad = 0;
#if MK_ONE_LAUNCH
    a.ph_lo = 0; a.ph_hi = NPH; a.use_bar = 1;
    hipLaunchKernelGGL(mk_fwd, dim3(grid), dim3(NWAVES * 64), LDS_BYTES, stream, a);
#else
    for (int p = 0; p < NPH; ++p) { a.ph_lo = p; a.ph_hi = p + 1; a.use_bar = 0;
        hipLaunchKernelGGL(mk_fwd, dim3(grid), dim3(NWAVES * 64), LDS_BYTES, stream, a); }
#endif
    const hipError_t le = hipPeekAtLastError();
    if (le != hipSuccess) fprintf(stderr, "kernel_launch: launch failed: %s\n", hipGetErrorName(le));
}
```
